# Optimizing an MI355X kernel written in HIP

```python
import jax, jax.numpy as jnp
from jax import lax
import numpy as np

D_MODEL = 1024
BATCH = 4
SEQ = 8192
DEPTH = 2

N_ATTN_HEADS = 8
ATTN_HEAD_DIM = 64
ATTN_WIDTH = N_ATTN_HEADS * ATTN_HEAD_DIM
N_REC_HEADS = 4
REC_HEAD_DIM = 128
REC_WIDTH = N_REC_HEADS * REC_HEAD_DIM
D_MIX = ATTN_WIDTH + REC_WIDTH
IN_COLS = 3 * ATTN_WIDTH + N_ATTN_HEADS + 4 * REC_WIDTH
SPLIT_POINTS = (ATTN_WIDTH, 2 * ATTN_WIDTH, 3 * ATTN_WIDTH,
                3 * ATTN_WIDTH + N_ATTN_HEADS,
                3 * ATTN_WIDTH + N_ATTN_HEADS + REC_WIDTH,
                3 * ATTN_WIDTH + N_ATTN_HEADS + 2 * REC_WIDTH,
                3 * ATTN_WIDTH + N_ATTN_HEADS + 3 * REC_WIDTH)
D_FF = 2816
CONV_WIDTH = 3
FOX_BLOCK = 128
HGRN_CHUNK = 64
LN_EPS = 1e-5
RMS_EPS = 1e-6
DEEPNORM_ALPHA = (2.0 * DEPTH) ** 0.25
DEEPNORM_BETA = (8.0 * DEPTH) ** -0.25

kernel_name = 'hybrid_fox_hgrn2_deepnorm'


def _layer_norm(x, g, b):
    xf = x.astype(jnp.float32)
    mu = jnp.mean(xf, axis=-1, keepdims=True)
    var = jnp.mean(jnp.square(xf - mu), axis=-1, keepdims=True)
    y = (xf - mu) * lax.rsqrt(var + LN_EPS)
    return (y * g.astype(jnp.float32) + b.astype(jnp.float32)).astype(x.dtype)


def _rms_norm_heads(x, g):
    xf = x.astype(jnp.float32)
    y = xf * lax.rsqrt(jnp.mean(jnp.square(xf), axis=-1, keepdims=True) + RMS_EPS)
    return y * g.astype(jnp.float32)


def _fox_attention(q, k, v, logf):
    B, H, S, D = q.shape
    n_blocks = S // FOX_BLOCK
    c = jnp.cumsum(logf.astype(jnp.float32), axis=-1)
    qf = q.astype(jnp.float32) * (D ** -0.5)
    kf = k.astype(jnp.float32)
    vf = v.astype(jnp.float32)
    q_blocks = qf.reshape(B, H, n_blocks, FOX_BLOCK, D).transpose(2, 0, 1, 3, 4)
    c_blocks = c.reshape(B, H, n_blocks, FOX_BLOCK).transpose(2, 0, 1, 3)
    key_pos = jnp.arange(S)

    def block(args):
        q_i, c_i, i = args
        s = jnp.einsum('bhqd,bhkd->bhqk', q_i, kf) + c_i[..., :, None] - c[..., None, :]
        q_pos = i * FOX_BLOCK + jnp.arange(FOX_BLOCK)
        s = jnp.where(key_pos[None, :] <= q_pos[:, None], s, -jnp.inf)
        p = jax.nn.softmax(s, axis=-1)
        return jnp.einsum('bhqk,bhkd->bhqd', p, vf)

    o = lax.map(block, (q_blocks, c_blocks, jnp.arange(n_blocks)))
    return o.transpose(1, 2, 0, 3, 4).reshape(B, H, S, D)


def _hgrn2_chunked(q, k, v, logf):
    B, H, S, DK = q.shape
    DV = v.shape[-1]
    C = HGRN_CHUNK
    n_chunks = S // C

    def to_chunks(t):
        return t.astype(jnp.float32).reshape(B, H, n_chunks, C, t.shape[-1]).transpose(2, 0, 1, 3, 4)

    qc, kc, vc, gc = to_chunks(q), to_chunks(k), to_chunks(v), to_chunks(logf)
    b = jnp.cumsum(gc, axis=-2)
    causal = jnp.tril(jnp.ones((C, C), dtype=bool))

    def step(state, inp):
        q_i, k_i, v_i, b_i = inp
        diff = b_i[..., :, None, :] - b_i[..., None, :, :]
        decay = jnp.where(causal[:, :, None], jnp.exp(jnp.minimum(diff, 0.0)), 0.0)
        scores = jnp.einsum('bhtd,bhsd,bhtsd->bhts', q_i, k_i, decay)
        o = jnp.einsum('bhts,bhse->bhte', scores, v_i) \
            + jnp.einsum('bhtd,bhde->bhte', q_i * jnp.exp(b_i), state)
        b_last = b_i[..., -1:, :]
        state = jnp.exp(b_last[..., 0, :])[..., None] * state \
            + jnp.einsum('bhsd,bhse->bhde', k_i * jnp.exp(b_last - b_i), v_i)
        return state, o

    state0 = jnp.zeros((B, H, DK, DV), jnp.float32)
    _, o = lax.scan(step, state0, (qc, kc, vc, b))
    return o.transpose(1, 2, 0, 3, 4).reshape(B, H, S, DV)


def _causal_depthwise_conv(h, w, bias):
    S = h.shape[1]
    hp = jnp.pad(h, ((0, 0), (CONV_WIDTH - 1, 0), (0, 0)))
    y = bias
    for j in range(CONV_WIDTH):
        y = y + w[j] * hp[:, j:j + S, :]
    return y


def setup_inputs(seed: int = 0) -> dict:
    key = jax.random.key(seed)
    ks = jax.random.split(key, 17)

    def nrm(k, shape, scale):
        return jax.random.normal(k, shape, jnp.float32) * scale

    col_scale = jnp.concatenate([
        jnp.ones((2 * ATTN_WIDTH,), jnp.float32),
        jnp.full((ATTN_WIDTH,), DEEPNORM_BETA, jnp.float32),
        jnp.ones((N_ATTN_HEADS + 2 * REC_WIDTH,), jnp.float32),
        jnp.full((REC_WIDTH,), DEEPNORM_BETA, jnp.float32),
        jnp.ones((REC_WIDTH,), jnp.float32)])

    return {
        'x': nrm(ks[0], (BATCH, SEQ, D_MODEL), 1.0),
        'ln_emb_g': 1.0 + nrm(ks[1], (D_MODEL,), 0.05),
        'ln_emb_b': nrm(ks[2], (D_MODEL,), 0.02),
        'w_in': nrm(ks[3], (DEPTH, D_MODEL, IN_COLS), D_MODEL ** -0.5) * col_scale,
        'fox_f_bias': 1.0 + nrm(ks[4], (DEPTH, N_ATTN_HEADS), 0.1),
        'fox_norm_g': 1.0 + nrm(ks[5], (DEPTH, ATTN_WIDTH), 0.05),
        'hgrn_lower_bounds': nrm(ks[6], (DEPTH, REC_WIDTH), 0.1),
        'hgrn_norm_g': 1.0 + nrm(ks[7], (DEPTH, REC_WIDTH), 0.05),
        'w_o': nrm(ks[8], (DEPTH, D_MIX, D_MODEL), D_MIX ** -0.5 * DEEPNORM_BETA),
        'ln_mix_g': 1.0 + nrm(ks[9], (DEPTH, D_MODEL), 0.05),
        'ln_mix_b': nrm(ks[10], (DEPTH, D_MODEL), 0.02),
        'w_up': nrm(ks[11], (DEPTH, D_MODEL, 2 * D_FF), D_MODEL ** -0.5 * DEEPNORM_BETA),
        'conv_w': nrm(ks[12], (DEPTH, CONV_WIDTH, 2 * D_FF), CONV_WIDTH ** -0.5),
        'conv_b': nrm(ks[13], (DEPTH, 2 * D_FF), 0.02),
        'w_down': nrm(ks[14], (DEPTH, D_FF, D_MODEL), D_FF ** -0.5 * DEEPNORM_BETA),
        'ln_ffn_g': 1.0 + nrm(ks[15], (DEPTH, D_MODEL), 0.05),
        'ln_ffn_b': nrm(ks[16], (DEPTH, D_MODEL), 0.02),
    }


def reference(x, ln_emb_g, ln_emb_b, w_in, fox_f_bias, fox_norm_g, hgrn_lower_bounds,
              hgrn_norm_g, w_o, ln_mix_g, ln_mix_b, w_up, conv_w, conv_b, w_down,
              ln_ffn_g, ln_ffn_b):
    B, S, _ = x.shape
    dtype = x.dtype

    lb_sm = jax.nn.softmax(hgrn_lower_bounds.astype(jnp.float32), axis=0)
    lb_cum = jnp.cumsum(lb_sm, axis=0)
    lower_bounds = lb_cum - lb_cum[0:1]

    def heads(t, n_heads):
        return t.reshape(B, S, n_heads, -1).transpose(0, 2, 1, 3)

    x = _layer_norm(x, ln_emb_g, ln_emb_b)

    for l in range(DEPTH):
        proj = x @ w_in[l]
        q_a, k_a, v_a, f_a, q_r, f_r, i_r, g_r = jnp.split(proj, SPLIT_POINTS, axis=-1)

        logf_a = jax.nn.log_sigmoid((f_a + fox_f_bias[l]).astype(jnp.float32)).transpose(0, 2, 1)
        o_a = _fox_attention(heads(q_a, N_ATTN_HEADS), heads(k_a, N_ATTN_HEADS),
                             heads(v_a, N_ATTN_HEADS), logf_a)
        o_a = _rms_norm_heads(o_a.transpose(0, 2, 1, 3),
                              fox_norm_g[l].reshape(N_ATTN_HEADS, ATTN_HEAD_DIM))
        o_a = o_a.reshape(B, S, ATTN_WIDTH)

        lb = lower_bounds[l]
        logf_r = jnp.logaddexp(jnp.log(lb),
                               jnp.log1p(-lb) + jax.nn.log_sigmoid(f_r.astype(jnp.float32)))
        k_r = -jnp.expm1(logf_r)
        o_r = _hgrn2_chunked(heads(jax.nn.silu(q_r), N_REC_HEADS), heads(k_r, N_REC_HEADS),
                             heads(i_r, N_REC_HEADS), heads(logf_r, N_REC_HEADS))
        o_r = _rms_norm_heads(o_r.transpose(0, 2, 1, 3),
                              hgrn_norm_g[l].reshape(N_REC_HEADS, REC_HEAD_DIM))
        o_r = o_r.reshape(B, S, REC_WIDTH) * jax.nn.silu(g_r.astype(jnp.float32))

        mix = jnp.concatenate([o_a, o_r], axis=-1).astype(dtype) @ w_o[l]
        x = _layer_norm(DEEPNORM_ALPHA * x + mix, ln_mix_g[l], ln_mix_b[l])

        h = _causal_depthwise_conv(x @ w_up[l], conv_w[l], conv_b[l])
        a, u = jnp.split(h, 2, axis=-1)
        ffn = (jax.nn.gelu(a, approximate=False) * u) @ w_down[l]
        x = _layer_norm(DEEPNORM_ALPHA * x + ffn, ln_ffn_g[l], ln_ffn_b[l])

    return x
```

```cpp
#include <hip/hip_runtime.h>
#include <hip/hip_cooperative_groups.h>
#include <hip/hip_bf16.h>
#include <cstdio>
#include <cstdint>
#include <cmath>
namespace pg8 {
#define PG8_LAS __attribute__((address_space(3)))
typedef unsigned short bf16_t;
typedef short bf16x8 __attribute__((ext_vector_type(8)));
typedef float f32x4 __attribute__((ext_vector_type(4)));
typedef unsigned u32x4 __attribute__((ext_vector_type(4)));
constexpr int BM = 256, BK = 64, HALF = 128, HTB = HALF * BK * 2  , STAGE_BYTES = 8 * HTB, NXCD = 8, WGM = 4;

__host__ __device__ __forceinline__ int lds_byte(int r, int c) { const int st = (r >> 4) * 2 + (c >> 5), rr = r & 15, cc = c & 31, ob = rr * 64 + cc * 2; return st * 1024 + (ob ^ (((ob >> 9) & 1) << 5)); }
__host__ __device__ __forceinline__ void stage_rc(int b, int& R, int& C) { const int st = b / 1024, sb = b % 1024, swz = sb ^ (((sb >> 9) & 1) << 5); R = (st >> 1) * 16 + swz / 64; C = (st & 1) * 32 + (swz % 64) / 2; }
__host__ __device__ __forceinline__ int perm32(int rho) { const int n = rho >> 4, i = rho & 15; return 8 * (i >> 2) + 4 * n + (i & 3); }

struct Unit { int pm, pn; };
struct Gemm { const bf16_t* A; const bf16_t* Bt; int M, N, K; };

struct StaticOrder {
    int nM, nN, nwg, G, c;
    __host__ __device__ void init(int M, int N, int G_, int c_) { nM = M / BM; nN = N / BM; nwg = nM * nN; G = G_; c = c_; }
    __host__ __device__ bool next(int i, Unit& u) const {
        const long L = (long)i * G + c; if (L >= nwg) return false;
        int wgid = (int)L; { const int q = nwg / NXCD, r = nwg % NXCD, xcd = wgid % NXCD, off = wgid / NXCD; wgid = (xcd < r ? xcd * (q + 1) : r * (q + 1) + (xcd - r) * q) + off; }
        const int nig = WGM * nN, gid = wgid / nig, fm = gid * WGM, gsz = (nM - fm) < WGM ? (nM - fm) : WGM;
        u.pm = fm + ((wgid % nig) % gsz); u.pn = (wgid % nig) / gsz; return true;
    }
    __device__ __forceinline__ void a_ready(const Unit&) const {}
    __device__ __forceinline__ void done(const Unit&) const {}
};

typedef float f32x2c __attribute__((ext_vector_type(2))); typedef __bf16 bf16x2c __attribute__((ext_vector_type(2)));
__device__ __forceinline__ unsigned cvt_pk_bf16(float lo, float hi) { f32x2c v = {lo, hi}; bf16x2c b = __builtin_convertvector(v, bf16x2c); return __builtin_bit_cast(unsigned, b); }
typedef float f32x2 __attribute__((ext_vector_type(2)));
__device__ __forceinline__ f32x2 gelu_pk(f32x2 v) {
    const f32x2 av = __builtin_elementwise_abs(v), d = av * 0.2316418882f + 1.0f;
    f32x2 t; t.x = __builtin_amdgcn_rcpf(d.x); t.y = __builtin_amdgcn_rcpf(d.y);
    f32x2 q = t * 0.5307027145f + (-0.7265760135f); q = q * t + 0.7107068705f; q = q * t + (-0.142248368f); q = q * t + 0.127414796f; q = q * t;
    const f32x2 s = (v * v) * (-0.72134752044f);
    f32x2 e; e.x = __builtin_amdgcn_exp2f(s.x); e.y = __builtin_amdgcn_exp2f(s.y);
    f32x2 p; p.x = fmaxf(v.x, 0.f); p.y = fmaxf(v.y, 0.f);
    return p - av * (q * e);
}

template <int ACT  > struct EpiBf16 {
    static constexpr bool PERM = true, AFTER_DRAIN = false; static_assert(ACT == 0 || ACT == 1, "EpiBf16: ACT is 0 (none) or 1 (gelu_pk)");
    bf16_t* O; int ldc; const float* bias; int split_cols; size_t split_stride; float scale0;
    __device__ __forceinline__ void operator()(const f32x4 (&acc)[2][2][4][2], const Unit& u, int wr, int wc, int fr, int fq) const {
        const int row0 = u.pm * BM + wr * 64 + fr; int colt = u.pn * BM; bf16_t* base = O;
        float sc = 1.f; if (split_cols) { const int t = colt / split_cols; base += (size_t)t * split_stride; colt -= t * split_cols; if (t == 0) sc = scale0; }
        const int col0 = colt + wc * 32 + 8 * fq, bcol0 = u.pn * BM + wc * 32 + 8 * fq;
        f32x4 bv[2][2];
#pragma unroll
        for (int bj = 0; bj < 2; ++bj)
#pragma unroll
            for (int n = 0; n < 2; ++n) bv[bj][n] = bias ? *(const f32x4*)(bias + bcol0 + bj * HALF + 4 * n) : (f32x4){0.f, 0.f, 0.f, 0.f};
#pragma unroll
        for (int ai = 0; ai < 2; ++ai)
#pragma unroll
            for (int m = 0; m < 4; ++m) { bf16_t* rowp = base + (size_t)(row0 + ai * HALF + m * 16) * ldc + col0;
#pragma unroll
                for (int bj = 0; bj < 2; ++bj) { f32x4 v0 = acc[ai][bj][m][0] + bv[bj][0], v1 = acc[ai][bj][m][1] + bv[bj][1];
                    if (ACT == 1) { f32x2 a = gelu_pk((f32x2){v0[0], v0[1]}), b = gelu_pk((f32x2){v0[2], v0[3]}), c = gelu_pk((f32x2){v1[0], v1[1]}), d = gelu_pk((f32x2){v1[2], v1[3]});
                        v0 = (f32x4){a.x, a.y, b.x, b.y}; v1 = (f32x4){c.x, c.y, d.x, d.y}; }
                    v0 = v0 * sc; v1 = v1 * sc; u32x4 w; w.x = cvt_pk_bf16(v0[0], v0[1]); w.y = cvt_pk_bf16(v0[2], v0[3]); w.z = cvt_pk_bf16(v1[0], v1[1]); w.w = cvt_pk_bf16(v1[2], v1[3]);
                    *(u32x4*)(rowp + bj * HALF) = w; } }
    }
};
__device__ __forceinline__ float silu_f(float x) { return x * __builtin_amdgcn_rcpf(1.0f + __expf(-x)); }
constexpr size_t SLOT_ELEMS = (size_t)32768 * 512;
struct EpiProj {
    static constexpr bool PERM = true, AFTER_DRAIN = false;
    bf16_t* base0; const float* hlb; int layer; float qscale;
    template <int MODE  > __device__ __forceinline__ void st_bf16(const f32x4 (&acc)[2][2][4][2], bf16_t* base, int row0, int col0, float sc) const {
#pragma unroll
        for (int ai = 0; ai < 2; ++ai)
#pragma unroll
            for (int m = 0; m < 4; ++m) { bf16_t* rowp = base + (size_t)(row0 + ai * HALF + m * 16) * 512 + col0;
#pragma unroll
                for (int bj = 0; bj < 2; ++bj) { f32x4 v0 = acc[ai][bj][m][0], v1 = acc[ai][bj][m][1];
                    if (MODE == 2) { v0 = (f32x4){silu_f(v0[0]), silu_f(v0[1]), silu_f(v0[2]), silu_f(v0[3])}; v1 = (f32x4){silu_f(v1[0]), silu_f(v1[1]), silu_f(v1[2]), silu_f(v1[3])}; }
                    if (MODE == 1) { v0 = v0 * sc; v1 = v1 * sc; }
                    u32x4 w; w.x = cvt_pk_bf16(v0[0], v0[1]); w.y = cvt_pk_bf16(v0[2], v0[3]); w.z = cvt_pk_bf16(v1[0], v1[1]); w.w = cvt_pk_bf16(v1[2], v1[3]);
                    *(u32x4*)(rowp + bj * HALF) = w; } }
    }
    template <bool LB0> static __device__ __forceinline__ float logf_gate(float z, float l) {
        const float e = __expf(-fabsf(z));
        if (LB0) return fminf(z, 0.f) - __logf(1.0f + e);
        const float r = __builtin_amdgcn_rcpf(1.0f + e); const float sg = (z >= 0.f) ? r : e * r;
        return __logf(l + (1.0f - l) * sg);
    }
    template <bool LB0> static __device__ __forceinline__ f32x4 logf_gate4(f32x4 v, f32x4 l) { return (f32x4){logf_gate<LB0>(v[0], l[0]), logf_gate<LB0>(v[1], l[1]), logf_gate<LB0>(v[2], l[2]), logf_gate<LB0>(v[3], l[3])}; }
    __device__ __forceinline__ f32x4 lb4(int c) const {
        const f32x4 h0 = *(const f32x4*)(hlb + c), h1 = *(const f32x4*)(hlb + 512 + c);
        return (f32x4){__builtin_amdgcn_rcpf(1.0f + __expf(h0[0] - h1[0])), __builtin_amdgcn_rcpf(1.0f + __expf(h0[1] - h1[1])), __builtin_amdgcn_rcpf(1.0f + __expf(h0[2] - h1[2])), __builtin_amdgcn_rcpf(1.0f + __expf(h0[3] - h1[3]))};
    }
    template <bool LB0> __device__ __forceinline__ void st_logf(const f32x4 (&acc)[2][2][4][2], float* base, int row0, int col0) const {
        const f32x4 z4 = (f32x4){0.f, 0.f, 0.f, 0.f};
        const f32x4 lA0 = LB0 ? z4 : lb4(col0), lA1 = LB0 ? z4 : lb4(col0 + 4), lB0 = LB0 ? z4 : lb4(col0 + HALF), lB1 = LB0 ? z4 : lb4(col0 + HALF + 4);
#pragma unroll
        for (int ai = 0; ai < 2; ++ai)
#pragma unroll
            for (int m = 0; m < 4; ++m) { float* rowp = base + (size_t)(row0 + ai * HALF + m * 16) * 512 + col0;
                *(f32x4*)(rowp) = logf_gate4<LB0>(acc[ai][0][m][0], lA0); *(f32x4*)(rowp + 4) = logf_gate4<LB0>(acc[ai][0][m][1], lA1);
                *(f32x4*)(rowp + HALF) = logf_gate4<LB0>(acc[ai][1][m][0], lB0); *(f32x4*)(rowp + HALF + 4) = logf_gate4<LB0>(acc[ai][1][m][1], lB1); }
    }
    __device__ __forceinline__ void operator()(const f32x4 (&acc)[2][2][4][2], const Unit& u, int wr, int wc, int fr, int fq) const {
        const int t = u.pn >> 1, colt = (u.pn & 1) * 256, slot = t < 5 ? t : t + 1;
        const int row0 = u.pm * BM + wr * 64 + fr, col0 = colt + wc * 32 + 8 * fq;
        bf16_t* base = base0 + (size_t)slot * SLOT_ELEMS;
        if (t == 4) { if (layer == 0) st_logf<true>(acc, (float*)base, row0, col0); else st_logf<false>(acc, (float*)base, row0, col0); }
        else if (t == 0) st_bf16<1>(acc, base, row0, col0, qscale);
        else if (t == 3 || t == 6) st_bf16<2>(acc, base, row0, col0, 1.f);
        else st_bf16<0>(acc, base, row0, col0, 1.f);
    }
};
struct EpiRes {
    static constexpr bool PERM = false, AFTER_DRAIN = false;
    const float* ysrc; float* ydst; const float* stats; const float* g; const float* b; float alpha;
    __device__ __forceinline__ void operator()(const f32x4 (&acc)[2][2][4][2], const Unit& u, int wr, int wc, int fr, int fq) const {
        const int col0 = u.pn * BM + wc * 32 + 4 * fq, rowb = u.pm * BM + wr * 64 + fr;
        float mu[2][4], rs[2][4];
#pragma unroll
        for (int ai = 0; ai < 2; ++ai)
#pragma unroll
            for (int m = 0; m < 4; ++m) { const f32x2 st = *(const f32x2*)(stats + 2 * (rowb + ai * HALF + m * 16)); mu[ai][m] = st.x; rs[ai][m] = st.y; }
#pragma unroll
        for (int bj = 0; bj < 2; ++bj)
#pragma unroll
            for (int n = 0; n < 2; ++n) { const int c = col0 + bj * HALF + n * 16;
                f32x4 y[2][4];
#pragma unroll
                for (int ai = 0; ai < 2; ++ai)
#pragma unroll
                    for (int m = 0; m < 4; ++m) y[ai][m] = *(const f32x4*)(ysrc + (size_t)(rowb + ai * HALF + m * 16) * 1024 + c);
                const f32x4 gv = *(const f32x4*)(g + c), bv = *(const f32x4*)(b + c);
#pragma unroll
                for (int ai = 0; ai < 2; ++ai)
#pragma unroll
                    for (int m = 0; m < 4; ++m) { const f32x4 o = (((y[ai][m] - mu[ai][m]) * rs[ai][m]) * gv + bv) * alpha + acc[ai][bj][m][n];
                        *(f32x4*)(ydst + (size_t)(rowb + ai * HALF + m * 16) * 1024 + c) = o; }
                asm volatile("" ::: "memory"); }
    }
};
struct EpiGate {
    static constexpr bool PERM = true, AFTER_DRAIN = false;
    bf16_t* G; float* halo; const float* cw; const float* cb;
    static __device__ __forceinline__ float ror1(float v) { return __builtin_bit_cast(float, __builtin_amdgcn_mov_dpp(__builtin_bit_cast(int, v), 0x121, 0xf, 0xf, false)); }
    static __device__ __forceinline__ float ror2(float v) { return __builtin_bit_cast(float, __builtin_amdgcn_mov_dpp(__builtin_bit_cast(int, v), 0x122, 0xf, 0xf, false)); }
    static __device__ __forceinline__ f32x4 ror1v(f32x4 v) { return (f32x4){ror1(v[0]), ror1(v[1]), ror1(v[2]), ror1(v[3])}; }
    static __device__ __forceinline__ f32x4 ror2v(f32x4 v) { return (f32x4){ror2(v[0]), ror2(v[1]), ror2(v[2]), ror2(v[3])}; }
    __device__ __forceinline__ void operator()(const f32x4 (&acc)[2][2][4][2], const Unit& u, int wr, int wc, int fr, int fq) const {
        const int rowb = u.pm * BM + wr * 64 + fr;
#pragma unroll
        for (int n = 0; n < 2; ++n) {
            const int ch = u.pn * 128 + wc * 32 + 8 * fq + 4 * n;
            const f32x4 wa0 = *(const f32x4*)(cw + ch), wa1 = *(const f32x4*)(cw + 5632 + ch), wa2 = *(const f32x4*)(cw + 2 * 5632 + ch), ba = *(const f32x4*)(cb + ch);
            const f32x4 wu0 = *(const f32x4*)(cw + 2816 + ch), wu1 = *(const f32x4*)(cw + 5632 + 2816 + ch), wu2 = *(const f32x4*)(cw + 2 * 5632 + 2816 + ch), bu = *(const f32x4*)(cb + 2816 + ch);
#pragma unroll
            for (int ai = 0; ai < 2; ++ai) {
                f32x4 pa1 = (f32x4){0.f, 0.f, 0.f, 0.f}, pa2 = pa1, pu1 = pa1, pu2 = pa1;
#pragma unroll
                for (int m = 0; m < 4; ++m) {
                    const f32x4 a = acc[ai][0][m][n], uu = acc[ai][1][m][n];
                    const f32x4 ra1 = ror1v(a), ra2 = ror2v(a), ru1 = ror1v(uu), ru2 = ror2v(uu);
                    const f32x4 a1 = (fr >= 1) ? ra1 : pa1, a2 = (fr >= 2) ? ra2 : pa2, u1 = (fr >= 1) ? ru1 : pu1, u2 = (fr >= 2) ? ru2 : pu2;
                    const f32x4 ya = wa0 * a2 + wa1 * a1 + wa2 * a + ba, yu = wu0 * u2 + wu1 * u1 + wu2 * uu + bu;
                    const f32x2 g0 = gelu_pk((f32x2){ya[0], ya[1]}), g1 = gelu_pk((f32x2){ya[2], ya[3]});
                    const int row = rowb + ai * HALF + m * 16;
                    if (m > 0 || fr >= 2) { typedef unsigned u32x2 __attribute__((ext_vector_type(2)));
                        u32x2 w; w.x = cvt_pk_bf16(g0.x * yu[0], g0.y * yu[1]); w.y = cvt_pk_bf16(g1.x * yu[2], g1.y * yu[3]); *(u32x2*)(G + (size_t)row * 2816 + ch) = w; }
                    if (m == 0 && fr < 2) { float* hp = halo + ((size_t)(row >> 6) * 4 + fr) * 5632 + ch; *(f32x4*)hp = a; *(f32x4*)(hp + 2816) = uu; }
                    if (m == 3 && fr >= 14) { float* hp = halo + ((size_t)(row >> 6) * 4 + (fr - 12)) * 5632 + ch; *(f32x4*)hp = a; *(f32x4*)(hp + 2816) = uu; }
                    pa1 = ra1; pa2 = ra2; pu1 = ru1; pu2 = ru2;
                }
            }
        }
    }
};
template <class Epi, class Sched, bool ALIGN_EPI = false, bool SP2 = false>
__device__ __forceinline__ void gemm_phase(PG8_LAS unsigned char* lds, const Gemm g, const Sched& S, const Epi& E) {
    int tid_ = threadIdx.x; asm volatile("" : "+v"(tid_)); const int tid = tid_, wid = __builtin_amdgcn_readfirstlane(tid >> 6), lane = tid & 63, wr = wid >> 2, wc = wid & 3, fr = lane & 15, fq = lane >> 4;
    const int K = g.K, nt = K / BK;
    unsigned voffA[2], voffB[2];
#pragma unroll
    for (int i = 0; i < 2; ++i) { int R, C; stage_rc(tid * 16 + i * 8192, R, C); const int Rb = Epi::PERM ? ((R & ~31) + perm32(R & 31)) : R;
        voffA[i] = (unsigned)(R * K + C) * 2u; voffB[i] = (unsigned)(Rb * K + C) * 2u; }
    const size_t kstep = (size_t)(BK * 2);
    const size_t hstep = (size_t)HALF * K * 2;
    const size_t tstep = 2 * hstep;
    const unsigned ldsw = (unsigned)wid * 1024u;
    const int aoff = lds_byte(wr * 64 + fr, fq * 8), boff = lds_byte(wc * 32 + fr, fq * 8);
#define PG8_SA(b, h) (((b) * 2 + (h)) * HTB)
#define PG8_SB(b, h) ((4 + (b) * 2 + (h)) * HTB)
#define PG8_STAGE(bufoff, gbase, voff) do { _Pragma("unroll") for (int _i = 0; _i < 2; ++_i) \
        __builtin_amdgcn_global_load_lds((const unsigned*)((const char*)(gbase) + (voff)[_i]), (PG8_LAS unsigned*)(lds + (bufoff) + ldsw + _i * 8192), 16, 0, 0); } while (0)
#define PG8_LDA(dst, b, h) do { _Pragma("unroll") for (int m = 0; m < 4; ++m) _Pragma("unroll") for (int k = 0; k < 2; ++k) dst[m][k] = *(const PG8_LAS bf16x8*)(lds + PG8_SA(b, h) + aoff + m * 2048 + k * 1024); } while (0)
#define PG8_LDB(dst, b, h) do { _Pragma("unroll") for (int n = 0; n < 2; ++n) _Pragma("unroll") for (int k = 0; k < 2; ++k) dst[n][k] = *(const PG8_LAS bf16x8*)(lds + PG8_SB(b, h) + boff + n * 2048 + k * 1024); } while (0)
#define PG8_MMA(ai, bj, At, Bt) do { __builtin_amdgcn_s_setprio(1); _Pragma("unroll") for (int m = 0; m < 4; ++m) _Pragma("unroll") for (int n = 0; n < 2; ++n) _Pragma("unroll") for (int k = 0; k < 2; ++k) \
        acc[ai][bj][m][n] = __builtin_amdgcn_mfma_f32_16x16x32_bf16(Bt[n][k], At[m][k], acc[ai][bj][m][n], 0, 0, 0); __builtin_amdgcn_s_setprio(0); } while (0)
#define PG8_WAIT_V(n) asm volatile("s_waitcnt vmcnt(" #n ")" ::: "memory")
#define PG8_WAIT_L(n) asm volatile("s_waitcnt lgkmcnt(" #n ")" ::: "memory")
#define PG8_BAR __builtin_amdgcn_s_barrier()
#define PG8_SCHED __builtin_amdgcn_sched_barrier(0)
    Unit cur, nxt; int ui = 0;
    if (!S.next(0, cur)) return;
    f32x4 acc[2][2][4][2];
#pragma unroll
    for (int a = 0; a < 2; ++a)
#pragma unroll
        for (int b = 0; b < 2; ++b)
#pragma unroll
            for (int m = 0; m < 4; ++m)
#pragma unroll
                for (int n = 0; n < 2; ++n) acc[a][b][m][n] = (f32x4){0.f, 0.f, 0.f, 0.f};
    bf16x8 At[4][2], B0[2][2], B1[2][2];
    const char* cA = (const char*)g.A + (size_t)cur.pm * tstep; const char* cB = (const char*)g.Bt + (size_t)cur.pn * tstep;
    S.a_ready(cur);
    if constexpr (SP2) {
        PG8_STAGE(PG8_SB(0, 0), cB, voffB); PG8_STAGE(PG8_SB(0, 1), cB + hstep, voffB); PG8_STAGE(PG8_SA(0, 0), cA, voffA); PG8_STAGE(PG8_SA(0, 1), cA + hstep, voffA);
        if (wr == 1) PG8_BAR;
        PG8_WAIT_V(2); PG8_BAR;
        PG8_STAGE(PG8_SB(1, 0), cB + kstep, voffB); PG8_STAGE(PG8_SA(1, 0), cA + kstep, voffA); PG8_STAGE(PG8_SB(1, 1), cB + hstep + kstep, voffB);
        PG8_WAIT_V(6); PG8_BAR;
    } else {
        PG8_STAGE(PG8_SB(0, 0), cB, voffB); PG8_STAGE(PG8_SA(0, 0), cA, voffA); PG8_STAGE(PG8_SB(0, 1), cB + hstep, voffB); PG8_STAGE(PG8_SA(0, 1), cA + hstep, voffA);
        if (wr == 1) PG8_BAR;
        PG8_WAIT_V(4); PG8_BAR;
        PG8_STAGE(PG8_SB(1, 0), cB + kstep, voffB); PG8_STAGE(PG8_SA(1, 0), cA + kstep, voffA); PG8_STAGE(PG8_SB(1, 1), cB + hstep + kstep, voffB);
        PG8_WAIT_V(6); PG8_BAR;
    }
    for (;;) {
        const bool has_next = S.next(ui + 1, nxt);
        const char* nA = has_next ? (const char*)g.A + (size_t)nxt.pm * tstep : cA; const char* nB = has_next ? (const char*)g.Bt + (size_t)nxt.pn * tstep : cB;
        for (int t = 0; t < nt; t += 2) {
            const bool last = (t == nt - 2);
            const char* a1 = cA + (size_t)(t + 1) * kstep;
            const char* a2 = last ? nA : cA + (size_t)(t + 2) * kstep; const char* b2 = last ? nB : cB + (size_t)(t + 2) * kstep;
            const char* a3 = a2 + kstep; const char* b3 = b2 + kstep;
            if (last && has_next) S.a_ready(nxt);
            if constexpr (SP2) {
            PG8_LDB(B0, 0, 0); PG8_LDB(B1, 0, 1); PG8_SCHED; PG8_LDA(At, 0, 0); PG8_STAGE(PG8_SA(1, 1), a1 + hstep, voffA);
            PG8_WAIT_V(8); PG8_WAIT_L(0); PG8_BAR; PG8_MMA(0, 0, At, B0); PG8_MMA(0, 1, At, B1); PG8_BAR; PG8_SCHED;
            PG8_LDA(At, 0, 1); PG8_STAGE(PG8_SB(0, 0), b2, voffB); PG8_STAGE(PG8_SB(0, 1), b2 + hstep, voffB); PG8_STAGE(PG8_SA(0, 0), a2, voffA);
            PG8_WAIT_V(8); PG8_WAIT_L(0); PG8_BAR; PG8_MMA(1, 0, At, B0); PG8_MMA(1, 1, At, B1); PG8_BAR; PG8_SCHED;
            PG8_LDB(B0, 1, 0); PG8_LDB(B1, 1, 1); PG8_SCHED; PG8_LDA(At, 1, 0); PG8_STAGE(PG8_SA(0, 1), a2 + hstep, voffA);
            PG8_WAIT_V(8); PG8_WAIT_L(0); PG8_BAR; PG8_MMA(0, 0, At, B0); PG8_MMA(0, 1, At, B1); PG8_BAR; PG8_SCHED;
            PG8_LDA(At, 1, 1); PG8_STAGE(PG8_SB(1, 0), b3, voffB); PG8_STAGE(PG8_SB(1, 1), b3 + hstep, voffB); PG8_STAGE(PG8_SA(1, 0), a3, voffA);
            PG8_WAIT_V(8); PG8_WAIT_L(0); PG8_BAR; PG8_MMA(1, 0, At, B0); PG8_MMA(1, 1, At, B1); PG8_BAR; PG8_SCHED;
            } else {
            PG8_LDB(B0, 0, 0); PG8_SCHED; PG8_LDA(At, 0, 0); PG8_STAGE(PG8_SA(1, 1), a1 + hstep, voffA);
            PG8_WAIT_L(8); PG8_BAR; PG8_WAIT_L(0); PG8_MMA(0, 0, At, B0); PG8_BAR; PG8_SCHED;
            PG8_LDB(B1, 0, 1); PG8_STAGE(PG8_SB(0, 0), b2, voffB);
            PG8_BAR; PG8_WAIT_L(0); PG8_MMA(0, 1, At, B1); PG8_BAR;
            PG8_LDA(At, 0, 1); PG8_STAGE(PG8_SA(0, 0), a2, voffA);
            PG8_BAR; PG8_WAIT_L(0); PG8_MMA(1, 0, At, B0); PG8_BAR; PG8_SCHED;
            PG8_STAGE(PG8_SB(0, 1), b2 + hstep, voffB);
            PG8_WAIT_V(6); PG8_BAR; PG8_MMA(1, 1, At, B1); PG8_BAR;
            PG8_LDB(B0, 1, 0); PG8_SCHED; PG8_LDA(At, 1, 0); PG8_STAGE(PG8_SA(0, 1), a2 + hstep, voffA);
            PG8_WAIT_L(8); PG8_BAR; PG8_WAIT_L(0); PG8_MMA(0, 0, At, B0); PG8_BAR; PG8_SCHED;
            PG8_LDB(B1, 1, 1); PG8_STAGE(PG8_SB(1, 0), b3, voffB);
            PG8_BAR; PG8_WAIT_L(0); PG8_MMA(0, 1, At, B1); PG8_BAR;
            PG8_LDA(At, 1, 1); PG8_STAGE(PG8_SA(1, 0), a3, voffA);
            PG8_BAR; PG8_WAIT_L(0); PG8_MMA(1, 0, At, B0); PG8_BAR; PG8_SCHED;
            PG8_STAGE(PG8_SB(1, 1), b3 + hstep, voffB);
            PG8_WAIT_V(6); PG8_BAR; PG8_MMA(1, 1, At, B1); PG8_BAR;
            }
        }
        if constexpr (ALIGN_EPI) { if (wr == 0) PG8_BAR; }
        if constexpr (!Epi::AFTER_DRAIN) { E(acc, cur, wr, wc, fr, fq); S.done(cur); }
        if (!has_next) break;
#pragma unroll
        for (int a = 0; a < 2; ++a)
#pragma unroll
            for (int b = 0; b < 2; ++b)
#pragma unroll
                for (int m = 0; m < 4; ++m)
#pragma unroll
                    for (int n = 0; n < 2; ++n) acc[a][b][m][n] = (f32x4){0.f, 0.f, 0.f, 0.f};
        cur = nxt; cA = nA; cB = nB; ++ui;
        if constexpr (ALIGN_EPI) { if (wr == 1) PG8_BAR; }
    }
    PG8_WAIT_V(0);
    if constexpr (!ALIGN_EPI) { if (wr == 0) PG8_BAR; }
    PG8_BAR;
    if constexpr (Epi::AFTER_DRAIN) { E.fused(acc, cur, wr, wc, fr, fq, lds, wid, lane); S.done(cur); }
#undef PG8_SA
#undef PG8_SB
#undef PG8_STAGE
#undef PG8_LDA
#undef PG8_LDB
#undef PG8_MMA
#undef PG8_WAIT_V
#undef PG8_WAIT_L
#undef PG8_BAR
#undef PG8_SCHED
}
}
namespace attn_body {
using bf16=__hip_bfloat16;
using bf16x8=__attribute__((ext_vector_type(8)))short;
using s16x4=__attribute__((ext_vector_type(4)))short;
using f32x16=__attribute__((ext_vector_type(16)))float;
using u32x4=__attribute__((ext_vector_type(4)))unsigned;
constexpr int BATCH=4,NHEAD=8,SEQ=8192,D=64,DM=NHEAD*D,OPITCH=1024;
constexpr int NW=8,QBLK=32,QB=QBLK*NW,KVBLK=64,NQB=SEQ/QB;
constexpr int ATTN_PITCH=DM, ATTN_UNIT_ROWS=QB;
__device__ __forceinline__ int crow(int r,int hi){return (r&3)+8*(r>>2)+4*hi;}
#define SBAR() __builtin_amdgcn_sched_barrier(0)
__device__ __forceinline__ void cmask(f32x16&p0,f32x16&p1,int jb,int qrel,int hi){
  const float NEG=-INFINITY; int kb=64*jb+4*hi;
  #pragma unroll
  for(int r=0;r<16;++r){int kv=kb+(r&3)+8*(r>>2); if(kv>qrel)p0[r]=NEG; if(kv+32>qrel)p1[r]=NEG;}
}

constexpr int NSLOT=3, SLOTB=8192;
constexpr int LDS_K=0, LDS_V=NSLOT*SLOTB, LDS_WS=2*NSLOT*SLOTB, LDS_OST=LDS_WS+NW*64*4, LDS_CK=LDS_OST+NW*4096, LDS_BYTES=LDS_CK+SEQ*4;
constexpr float C2=0.125f*1.4426950408889634f;
__device__ __forceinline__ void glds16(const void*gsrc,unsigned lds_dst){unsigned keep;
  asm volatile("s_mov_b32 %0, m0\n\ts_mov_b32 m0, %2\n\ts_nop 0\n\tglobal_load_lds_dwordx4 %1, off\n\ts_mov_b32 m0, %0":"=&s"(keep):"v"(gsrc),"s"(lds_dst):"memory");}
__device__ __forceinline__ float max3f(float a,float b,float c){float r;asm("v_max3_f32 %0, %1, %2, %3":"=v"(r):"v"(a),"v"(b),"v"(c));return r;}
__device__ __forceinline__ float max2f(float a,float b){float r;asm("v_max_f32_e32 %0, %1, %2":"=v"(r):"v"(a),"v"(b));return r;}
__device__ __forceinline__ float fadd_s(float a,float b){float r;asm("v_add_f32_e32 %0, %1, %2":"=v"(r):"v"(a),"v"(b));return r;}
__device__ __forceinline__ float fsub_s(float a,float b){float r;asm("v_sub_f32_e32 %0, %1, %2":"=v"(r):"v"(a),"v"(b));return r;}
typedef float f32x2_t __attribute__((ext_vector_type(2))); typedef __bf16 bf16x2_t __attribute__((ext_vector_type(2)));
__device__ __forceinline__ unsigned cvtpk_s(float lo,float hi){f32x2_t v={lo,hi};bf16x2_t b=__builtin_convertvector(v,bf16x2_t);return __builtin_bit_cast(unsigned,b);}
#define WAIT_BAR(N) asm volatile("s_waitcnt vmcnt(" #N ") lgkmcnt(0)\n\ts_barrier":::"memory")

__device__ __forceinline__ void qkt(f32x16&p0,f32x16&p1,const char*Kslot,const bf16x8*qr,const f32x16&negm,int r32,int hi){
  const char*kb=Kslot+hi*1024+r32*16;
  #pragma unroll
  for(int d0=0;d0<4;++d0){
    const bf16x8 b0=*reinterpret_cast<const bf16x8*>(kb+d0*2048);
    const bf16x8 b1=*reinterpret_cast<const bf16x8*>(kb+d0*2048+512);
    if(d0==0){p0=__builtin_amdgcn_mfma_f32_32x32x16_bf16(b0,qr[0],negm,0,0,0);p1=__builtin_amdgcn_mfma_f32_32x32x16_bf16(b1,qr[0],negm,0,0,0);}
    else{p0=__builtin_amdgcn_mfma_f32_32x32x16_bf16(b0,qr[d0],p0,0,0,0);p1=__builtin_amdgcn_mfma_f32_32x32x16_bf16(b1,qr[d0],p1,0,0,0);}}
}
typedef __attribute__((address_space(3))) const char* lds_cptr;
typedef short v4i16_t __attribute__((ext_vector_type(4)));
__device__ __forceinline__ void kload8(bf16x8*kf,lds_cptr kp){
  kf[0]=*(const __attribute__((address_space(3))) bf16x8*)(kp);      kf[1]=*(const __attribute__((address_space(3))) bf16x8*)(kp+512);
  kf[2]=*(const __attribute__((address_space(3))) bf16x8*)(kp+2048); kf[3]=*(const __attribute__((address_space(3))) bf16x8*)(kp+2560);
  kf[4]=*(const __attribute__((address_space(3))) bf16x8*)(kp+4096); kf[5]=*(const __attribute__((address_space(3))) bf16x8*)(kp+4608);
  kf[6]=*(const __attribute__((address_space(3))) bf16x8*)(kp+6144); kf[7]=*(const __attribute__((address_space(3))) bf16x8*)(kp+6656);
}
__device__ __forceinline__ void kload2(bf16x8*kf,lds_cptr kp,int j){ kf[2*j]=*(const __attribute__((address_space(3))) bf16x8*)(kp+j*2048); kf[2*j+1]=*(const __attribute__((address_space(3))) bf16x8*)(kp+j*2048+512); }
__device__ __forceinline__ s16x4 vtr(lds_cptr p){ return __builtin_bit_cast(s16x4,__builtin_amdgcn_ds_read_tr16_b64_v4i16((__attribute__((address_space(3))) v4i16_t*)p)); }
__device__ __forceinline__ float rowmax(const f32x16&p0,const f32x16&p1){
  float a=max3f(p0[0],p0[1],p1[0]),b=max3f(p0[2],p0[3],p1[1]);a=max3f(a,p1[2],p1[3]);
  #pragma unroll
  for(int r=4;r<16;r+=4){a=max3f(a,p0[r],p0[r+1]);b=max3f(b,p0[r+2],p0[r+3]);a=max3f(a,p1[r],p1[r+1]);b=max3f(b,p1[r+2],p1[r+3]);}
  const float m=max2f(a,b);
  auto rr=__builtin_amdgcn_permlane32_swap(__float_as_uint(m),__float_as_uint(m),false,false);
  return max2f(__uint_as_float(rr[0]),__uint_as_float(rr[1]));
}
__device__ __forceinline__ void pv(f32x16*o,int vb,bf16x8 pa0,bf16x8 pa1,bf16x8 pa2,bf16x8 pa3){
  #pragma unroll
  for(int d0=0;d0<2;++d0){s16x4 lo[4],hi[4];
    #pragma unroll
    for(int ks=0;ks<4;++ks){
      asm volatile("ds_read_b64_tr_b16 %0,%1 offset:%c2":"=&v"(lo[ks]):"v"(vb),"i"(d0*4096+ks*1024):"memory");
      asm volatile("ds_read_b64_tr_b16 %0,%1 offset:%c2":"=&v"(hi[ks]):"v"(vb),"i"(d0*4096+ks*1024+512):"memory");}
    asm volatile("s_waitcnt lgkmcnt(0)":::"memory");SBAR();
    #define PK(k) (bf16x8){lo[k][0],lo[k][1],lo[k][2],lo[k][3],hi[k][0],hi[k][1],hi[k][2],hi[k][3]}
    o[d0]=__builtin_amdgcn_mfma_f32_32x32x16_bf16(pa0,PK(0),o[d0],0,0,0);
    o[d0]=__builtin_amdgcn_mfma_f32_32x32x16_bf16(pa1,PK(1),o[d0],0,0,0);
    o[d0]=__builtin_amdgcn_mfma_f32_32x32x16_bf16(pa2,PK(2),o[d0],0,0,0);
    o[d0]=__builtin_amdgcn_mfma_f32_32x32x16_bf16(pa3,PK(3),o[d0],0,0,0);
    #undef PK
  }
}

#ifndef ATTN_STORE16
#define ATTN_STORE16(p,v) (*(u32x4*)(p)=(v))
#endif
template<int THRL> __device__ __forceinline__ void attn_unit(int b,int h,int qb,const bf16*Q,const bf16*__restrict__ K,const bf16*__restrict__ V,bf16*O,const float*__restrict__ c2,const float*__restrict__ gnorm,int ts,char*shm){
  int tid_=threadIdx.x; asm volatile("":"+v"(tid_)); const int tid=tid_,lane=tid&63,r32=lane&31,hi=lane>>5; const int wid=__builtin_amdgcn_readfirstlane(tid>>6);
  const long rowbase=(long)b*SEQ; const int q0=qb*QB;
  const bf16*Qw=Q+(rowbase+q0+wid*QBLK)*DM+h*D;
  const bf16*Kh=K+(rowbase+(long)ts*KVBLK)*DM+h*D,*Vh=V+(rowbase+(long)ts*KVBLK)*DM+h*D;
  const unsigned lds0=(unsigned)(uintptr_t)shm;
  float*wsf=(float*)(shm+LDS_WS)+wid*64;
  const bf16*ksrc=Kh+(long)lane*DM+wid*8;
  const bf16*vsrc=Vh+(long)(16*(wid&3)+(lane>>2))*DM+(wid>>2)*32+(lane&3)*8;
  const unsigned kdst=lds0+LDS_K+wid*1024, vdst=lds0+LDS_V+wid*1024;
  #define DMA_K(t,slot) glds16(ksrc+(long)(t)*KVBLK*DM,(unsigned)__builtin_amdgcn_readfirstlane(kdst+(slot)))
  #define DMA_V(t,slot) glds16(vsrc+(long)(t)*KVBLK*DM,(unsigned)__builtin_amdgcn_readfirstlane(vdst+(slot)))
  const int vb0=(int)(lds0+LDS_V)+((lane>>4)&1)*32+(lane&3)*8+(4*hi+((lane&15)>>2))*64;
  const char*Kbase=shm+LDS_K; bf16x8 kf[8];
  const lds_cptr shm3=(lds_cptr)shm; const lds_cptr kp0=shm3+LDS_K+hi*1024+r32*16; const lds_cptr vp0=shm3+LDS_V+((lane>>4)&1)*32+(lane&3)*8+(4*hi+((lane&15)>>2))*64;
  const int NT=(q0+QB)/KVBLK-ts;
  DMA_K(0,0);DMA_V(0,0);DMA_K(1,SLOTB);
  bf16x8 qr[4];
  #pragma unroll
  for(int d0=0;d0<4;++d0)qr[d0]=*reinterpret_cast<const bf16x8*>(&Qw[(long)r32*DM+d0*16+hi*8]);
  float mhat=0.f,l_reg=0.f;f32x16 o[2];o[0]=f32x16{};o[1]=f32x16{};f32x16 negm=f32x16{};asm volatile("":"+v"(negm));
  const int qrel=wid*QBLK+r32;
  #define CMASK(P0,P1,t) do{int jb_=(t)-(NT-4); if(jb_>=0)cmask(P0,P1,jb_,qrel,hi);}while(0)
  bool resc=false;
  #define START(P0,P1) do{ const float rm=*(const __attribute__((address_space(3))) float*)(shm3+LDS_CK+4*(q0-ts*KVBLK+wid*QBLK+r32)); resc=false; \
    { const float dl=rm; mhat=fadd_s(mhat,dl); \
      _Pragma("unroll") for(int r=0;r<16;++r){P0[r]=fsub_s(P0[r],dl);P1[r]=fsub_s(P1[r],dl);} \
      _Pragma("unroll") for(int r=0;r<16;++r)negm[r]=-mhat; asm volatile("":"+v"(negm)); } \
    _Pragma("unroll") for(int r=0;r<16;++r)P0[r]=__builtin_amdgcn_exp2f(P0[r]); }while(0)
  #define RESC() do{ if(resc){ asm volatile("s_waitcnt lgkmcnt(0)":::"memory"); \
      _Pragma("unroll") for(int d_=0;d_<2;++d_) _Pragma("unroll") for(int r=0;r<16;++r)o[d_][r]*=wsf[crow(r,hi)]; } }while(0)
  f32x16 pA0,pA1,pB0,pB1;
  int sl_prev=0,sl_cur=0,sl_next=SLOTB;
  #define ROT() do{sl_prev=sl_cur;sl_cur=sl_next;sl_next=(sl_next==(NSLOT-1)*SLOTB)?0:sl_next+SLOTB;}while(0)
  { typedef float f32x4v __attribute__((ext_vector_type(4)));
    const float*cb=c2+((long)(b*NHEAD+h))*SEQ; const float cref=cb[q0+QB-1];
    for(int i=tid;i<(q0+QB)/4-ts*16;i+=NW*64){ const f32x4v v=*(const f32x4v*)(cb+ts*64+4*i); *(__attribute__((address_space(3))) f32x4v*)((lds_cptr)shm+LDS_CK+16*i)=(f32x4v){cref-v[0],cref-v[1],cref-v[2],cref-v[3]}; } }
  DMA_K(2,2*SLOTB);
  WAIT_BAR(3);
  typedef float f32x4w __attribute__((ext_vector_type(4)));
  #define CKADD(P0,P1,t) do{ const __attribute__((address_space(3))) f32x4w*cp_=(const __attribute__((address_space(3))) f32x4w*)(shm3+LDS_CK)+(t)*16+hi; \
    { SBAR(); const f32x4w a0_=cp_[0],a1_=cp_[2],a2_=cp_[4],a3_=cp_[6]; \
      P0[0]+=a0_[0];P0[1]+=a0_[1];P0[2]+=a0_[2];P0[3]+=a0_[3]; P0[4]+=a1_[0];P0[5]+=a1_[1];P0[6]+=a1_[2];P0[7]+=a1_[3]; \
      P0[8]+=a2_[0];P0[9]+=a2_[1];P0[10]+=a2_[2];P0[11]+=a2_[3]; P0[12]+=a3_[0];P0[13]+=a3_[1];P0[14]+=a3_[2];P0[15]+=a3_[3]; } \
    { SBAR(); const f32x4w b0_=cp_[8],b1_=cp_[10],b2_=cp_[12],b3_=cp_[14]; \
      P1[0]+=b0_[0];P1[1]+=b0_[1];P1[2]+=b0_[2];P1[3]+=b0_[3]; P1[4]+=b1_[0];P1[5]+=b1_[1];P1[6]+=b1_[2];P1[7]+=b1_[3]; \
      P1[8]+=b2_[0];P1[9]+=b2_[1];P1[10]+=b2_[2];P1[11]+=b2_[3]; P1[12]+=b3_[0];P1[13]+=b3_[1];P1[14]+=b3_[2];P1[15]+=b3_[3]; } }while(0)
  qkt(pA0,pA1,Kbase,qr,negm,r32,hi);asm volatile("s_nop 15\n\ts_nop 7":"+v"(pA0),"+v"(pA1));CKADD(pA0,pA1,0);CMASK(pA0,pA1,0);
  START(pA0,pA1);
  _Pragma("unroll") for(int r=0;r<16;++r)pA1[r]=__builtin_amdgcn_exp2f(pA1[r]);
  WAIT_BAR(0);
  DMA_K(3,0);DMA_V(1,SLOTB);
  ROT();
  kload8(kf,kp0+sl_cur);
  WAIT_BAR(2);
  s16x4 vlo[8],vhi[8]; u32x4 pw0,pw1,pw2,pw3;
  #define PKW(P,B) cvtpk_s(P[B],P[B+1])
  #define PAF(k) __builtin_bit_cast(bf16x8,pw##k)
  #define VFR(i) (bf16x8){vlo[i][0],vlo[i][1],vlo[i][2],vlo[i][3],vhi[i][0],vhi[i][1],vhi[i][2],vhi[i][3]}
  #define PIN(x) asm volatile("":"+v"(x))
  #define MX3(a,b,c) __builtin_fmaxf(__builtin_fmaxf((a),(b)),(c))
  #define GAPA(MF,A0,A1,A2,A3,W0,W1,PW) do{ MF; sacc+=A0; sacc+=A1; sacc+=A2; sacc+=A3; PIN(sacc); W0; W1; PIN(PW); SBAR(); }while(0)
  #define EX(v) __builtin_amdgcn_exp2f(v)
  #define GAPB(MF,X,B) do{ MF; X[B]=EX(X[B]); X[B+1]=EX(X[B+1]); X[B+2]=EX(X[B+2]); X[B+3]=EX(X[B+3]); PIN(X); SBAR(); }while(0)
  #define VRD(i) do{ vlo[i]=vtr(vp_+(((i)>>2)*4096+((i)&3)*1024)); vhi[i]=vtr(vp_+(((i)>>2)*4096+((i)&3)*1024+512)); }while(0)
  #define KRD(G,j) do{ if(G){ kload2(kf,kp0+sl_next,j); SBAR(); } }while(0)
  #define STEP(C0,C1,P0,P1,t,GK,GV,GL) do{ SBAR(); \
    const lds_cptr vp_=vp0+sl_prev; \
    VRD(0); SBAR(); float sacc=(P0[0]+P0[1]); \
    GAPA(C0=__builtin_amdgcn_mfma_f32_32x32x16_bf16(kf[0],qr[0],negm,0,0,0), P0[2],P0[3],P0[4],P0[5],     pw0[0]=PKW(P0,0), pw0[1]=PKW(P0,2), pw0); \
    VRD(4); SBAR(); GAPA(C1=__builtin_amdgcn_mfma_f32_32x32x16_bf16(kf[1],qr[0],negm,0,0,0), P0[6],P0[7],P0[8],P0[9],     pw0[2]=PKW(P0,4), pw0[3]=PKW(P0,6), pw0); \
    VRD(1); SBAR(); GAPA(C0=__builtin_amdgcn_mfma_f32_32x32x16_bf16(kf[2],qr[1],C0,0,0,0),   P0[10],P0[11],P0[12],P0[13], pw1[0]=PKW(P0,8), pw1[1]=PKW(P0,10), pw1); \
    VRD(5); SBAR(); GAPA(C1=__builtin_amdgcn_mfma_f32_32x32x16_bf16(kf[3],qr[1],C1,0,0,0),   P0[14],P0[15],P1[0],P1[1],   pw1[2]=PKW(P0,12),pw1[3]=PKW(P0,14), pw1); \
    VRD(2); SBAR(); GAPA(C0=__builtin_amdgcn_mfma_f32_32x32x16_bf16(kf[4],qr[2],C0,0,0,0),   P1[2],P1[3],P1[4],P1[5],     pw2[0]=PKW(P1,0), pw2[1]=PKW(P1,2), pw2); \
    VRD(6); SBAR(); GAPA(C1=__builtin_amdgcn_mfma_f32_32x32x16_bf16(kf[5],qr[2],C1,0,0,0),   P1[6],P1[7],P1[8],P1[9],     pw2[2]=PKW(P1,4), pw2[3]=PKW(P1,6), pw2); \
    VRD(3); SBAR(); GAPA(C0=__builtin_amdgcn_mfma_f32_32x32x16_bf16(kf[6],qr[3],C0,0,0,0),   P1[10],P1[11],P1[12],P1[13], pw3[0]=PKW(P1,8), pw3[1]=PKW(P1,10), pw3); \
    VRD(7); SBAR(); GAPA(C1=__builtin_amdgcn_mfma_f32_32x32x16_bf16(kf[7],qr[3],C1,0,0,0),   P1[14],P1[15],0.f,0.f,       pw3[2]=PKW(P1,12),pw3[3]=PKW(P1,14), pw3); \
    l_reg+=sacc; \
    if(GK){DMA_K((t)+3,sl_cur);} if(GV){DMA_V((t)+1,sl_next);} \
    CKADD(C0,C1,t); CMASK(C0,C1,t); \
    { float a=MX3(C0[0],C0[1],C1[0]),b=MX3(C0[2],C0[3],C1[1]); a=MX3(a,C1[2],C1[3]); \
      _Pragma("unroll") for(int r=4;r<16;r+=4){a=MX3(a,C0[r],C0[r+1]);b=MX3(b,C0[r+2],C0[r+3]);a=MX3(a,C1[r],C1[r+1]);b=MX3(b,C1[r+2],C1[r+3]);} \
      float rm=__builtin_fmaxf(a,b); { auto rr=__builtin_amdgcn_permlane32_swap(__float_as_uint(rm),__float_as_uint(rm),false,false); rm=__builtin_fmaxf(__uint_as_float(rr[0]),__uint_as_float(rr[1])); } \
      resc=false; \
      if(__builtin_expect(__any(rm>(float)THRL),0)){ const float dl=__builtin_fmaxf(rm,0.f); mhat+=dl; \
        _Pragma("unroll") for(int r=0;r<16;++r){C0[r]-=dl;C1[r]-=dl;} \
        _Pragma("unroll") for(int r=0;r<16;++r)negm[r]=-mhat; asm volatile("":"+v"(negm)); \
        const float f=__builtin_amdgcn_exp2f(-dl); l_reg*=f; if(hi==0)wsf[r32]=f; resc=true; } } \
    SBAR(); \
    GAPB(o[0]=__builtin_amdgcn_mfma_f32_32x32x16_bf16(PAF(0),VFR(0),o[0],0,0,0), C0,0); \
    GAPB(o[1]=__builtin_amdgcn_mfma_f32_32x32x16_bf16(PAF(0),VFR(4),o[1],0,0,0), C0,4); \
    KRD(GL,0); GAPB(o[0]=__builtin_amdgcn_mfma_f32_32x32x16_bf16(PAF(1),VFR(1),o[0],0,0,0), C0,8); \
    KRD(GL,1); GAPB(o[1]=__builtin_amdgcn_mfma_f32_32x32x16_bf16(PAF(1),VFR(5),o[1],0,0,0), C0,12); \
    KRD(GL,2); GAPB(o[0]=__builtin_amdgcn_mfma_f32_32x32x16_bf16(PAF(2),VFR(2),o[0],0,0,0), C1,0); \
    KRD(GL,3); GAPB(o[1]=__builtin_amdgcn_mfma_f32_32x32x16_bf16(PAF(2),VFR(6),o[1],0,0,0), C1,4); \
    GAPB(o[0]=__builtin_amdgcn_mfma_f32_32x32x16_bf16(PAF(3),VFR(3),o[0],0,0,0), C1,8); \
    GAPB(o[1]=__builtin_amdgcn_mfma_f32_32x32x16_bf16(PAF(3),VFR(7),o[1],0,0,0), C1,12); \
    }while(0)
  int t=1;
  #undef CMASK
  #define CMASK(P0,P1,t) do{}while(0)
  for(;t+5<NT;t+=2){
    STEP(pB0,pB1,pA0,pA1,t,true,true,true);     WAIT_BAR(2); RESC(); ROT();
    STEP(pA0,pA1,pB0,pB1,t+1,true,true,true);   WAIT_BAR(2); RESC(); ROT();
  }
  #undef CMASK
  #define CMASK(P0,P1,t) do{int jb_=(t)-(NT-4); if(jb_>=0)cmask(P0,P1,jb_,qrel,hi);}while(0)
  #define ENDW(tt) do{ if((tt)+3<NT){WAIT_BAR(2);} else if((tt)+2<NT){WAIT_BAR(1);} else {WAIT_BAR(0);} }while(0)
  for(;t+1<NT;t+=2){
    STEP(pB0,pB1,pA0,pA1,t,(t+3<NT),(t+1<NT),(t+1<NT));       ENDW(t);   RESC(); ROT();
    STEP(pA0,pA1,pB0,pB1,t+1,(t+4<NT),(t+2<NT),(t+2<NT));     ENDW(t+1); RESC(); ROT();
  }
  STEP(pB0,pB1,pA0,pA1,NT-1,false,false,false); RESC();
  { float sacc=pB0[0]+pB0[1]; _Pragma("unroll") for(int r=2;r<16;++r)sacc+=pB0[r]; _Pragma("unroll") for(int r=0;r<16;++r)sacc+=pB1[r]; l_reg+=sacc;
    pw0=(u32x4){PKW(pB0,0),PKW(pB0,2),PKW(pB0,4),PKW(pB0,6)};pw1=(u32x4){PKW(pB0,8),PKW(pB0,10),PKW(pB0,12),PKW(pB0,14)};pw2=(u32x4){PKW(pB1,0),PKW(pB1,2),PKW(pB1,4),PKW(pB1,6)};pw3=(u32x4){PKW(pB1,8),PKW(pB1,10),PKW(pB1,12),PKW(pB1,14)};
    SBAR(); pv(o,vb0+sl_cur,PAF(0),PAF(1),PAF(2),PAF(3)); }
  #undef PKW
  #undef PAF
  #undef VFR
  #undef PIN
  #undef MX3
  #undef GAPA
  #undef GAPB
  #undef EX
  #undef VRD
  #undef KRD
  #undef STEP
  #undef ENDW
  {auto rr=__builtin_amdgcn_permlane32_swap(__float_as_uint(l_reg),__float_as_uint(l_reg),false,false);l_reg=__uint_as_float(rr[0])+__uint_as_float(rr[1]);}
  if(hi==0)wsf[32+r32]=l_reg;asm volatile("s_waitcnt lgkmcnt(0)":::"memory");
  float rli[16];
  #pragma unroll
  for(int r=0;r<16;++r)rli[r]=__builtin_amdgcn_rcpf(wsf[32+crow(r,hi)]);
  { const float g0=gnorm[h*D+r32],g1=gnorm[h*D+32+r32];
    #pragma unroll
    for(int r=0;r<16;++r){ const float x0=o[0][r]*rli[r],x1=o[1][r]*rli[r]; float s=x0*x0+x1*x1;
      s+=__shfl_xor(s,1);s+=__shfl_xor(s,2);s+=__shfl_xor(s,4);s+=__shfl_xor(s,8);s+=__shfl_xor(s,16);
      const float sc=1.0f/sqrtf(s*(1.0f/64.0f)+1e-6f); o[0][r]=x0*sc*g0; o[1][r]=x1*sc*g1; rli[r]=1.0f; } }
  bf16*Ow=O+(rowbase+q0+wid*QBLK)*OPITCH+h*D;
  { bf16*stg=(bf16*)(shm+LDS_OST)+wid*2048;
    #pragma unroll
    for(int r=0;r<16;++r){const int orow=crow(r,hi);
      #pragma unroll
      for(int d0=0;d0<2;++d0)stg[orow*64+d0*32+r32]=__float2bfloat16(o[d0][r]*rli[r]);}
    asm volatile("s_waitcnt lgkmcnt(0)":::"memory");
    #pragma unroll
    for(int i=0;i<4;++i){const int row=i*8+(lane>>3),ch=lane&7; const u32x4 v=*(const u32x4*)(stg+row*64+ch*8); ATTN_STORE16(Ow+(long)row*OPITCH+ch*8,v);} }
  asm volatile("s_waitcnt lgkmcnt(0)\n\ts_barrier":::"memory");
  #undef DMA_K
  #undef DMA_V
  #undef CMASK
  #undef CKADD
  #undef START
  #undef RESC
  #undef ROT
}
constexpr int ATTN_LDS_BYTES=LDS_BYTES;
#undef SBAR
#undef WAIT_BAR
}
constexpr int NWAVES = 8;
constexpr int BATCH = 4, SEQ = 8192, M = BATCH * SEQ, D = 1024, DFF = 2816, INC = 3592, NPROJ = 3584;
constexpr int NP1 = 1536, NP2 = 1280;
constexpr float LN_EPS = 1e-5f, RMS_EPS = 1e-6f;
constexpr float DN_ALPHA = 1.4142135623730951f;
constexpr float LOG2E = 1.4426950408889634f;
constexpr size_t MiB = 1u << 20;
constexpr size_t WS_CTL = 0, CTL_ZERO_BYTES = 49152;
constexpr int CW_BAR = 8192;
constexpr int CW_KMAX = 1024, CW_QMAX = 2048, CW_TS = 4096;
constexpr size_t WS_WFA = 1 * MiB;
constexpr size_t WS_STATS = 2 * MiB;
constexpr size_t WS_C2 = 4 * MiB;
constexpr size_t WS_LFA = 5 * MiB;
constexpr size_t WS_WIN = 8 * MiB, WS_WO = 22 * MiB, WS_WUP = 26 * MiB, WS_WDN = 48 * MiB;
constexpr size_t WS_XN = 60 * MiB;
constexpr size_t WS_SLOT0 = 124 * MiB;
constexpr size_t WS_MIX = 380 * MiB;
constexpr size_t WS_HALO = 124 * MiB;
constexpr size_t WS_SUB = 124 * MiB;
constexpr size_t WS_G = 316 * MiB;
constexpr size_t WS_HQS = 444 * MiB, WS_HOI = 476 * MiB, WS_HDL = 508 * MiB;
constexpr size_t WS_END = 512 * MiB;
static_assert(WS_G + (size_t)M * DFF * 2 <= WS_END && WS_HALO + (size_t)(M / 64) * 4 * 5632 * 4 <= WS_G && WS_MIX + (size_t)M * 1024 * 2 <= WS_END, "ws map");
constexpr int RING_BYTES = 131072, MISC_OFF = RING_BYTES + 320, LDS_BYTES = 147456;

#define GAS __attribute__((address_space(1)))
#define LAS __attribute__((address_space(3)))
typedef unsigned short bf16;
typedef unsigned v4u __attribute__((ext_vector_type(4)));
typedef float f32x4 __attribute__((ext_vector_type(4)));
typedef short bf16x8 __attribute__((ext_vector_type(8)));
typedef short bf16x4 __attribute__((ext_vector_type(4)));
#define LDS_WAIT() asm volatile("s_waitcnt lgkmcnt(0)" ::: "memory")
__device__ __forceinline__ unsigned f2bf(float f) { unsigned u = __builtin_bit_cast(unsigned, f); return (u + 0x7fffu + ((u >> 16) & 1u)) >> 16; }
__device__ __forceinline__ unsigned pk2(float lo, float hi) { return f2bf(lo) | (f2bf(hi) << 16); }
__device__ __forceinline__ float bf2f(unsigned short v) { return __uint_as_float((unsigned)v << 16); }
__device__ __forceinline__ float wave_sum(float v) {
#pragma unroll
    for (int o = 1; o < 64; o <<= 1) v += __shfl_xor(v, o);
    return v;
}
__device__ __forceinline__ void p0_transpose_item(const float* W, int ldw, int K, int N, bf16* WT, int row_off, LAS float* scr, int item, int lane) {
    const int nblk = N / 32, kb = item / nblk, nb = item % nblk, k0 = 64 * kb, n0 = 32 * nb;
#pragma unroll
    for (int i = 0; i < 8; ++i) { const int kk = 8 * i + (lane >> 3), c4 = (lane & 7) * 4; const f32x4 v = *(const f32x4*)(W + (size_t)(k0 + kk) * ldw + n0 + c4);
        scr[kk * 33 + c4] = v.x; scr[kk * 33 + c4 + 1] = v.y; scr[kk * 33 + c4 + 2] = v.z; scr[kk * 33 + c4 + 3] = v.w; }
    LDS_WAIT(); asm volatile("" ::: "memory");
    const int c = lane & 7;
#pragma unroll
    for (int j = 0; j < 4; ++j) { const int n = (lane >> 3) + 8 * j; const LAS float* s = scr + (8 * c) * 33 + n;
        v4u o; o.x = pk2(s[0 * 33], s[1 * 33]); o.y = pk2(s[2 * 33], s[3 * 33]); o.z = pk2(s[4 * 33], s[5 * 33]); o.w = pk2(s[6 * 33], s[7 * 33]);
        *(GAS v4u*)(WT + (size_t)(row_off + n0 + n) * K + k0 + 8 * c) = o; }
    LDS_WAIT(); asm volatile("" ::: "memory");
}

typedef GAS unsigned gu32;
#define RLX_AGENT __ATOMIC_RELAXED, __HIP_MEMORY_SCOPE_AGENT
#define XB_TMO      128
#define XB_XCNT(j)  (256  + 64 * (j))
#define XB_XSUB(j)  (1280 + 64 * (j))
#define XB_XGEN(j)  (2304 + 64 * (j))
#define XB_TOP      3328
#define XB_TOPGEN   3392
#define XCD_BAR_WORDS 3456
#define XB_SPIN_CAP (1u << 18)

__device__ __forceinline__ unsigned xb_ld(unsigned* p)              { return __hip_atomic_load(p, __ATOMIC_RELAXED, __HIP_MEMORY_SCOPE_AGENT); }
__device__ __forceinline__ unsigned xb_add(unsigned* p, unsigned v) { return __hip_atomic_fetch_add(p, v, __ATOMIC_RELAXED, __HIP_MEMORY_SCOPE_AGENT); }
__device__ __forceinline__ unsigned xb_xcc_id() { return (unsigned)__builtin_amdgcn_s_getreg((3 << 11) | 20) & 0xFu; }
#define XB_SPIN(cond, bar) do { unsigned _sp = 0; while (cond) { __builtin_amdgcn_s_sleep(1); \
    if ((++_sp & 255u) == 0u) { if (xb_ld(&(bar)[XB_TMO])) break; if (_sp > XB_SPIN_CAP) { atomicAdd(&(bar)[XB_TMO], 1u); break; } } } } while (0)

struct XcdBarrier {
    unsigned* bar; unsigned x;
    volatile LAS unsigned* st;
};

__device__ __forceinline__ XcdBarrier xcd_barrier_post(unsigned* bar, volatile LAS unsigned* st) {
    XcdBarrier b; b.bar = bar; b.x = xb_xcc_id(); b.st = st;
    if (threadIdx.x == 0) (void)xb_add(&bar[XB_XCNT(b.x)], 1u);
    return b;
}
__device__ __forceinline__ void xcd_barrier_complete(unsigned* bar, unsigned x, unsigned& nloc, unsigned& nx) {
    const unsigned G = gridDim.x * gridDim.y * gridDim.z;
    unsigned sum, cnt, mine, sp = 0u;
    for (;;) {
        sum = 0u; cnt = 0u; mine = 0u;
#pragma unroll
        for (unsigned j = 0; j < 16; ++j) { const unsigned c = xb_ld(&bar[XB_XCNT(j)]); sum += c; cnt += (c > 0u) ? 1u : 0u; mine = (j == x) ? c : mine; }
        if (sum == G) break;
        __builtin_amdgcn_s_sleep(1);
        if ((++sp & 255u) == 0u) { if (xb_ld(&bar[XB_TMO])) break; if (sp > XB_SPIN_CAP) { atomicAdd(&bar[XB_TMO], 1u); break; } }
    }
    nloc = mine > 0u ? mine : 1u; nx = cnt > 0u ? cnt : 1u;
}

__device__ __forceinline__ void xcd_barrier(const XcdBarrier& b) {
    asm volatile("s_waitcnt vmcnt(0)" ::: "memory");
    __syncthreads();
    if (threadIdx.x == 0) {
        unsigned* bar = b.bar; unsigned xq = b.x; asm volatile("" : "+s"(bar), "+s"(xq));
        __builtin_amdgcn_s_waitcnt(0);
        unsigned nloc = b.st[0], nx = b.st[1];
        if (nloc == 0u) { xcd_barrier_complete(bar, xq, nloc, nx); b.st[0] = nloc; b.st[1] = nx; }
        const unsigned old = xb_add(&bar[XB_XSUB(xq)], 1u);
        const unsigned gen = old / nloc;
        if (old + 1u == (gen + 1u) * nloc) {
            __builtin_amdgcn_fence(__ATOMIC_RELEASE, "agent");
            asm volatile("s_waitcnt vmcnt(0)" ::: "memory");
            const unsigned og = xb_add(&bar[XB_TOP], 1u);
            const unsigned tg = og / nx;
            if (og + 1u == (tg + 1u) * nx) xb_add(&bar[XB_TOPGEN], 1u);
            else XB_SPIN(xb_ld(&bar[XB_TOPGEN]) == tg, bar);
            __builtin_amdgcn_fence(__ATOMIC_ACQUIRE, "agent");
            xb_add(&bar[XB_XGEN(xq)], 1u);
            asm volatile("s_waitcnt vmcnt(0)" ::: "memory");
        } else {
            XB_SPIN(xb_ld(&bar[XB_XGEN(xq)]) == gen, bar);
            __builtin_amdgcn_fence(__ATOMIC_ACQUIRE, "agent");
            asm volatile("s_waitcnt vmcnt(0)" ::: "memory");
        }
    }
    __syncthreads();
}

struct Ptrs {
    const float *x, *ln_emb_g, *ln_emb_b, *w_in, *fox_f_bias, *fox_norm_g, *hlb, *hgrn_norm_g, *w_o, *ln_mix_g, *ln_mix_b, *w_up, *conv_w, *conv_b, *w_down, *ln_ffn_g, *ln_ffn_b;
    float* out; unsigned char* ws;
};

__device__ __forceinline__ void prologue_weights(const Ptrs& P, LAS unsigned char* lds, int gw, int NGW, int wave, int lane, int gtid, int nthr) {
    LAS float* scr = (LAS float*)(lds + wave * 16384);
    bf16* win = (bf16*)(P.ws + WS_WIN); bf16* wo = (bf16*)(P.ws + WS_WO); bf16* wup = (bf16*)(P.ws + WS_WUP); bf16* wdn = (bf16*)(P.ws + WS_WDN);
    constexpr int IT0 = 16 * 48, IT1 = 16 * 64, IT2 = 16 * 32, IT3 = 44 * 16 * 4, IT7 = 44 * 32;
    constexpr int PER_LAYER = IT0 + IT1 + IT2 + IT3 + IT7;
    for (int it = gw; it < 2 * PER_LAYER; it += NGW) {
        const int l = it / PER_LAYER; int r = it % PER_LAYER;
        const float* wi = P.w_in + (size_t)l * 1024 * INC; const float* wu = P.w_up + (size_t)l * 1024 * 2 * DFF;
        bf16* winl = win + (size_t)l * NPROJ * 1024; bf16* wupl = wup + (size_t)l * 2 * DFF * 1024;
        if (r < IT0) { p0_transpose_item(wi, INC, 1024, 1536, winl, 0, scr, r, lane); continue; } r -= IT0;
        if (r < IT1) { p0_transpose_item(wi + 1544, INC, 1024, 2048, winl, 1536, scr, r, lane); continue; } r -= IT1;
        if (r < IT2) { p0_transpose_item(P.w_o + (size_t)l * 1024 * 1024, 1024, 1024, 1024, wo + (size_t)l * 1024 * 1024, 0, scr, r, lane); continue; } r -= IT2;
        if (r < IT3) { const int sgm = r >> 6, ri = r & 63; p0_transpose_item(wu + ((sgm & 1) ? DFF : 0) + (sgm >> 1) * 128, 2 * DFF, 1024, 128, wupl, sgm * 128, scr, ri, lane); continue; } r -= IT3;
        p0_transpose_item(P.w_down + (size_t)l * DFF * 1024, 1024, DFF, 1024, wdn + (size_t)l * 1024 * DFF, 0, scr, r, lane);
    }
    float* wfa = (float*)(P.ws + WS_WFA);
    for (int i = gtid; i < 2 * 8 * 1024; i += nthr) { const int l = i >> 13, j = (i >> 10) & 7, k = i & 1023; wfa[i] = P.w_in[(size_t)l * 1024 * INC + (size_t)k * INC + 1536 + j]; }
}

__device__ __forceinline__ void ln_phase(const float* xsrc, const bf16* xsrcb, const bf16* add, float alpha, float* xdst, bf16* XN, const float* g, const float* bta, const float* wfa, int wfa_ld, const float* fbias, float* lfa,
                                         LAS float* wl, int gw, int NGW, int lane, int tid) {
    if (wfa && wfa_ld == 0) { for (int i = tid; i < 8 * 1024 / 4; i += NWAVES * 64) ((LAS f32x4*)wl)[i] = ((const f32x4*)wfa)[i]; __syncthreads(); }
    else if (wfa) {
        for (int k = tid; k < 1024; k += NWAVES * 64) { const f32x4 a = *(const f32x4*)(wfa + (size_t)k * wfa_ld), b = *(const f32x4*)(wfa + (size_t)k * wfa_ld + 4);
            wl[k] = a.x; wl[1024 + k] = a.y; wl[2048 + k] = a.z; wl[3072 + k] = a.w; wl[4096 + k] = b.x; wl[5120 + k] = b.y; wl[6144 + k] = b.z; wl[7168 + k] = b.w; }
        __syncthreads(); }
    f32x4 gv[4], bv[4];
#pragma unroll
    for (int j = 0; j < 4; ++j) { gv[j] = ((const f32x4*)g)[lane + 64 * j]; bv[j] = ((const f32x4*)bta)[lane + 64 * j]; }
    const float fb = (wfa && lane < 8) ? fbias[lane] : 0.f;
#pragma nounroll
    for (int m = gw; m < M; m += NGW) {
        f32x4 v[4]; float s = 0.f;
        if (xsrc) { const GAS f32x4* xr = (const GAS f32x4*)(xsrc + (size_t)m * D) + lane;
#pragma unroll
            for (int j = 0; j < 4; ++j) v[j] = xr[64 * j]; }
        else { const GAS unsigned long long* xr = (const GAS unsigned long long*)(xsrcb + (size_t)m * D) + lane;
#pragma unroll
            for (int j = 0; j < 4; ++j) { const unsigned long long a = xr[64 * j]; const unsigned lo = (unsigned)a, hi = (unsigned)(a >> 32);
                v[j] = (f32x4){__uint_as_float(lo << 16), __uint_as_float(lo & 0xffff0000u), __uint_as_float(hi << 16), __uint_as_float(hi & 0xffff0000u)}; } }
        if (add) { const GAS unsigned long long* ar = (const GAS unsigned long long*)(add + (size_t)m * D) + lane;
#pragma unroll
            for (int j = 0; j < 4; ++j) { const unsigned long long a = ar[64 * j]; const unsigned lo = (unsigned)a, hi = (unsigned)(a >> 32);
                v[j] = v[j] * alpha + (f32x4){__uint_as_float(lo << 16), __uint_as_float(lo & 0xffff0000u), __uint_as_float(hi << 16), __uint_as_float(hi & 0xffff0000u)}; } }
#pragma unroll
        for (int j = 0; j < 4; ++j) s += (v[j].x + v[j].y) + (v[j].z + v[j].w);
        const float mean = wave_sum(s) * (1.f / D); float s2 = 0.f;
#pragma unroll
        for (int j = 0; j < 4; ++j) { v[j] = v[j] - mean; s2 += (v[j].x * v[j].x + v[j].y * v[j].y) + (v[j].z * v[j].z + v[j].w * v[j].w); }
        const float rstd = 1.f / sqrtf(wave_sum(s2) * (1.f / D) + LN_EPS);
#pragma unroll
        for (int j = 0; j < 4; ++j) v[j] = (v[j] * rstd) * gv[j] + bv[j];
        if (XN) { GAS unsigned long long* o8 = (GAS unsigned long long*)(XN + (size_t)m * D) + lane;
#pragma unroll
            for (int j = 0; j < 4; ++j) o8[64 * j] = (unsigned long long)pk2(v[j].x, v[j].y) | ((unsigned long long)pk2(v[j].z, v[j].w) << 32); }
        if (xdst) { GAS f32x4* o = (GAS f32x4*)(xdst + (size_t)m * D) + lane;
#pragma unroll
            for (int j = 0; j < 4; ++j) o[64 * j] = v[j]; }
        if (wfa) { float mine = 0.f;
#pragma unroll
            for (int h = 0; h < 8; ++h) { float d = 0.f;
#pragma unroll
                for (int j = 0; j < 4; ++j) { const f32x4 w = ((const LAS f32x4*)wl)[h * 256 + lane + 64 * j]; d += (v[j].x * w.x + v[j].y * w.y) + (v[j].z * w.z + v[j].w * w.w); }
                d = wave_sum(d); if (lane == h) mine = d; }
            if (lane < 8) { const float z = mine + fb; lfa[(size_t)m * 8 + lane] = fminf(z, 0.f) - __logf(1.0f + __expf(-fabsf(z))); } }
    }
}

__device__ __forceinline__ void cumsum_phase(const float* lfa, float* c2, int b, LAS float* scr, int tid, int wave, int lane) {
    const f32x4* src = (const f32x4*)(lfa + ((size_t)b * SEQ + 16 * tid) * 8);
    float a[16][8];
#pragma unroll
    for (int i = 0; i < 16; ++i) { const f32x4 p = src[2 * i], q = src[2 * i + 1]; a[i][0] = p.x; a[i][1] = p.y; a[i][2] = p.z; a[i][3] = p.w; a[i][4] = q.x; a[i][5] = q.y; a[i][6] = q.z; a[i][7] = q.w; }
#pragma unroll
    for (int i = 1; i < 16; ++i)
#pragma unroll
        for (int h = 0; h < 8; ++h) a[i][h] += a[i - 1][h];
    float off[8];
#pragma unroll
    for (int h = 0; h < 8; ++h) { float t = a[15][h], inc = t;
#pragma unroll
        for (int o = 1; o < 64; o <<= 1) { const float u = __shfl_up(inc, o); if (lane >= o) inc += u; }
        off[h] = inc - t; if (lane == 63) scr[wave * 8 + h] = inc; }
    __syncthreads();
#pragma unroll
    for (int h = 0; h < 8; ++h) { float p = 0.f; for (int w = 0; w < wave; ++w) p += scr[w * 8 + h]; off[h] += p; }
#pragma unroll
    for (int h = 0; h < 8; ++h) { f32x4* dst = (f32x4*)(c2 + ((size_t)(b * 8 + h)) * SEQ + 16 * tid);
#pragma unroll
        for (int i4 = 0; i4 < 4; ++i4) dst[i4] = (f32x4){(a[4 * i4][h] + off[h]) * LOG2E, (a[4 * i4 + 1][h] + off[h]) * LOG2E, (a[4 * i4 + 2][h] + off[h]) * LOG2E, (a[4 * i4 + 3][h] + off[h]) * LOG2E}; }
    __syncthreads();
}

#ifndef THR_EXTRA
#define THR_EXTRA 0.0f
#endif
__device__ __forceinline__ void fox_norms(const bf16* QA, const bf16* KA, unsigned* kmax, unsigned* qmax, int gw, int lane) {
    if (gw >= M / 16) return;
    float kq = 0.f, qq = 0.f;
#pragma unroll 4
    for (int i = 0; i < 16; ++i) { const size_t off = ((size_t)(16 * gw + i)) * 512 + lane * 8;
        const v4u kv = *(const v4u*)(KA + off), qv = *(const v4u*)(QA + off); float sk = 0.f, sq = 0.f;
#pragma unroll
        for (int j = 0; j < 4; ++j) { const float k0 = __uint_as_float(kv[j] << 16), k1 = __uint_as_float(kv[j] & 0xffff0000u), q0 = __uint_as_float(qv[j] << 16), q1 = __uint_as_float(qv[j] & 0xffff0000u); sk += k0 * k0 + k1 * k1; sq += q0 * q0 + q1 * q1; }
        sk += __shfl_xor(sk, 1); sk += __shfl_xor(sk, 2); sk += __shfl_xor(sk, 4); sq += __shfl_xor(sq, 1); sq += __shfl_xor(sq, 2); sq += __shfl_xor(sq, 4);
        kq = fmaxf(kq, sk); qq = fmaxf(qq, sq); }
    if ((lane & 7) == 0) { const int row0 = 16 * gw, b = row0 / SEQ, qb = (row0 % SEQ) / 256, h = lane >> 3;
        atomicMax(kmax + b * 8 + h, __float_as_uint(kq)); atomicMax(qmax + (b * 8 + h) * 32 + qb, __float_as_uint(qq)); }
}
__device__ __forceinline__ void fox_tstart(const float* c2, const unsigned* kmax, const unsigned* qmax, unsigned* tsout, int u) {
    if (u >= 1024) return;
    const int bh = u & 31, qb = u >> 5, q0 = qb * 256;
    const float kn = sqrtf(__uint_as_float(kmax[bh])) * 1.01f, qn = sqrtf(__uint_as_float(qmax[bh * 32 + qb])) * 1.01f;
    const float* cb = c2 + (size_t)bh * SEQ; const float thr = -170.0f - 2.0f * qn * kn - THR_EXTRA;
    const float cq0 = cb[q0];
    int T = q0 / 64 - 1;
    while (T >= 0 && !(cq0 - cb[64 * T + 63] < thr)) --T;
    int ts = (T + 1) & ~1; const int NTabs = q0 / 64 + 4; if (ts > NTabs - 4) ts = NTabs - 4;
    tsout[u] = (unsigned)ts;
}

__device__ __forceinline__ void gate_fixup(const float* halo, const float* cw, const float* cb, bf16* G, int gtid, int nthr) {
    const int ngrp = DFF / 4, nitems = (M / 64) * ngrp;
    for (int item = gtid; item < nitems; item += nthr) {
        const int blk = item / ngrp, ch = (item % ngrp) * 4;
        const float* h0 = halo + (size_t)blk * 4 * 5632 + ch;
        const f32x4 a0 = *(const f32x4*)(h0), u0 = *(const f32x4*)(h0 + 2816), a1 = *(const f32x4*)(h0 + 5632), u1 = *(const f32x4*)(h0 + 5632 + 2816);
        f32x4 pa62 = (f32x4){0.f, 0.f, 0.f, 0.f}, pa63 = pa62, pu62 = pa62, pu63 = pa62;
        if ((blk & 127) != 0) { const float* hp = h0 - 2 * 5632; pa62 = *(const f32x4*)(hp); pu62 = *(const f32x4*)(hp + 2816); pa63 = *(const f32x4*)(hp + 5632); pu63 = *(const f32x4*)(hp + 5632 + 2816); }
        const f32x4 wa0 = *(const f32x4*)(cw + ch), wa1 = *(const f32x4*)(cw + 5632 + ch), wa2 = *(const f32x4*)(cw + 2 * 5632 + ch), ba = *(const f32x4*)(cb + ch);
        const f32x4 wu0 = *(const f32x4*)(cw + 2816 + ch), wu1 = *(const f32x4*)(cw + 5632 + 2816 + ch), wu2 = *(const f32x4*)(cw + 2 * 5632 + 2816 + ch), bu = *(const f32x4*)(cb + 2816 + ch);
        const f32x4 ya0 = wa0 * pa62 + wa1 * pa63 + wa2 * a0 + ba, yu0 = wu0 * pu62 + wu1 * pu63 + wu2 * u0 + bu;
        const f32x4 ya1 = wa0 * pa63 + wa1 * a0 + wa2 * a1 + ba, yu1 = wu0 * pu63 + wu1 * u0 + wu2 * u1 + bu;
        const pg8::f32x2 g00 = pg8::gelu_pk((pg8::f32x2){ya0[0], ya0[1]}), g01 = pg8::gelu_pk((pg8::f32x2){ya0[2], ya0[3]}), g10 = pg8::gelu_pk((pg8::f32x2){ya1[0], ya1[1]}), g11 = pg8::gelu_pk((pg8::f32x2){ya1[2], ya1[3]});
        typedef unsigned u32x2f __attribute__((ext_vector_type(2)));
        *(u32x2f*)(G + (size_t)(blk * 64) * DFF + ch) = (u32x2f){pk2(g00.x * yu0[0], g00.y * yu0[1]), pk2(g01.x * yu0[2], g01.y * yu0[3])};
        *(u32x2f*)(G + (size_t)(blk * 64 + 1) * DFF + ch) = (u32x2f){pk2(g10.x * yu1[0], g10.y * yu1[1]), pk2(g11.x * yu1[2], g11.y * yu1[3])};
    }
}

namespace hg {
constexpr int QT_P = 272, KH_P = 144;
constexpr int O_QT = 0, O_KT = O_QT + 64 * QT_P, O_KH = O_KT + 64 * QT_P, O_VT = O_KH + 128 * KH_P, O_PB = O_VT + 128 * KH_P, O_BT = O_PB + 64 * KH_P, O_RS = O_BT + 2048, O_END = O_RS + 4096;
static_assert(O_END <= RING_BYTES, "hgrn lds");
constexpr int NITEMS = 16 * 128;
#define MFMA16(a, b, c) __builtin_amdgcn_mfma_f32_16x16x32_bf16((a), (b), (c), 0, 0, 0)
typedef float f32x2_t __attribute__((ext_vector_type(2))); typedef __bf16 bf16x2_t __attribute__((ext_vector_type(2)));
__device__ __forceinline__ unsigned cvtpk(float lo, float hi) { f32x2_t v = {lo, hi}; bf16x2_t b = __builtin_convertvector(v, bf16x2_t); return __builtin_bit_cast(unsigned, b); }
__device__ __forceinline__ void hgrn_prep(int first, int stride, bf16* QR, float* LF, const bf16* IR, const bf16* GR, bf16* U, bf16* QS, bf16* OI, float* DLg, LAS unsigned char* lds) {
    int tid_ = threadIdx.x; asm volatile("" : "+v"(tid_)); const int tid = tid_, lane = tid & 63, w = __builtin_amdgcn_readfirstlane(tid >> 6), n16 = lane & 15, g = lane >> 4;
    const int col = tid & 127, tq = tid >> 7;
    LAS unsigned char* QT = lds + O_QT; LAS unsigned char* KT = lds + O_KT; LAS unsigned char* KH = lds + O_KH; LAS unsigned char* VT = lds + O_VT; LAS unsigned char* PB = lds + O_PB;
    LAS float* BT = (LAS float*)(lds + O_BT);
    const int r32 = col & 31, qpos = (col & ~31) + ((r32 < 16) ? (8 * (r32 >> 2) + (r32 & 3)) : (8 * ((r32 - 16) >> 2) + 4 + (r32 & 3)));
    if (first >= NITEMS) return;
    float lf[16]; unsigned short qv[16], vv[16];
    { const int bh = first >> 7, c = first & 127; const size_t base = ((size_t)(bh >> 2) * SEQ + 64 * c + 16 * tq) * 512 + (bh & 3) * 128 + col;
#pragma unroll
      for (int i = 0; i < 16; ++i) { lf[i] = LF[base + (size_t)i * 512]; qv[i] = QR[base + (size_t)i * 512]; vv[i] = IR[base + (size_t)i * 512]; } }
    for (int it = first; it < NITEMS; it += stride) {
        float bl[16]; bl[0] = lf[0];
#pragma unroll
        for (int i = 1; i < 16; ++i) bl[i] = bl[i - 1] + lf[i];
        BT[tq * 128 + col] = bl[15];
        __syncthreads();
        const float t0 = BT[col], t1 = BT[128 + col], t2 = BT[256 + col], t3 = BT[384 + col];
        const float off = (tq == 0) ? 0.f : (tq == 1) ? t0 : (tq == 2) ? (t0 + t1) : (t0 + t1 + t2);
        const float bref = t0 + t1, blast = (t0 + t1) + (t2 + t3);
        unsigned khp[8], vtp[8];
        bf16* qsrow = QS + (size_t)it * 8192 + (size_t)(16 * tq) * 128 + qpos;
#pragma unroll
        for (int i = 0; i < 16; i += 2) {
            const float bb0 = bl[i] + off, bb1 = bl[i + 1] + off, k0 = 1.0f - __expf(lf[i]), k1 = 1.0f - __expf(lf[i + 1]), q0 = bf2f(qv[i]), q1 = bf2f(qv[i + 1]);
            const unsigned qs = cvtpk(q0 * __expf(fminf(bb0 - bref, 80.f)), q1 * __expf(fminf(bb1 - bref, 80.f)));
            const unsigned ks = cvtpk(k0 * __expf(fminf(bref - bb0, 80.f)), k1 * __expf(fminf(bref - bb1, 80.f)));
            const unsigned qa = cvtpk(q0 * __expf(bb0), q1 * __expf(bb1));
            khp[i >> 1] = cvtpk(k0 * __expf(blast - bb0), k1 * __expf(blast - bb1));
            vtp[i >> 1] = (unsigned)vv[i] | ((unsigned)vv[i + 1] << 16);
            *(LAS unsigned short*)(QT + (16 * tq + i) * QT_P + col * 2) = (unsigned short)qs; *(LAS unsigned short*)(QT + (16 * tq + i + 1) * QT_P + col * 2) = (unsigned short)(qs >> 16);
            *(LAS unsigned short*)(KT + (16 * tq + i) * QT_P + col * 2) = (unsigned short)ks; *(LAS unsigned short*)(KT + (16 * tq + i + 1) * QT_P + col * 2) = (unsigned short)(ks >> 16);
            qsrow[(size_t)i * 128] = (unsigned short)qa; qsrow[(size_t)(i + 1) * 128] = (unsigned short)(qa >> 16);
        }
        *(LAS v4u*)(KH + col * KH_P + 32 * tq) = (v4u){khp[0], khp[1], khp[2], khp[3]}; *(LAS v4u*)(KH + col * KH_P + 32 * tq + 16) = (v4u){khp[4], khp[5], khp[6], khp[7]};
        *(LAS v4u*)(VT + col * KH_P + 32 * tq) = (v4u){vtp[0], vtp[1], vtp[2], vtp[3]}; *(LAS v4u*)(VT + col * KH_P + 32 * tq + 16) = (v4u){vtp[4], vtp[5], vtp[6], vtp[7]};
        if (tq == 0) DLg[(size_t)it * 128 + col] = __expf(blast);
        if (it + stride < NITEMS) { const int nx = it + stride, bh = nx >> 7, c = nx & 127; const size_t base = ((size_t)(bh >> 2) * SEQ + 64 * c + 16 * tq) * 512 + (bh & 3) * 128 + col;
#pragma unroll
            for (int i = 0; i < 16; ++i) { lf[i] = LF[base + (size_t)i * 512]; qv[i] = QR[base + (size_t)i * 512]; vv[i] = IR[base + (size_t)i * 512]; } }
        __syncthreads();
        { const int tb = w >> 1;
#pragma unroll
          for (int jj = 0; jj < 2; ++jj) { const int sb = 2 * (w & 1) + jj; f32x4 p = (f32x4){0.f, 0.f, 0.f, 0.f};
              if (sb <= tb) {
#pragma unroll
                  for (int kk = 0; kk < 4; ++kk) { const bf16x8 A = *(const LAS bf16x8*)(QT + (16 * tb + n16) * QT_P + (32 * kk + 8 * g) * 2), B = *(const LAS bf16x8*)(KT + (16 * sb + n16) * QT_P + (32 * kk + 8 * g) * 2); p = MFMA16(A, B, p); }
                  if (sb == tb) {
#pragma unroll
                      for (int i = 0; i < 4; ++i) if (n16 > 4 * g + i) p[i] = 0.f; } }
#pragma unroll
              for (int i = 0; i < 4; ++i) *(LAS unsigned short*)(PB + (16 * tb + 4 * g + i) * KH_P + (16 * sb + n16) * 2) = (unsigned short)f2bf(p[i]); } }
        __syncthreads();
        bf16x8 vB[2];
#pragma unroll
        for (int kk = 0; kk < 2; ++kk) vB[kk] = *(const LAS bf16x8*)(VT + (16 * w + n16) * KH_P + (32 * kk + 8 * g) * 2);
#pragma unroll
        for (int mt = 0; mt < 4; ++mt) { f32x4 acc = (f32x4){0.f, 0.f, 0.f, 0.f};
#pragma unroll
            for (int kk = 0; kk < 2; ++kk) { const bf16x8 A = *(const LAS bf16x8*)(PB + (16 * mt + n16) * KH_P + (32 * kk + 8 * g) * 2); acc = MFMA16(A, vB[kk], acc); }
            *(unsigned long long*)(OI + (((size_t)it * 8 + w) * 4 + mt) * 256 + lane * 4) = (unsigned long long)cvtpk(acc[0], acc[1]) | ((unsigned long long)cvtpk(acc[2], acc[3]) << 32); }
#pragma unroll
        for (int j = 0; j < 8; ++j) { f32x4 acc = (f32x4){0.f, 0.f, 0.f, 0.f};
#pragma unroll
            for (int kk = 0; kk < 2; ++kk) { const bf16x8 A = *(const LAS bf16x8*)(KH + (16 * j + n16) * KH_P + (32 * kk + 8 * g) * 2); acc = MFMA16(A, vB[kk], acc); }
            { const int bh_ = it >> 7; const size_t T0_ = (size_t)(bh_ >> 2) * SEQ + 64 * (it & 127);
              *(unsigned long long*)((bf16*)(LF + (T0_ + 8 * w + j) * 512 + (bh_ & 3) * 128) + lane * 4) = (unsigned long long)cvtpk(acc[0], acc[1]) | ((unsigned long long)cvtpk(acc[2], acc[3]) << 32); } }
    }
    __syncthreads();
}
typedef unsigned u32x2 __attribute__((ext_vector_type(2)));
__device__ __forceinline__ f32x4 up4(u32x2 v) { return (f32x4){__uint_as_float(v.x << 16), __uint_as_float(v.x & 0xffff0000u), __uint_as_float(v.y << 16), __uint_as_float(v.y & 0xffff0000u)}; }
__device__ __forceinline__ void hgrn_scan(int task, float* LF, const float* DLg, int lane) {
    if (task >= 16 * 64) return;
    const int bh = task >> 6, wj = task & 63, g = lane >> 4;
    bf16* up = (bf16*)(LF + ((size_t)(bh >> 2) * SEQ + wj) * 512 + (bh & 3) * 128) + lane * 4;
    const float* dlp = DLg + (size_t)bh * 128 * 128 + 16 * (wj & 7) + 4 * g;
    f32x4 S = (f32x4){0.f, 0.f, 0.f, 0.f};
    u32x2 ub[8]; f32x4 db[8];
#pragma unroll
    for (int k = 0; k < 8; ++k) { ub[k] = *(const u32x2*)(up + (size_t)k * 65536); db[k] = *(const f32x4*)(dlp + (size_t)k * 128); }
#pragma nounroll
    for (int c0 = 0; c0 < SEQ / 64; c0 += 8) {
        u32x2 un[8]; f32x4 dn[8];
        if (c0 + 8 < SEQ / 64) {
#pragma unroll
            for (int k = 0; k < 8; ++k) { un[k] = *(const u32x2*)(up + (size_t)(c0 + 8 + k) * 65536); dn[k] = *(const f32x4*)(dlp + (size_t)(c0 + 8 + k) * 128); } }
        else {
#pragma unroll
            for (int k = 0; k < 8; ++k) { un[k] = (u32x2){0u, 0u}; dn[k] = (f32x4){0.f, 0.f, 0.f, 0.f}; } }
#pragma unroll
        for (int k = 0; k < 8; ++k) { *(u32x2*)(up + (size_t)(c0 + k) * 65536) = (u32x2){cvtpk(S[0], S[1]), cvtpk(S[2], S[3])}; S = S * db[k] + up4(ub[k]); }
#pragma unroll
        for (int k = 0; k < 8; ++k) { ub[k] = un[k]; db[k] = dn[k]; }
    }
}
__device__ __forceinline__ void hgrn_out_phase(int first, int stride, const float* LF, const bf16* QS, const bf16* OI, const bf16* GQ, const float* gnorm, bf16* MIX, LAS unsigned char* lds) {
    int tid_ = threadIdx.x; asm volatile("" : "+v"(tid_)); const int tid = tid_, lane = tid & 63, w = __builtin_amdgcn_readfirstlane(tid >> 6), n16 = lane & 15, g = lane >> 4;
    if (first >= NITEMS) return;
    LAS float* RS = (LAS float*)(lds + O_RS);
    bf16x8 qf[4][4]; u32x2 oif[4], sp[8]; unsigned short gq[16];
#define HO_LOAD(IT) do { const int bh_ = (IT) >> 7, hc_ = (bh_ & 3) * 128; const size_t T0_ = (size_t)(bh_ >> 2) * SEQ + 64 * ((IT) & 127); \
      _Pragma("unroll") for (int mt = 0; mt < 4; ++mt) { _Pragma("unroll") for (int kk = 0; kk < 4; ++kk) qf[mt][kk] = *(const bf16x8*)(QS + (size_t)(IT) * 8192 + (16 * mt + n16) * 128 + 32 * kk + 8 * g); \
          oif[mt] = *(const u32x2*)(OI + (((size_t)(IT) * 8 + w) * 4 + mt) * 256 + lane * 4); \
          _Pragma("unroll") for (int i = 0; i < 4; ++i) gq[4 * mt + i] = GQ[(T0_ + 16 * mt + 4 * g + i) * 512 + hc_ + 16 * w + n16]; } \
      _Pragma("unroll") for (int j = 0; j < 8; ++j) sp[j] = *(const u32x2*)((const bf16*)(LF + (T0_ + 8 * w + j) * 512 + hc_) + lane * 4); } while (0)
    HO_LOAD(first);
    int par = 0;
    for (int it = first; it < NITEMS; it += stride, par ^= 1) {
        const int bh = it >> 7, hc = (bh & 3) * 128; const size_t T0 = (size_t)(bh >> 2) * SEQ + 64 * (it & 127);
        const float gn = gnorm[hc + 16 * w + n16];
        f32x4 o[4], gf[4];
#pragma unroll
        for (int mt = 0; mt < 4; ++mt) { f32x4 acc = up4(oif[mt]); gf[mt] = (f32x4){bf2f(gq[4 * mt]), bf2f(gq[4 * mt + 1]), bf2f(gq[4 * mt + 2]), bf2f(gq[4 * mt + 3])};
#pragma unroll
            for (int kk = 0; kk < 4; ++kk) acc = MFMA16(qf[mt][kk], __builtin_bit_cast(bf16x8, (v4u){sp[2 * kk].x, sp[2 * kk].y, sp[2 * kk + 1].x, sp[2 * kk + 1].y}), acc);
            o[mt] = acc; }
        asm volatile("" ::: "memory");
        if (it + stride < NITEMS) HO_LOAD(it + stride);
        LAS float* RSc = RS + par * 512;
#pragma unroll
        for (int mt = 0; mt < 4; ++mt) { f32x4 q = o[mt] * o[mt];
#pragma unroll
            for (int sh = 1; sh < 16; sh <<= 1) { q[0] += __shfl_xor(q[0], sh); q[1] += __shfl_xor(q[1], sh); q[2] += __shfl_xor(q[2], sh); q[3] += __shfl_xor(q[3], sh); }
            if (n16 == 0) *(LAS f32x4*)(RSc + w * 64 + 16 * mt + 4 * g) = q; }
        asm volatile("s_waitcnt lgkmcnt(0)\n\ts_barrier" ::: "memory");
#pragma unroll
        for (int mt = 0; mt < 4; ++mt) { f32x4 tot = (f32x4){0.f, 0.f, 0.f, 0.f};
#pragma unroll
            for (int ww = 0; ww < 8; ++ww) tot += *(const LAS f32x4*)(RSc + ww * 64 + 16 * mt + 4 * g);
#pragma unroll
            for (int i = 0; i < 4; ++i) { const float r = __builtin_amdgcn_rsqf(tot[i] * (1.f / 128.f) + RMS_EPS); const float val = o[mt][i] * r * gn * gf[mt][i];
                MIX[(T0 + 16 * mt + 4 * g + i) * 1024 + 512 + hc + 16 * w + n16] = (unsigned short)f2bf(val); } }
    }
    __syncthreads();
#undef HO_LOAD
}
}
namespace cg = cooperative_groups;
#ifndef PHM
#define PHM 0xffff
#endif
#define PH(b) if constexpr ((PHM >> (b)) & 1)
#ifndef DUPP
#define DUPP 0
#endif
#define GSYNC() do { xcd_barrier(xbar); if (DUPP == 9) xcd_barrier(xbar); } while (0)
#ifndef PG8_SP2_
#define PG8_SP2_ true
#endif
#ifndef PG8_ALIGN_UP
#define PG8_ALIGN_UP true
#endif
#ifndef PG8_ALIGN_
#define PG8_ALIGN_ true
#endif
#define REP(k) for (int rep_ = 0; rep_ < ((DUPP == (k)) ? 2 : 1); ++rep_)
struct Args { Ptrs p; };
#define FRESH_IDS() int tid = threadIdx.x; asm volatile("" : "+v"(tid)); const int lane = tid & 63, wave = __builtin_amdgcn_readfirstlane(tid >> 6); const int gw = bx * NWAVES + wave, gtid = bx * (NWAVES * 64) + tid; (void)lane; (void)gw; (void)gtid;
__global__ void __launch_bounds__(NWAVES * 64, 2) fwd_megakernel(Args args) {
    extern __shared__ __attribute__((aligned(16))) unsigned char lds_raw[];
    cg::grid_group grid = cg::this_grid();
    const Ptrs& P = args.p;
    LAS unsigned char* lds = (LAS unsigned char*)lds_raw;
    volatile LAS int* MISC = (volatile LAS int*)(lds + MISC_OFF);
    const int G = gridDim.x, bx = blockIdx.x;
    const int NGW = G * NWAVES, nthr = G * NWAVES * 64;
    unsigned char* ws = P.ws;
    unsigned* ctl = (unsigned*)(ws + WS_CTL);
    if (threadIdx.x < 32) ((LAS unsigned*)(lds + MISC_OFF))[threadIdx.x] = 0u;
    __syncthreads();
    const XcdBarrier xbar = xcd_barrier_post(ctl + CW_BAR, (volatile LAS unsigned*)(lds + MISC_OFF) + 8);
    float* c2 = (float*)(ws + WS_C2); float* lfa = (float*)(ws + WS_LFA); const float* wfa = (const float*)(ws + WS_WFA);
    bf16* XN = (bf16*)(ws + WS_XN); bf16* slot0 = (bf16*)(ws + WS_SLOT0); bf16* MIX = (bf16*)(ws + WS_MIX); bf16* GB = (bf16*)(ws + WS_G); bf16* SUB = (bf16*)(ws + WS_SUB);

    REP(5) PH(0) { FRESH_IDS(); prologue_weights(P, lds, gw, NGW, wave, lane, gtid, nthr); }
    __syncthreads();
    PH(1) { FRESH_IDS(); ln_phase(P.x, nullptr, nullptr, 1.f, nullptr, XN, P.ln_emb_g, P.ln_emb_b, P.w_in + 1536, INC, P.fox_f_bias, lfa, (LAS float*)lds, gw, NGW, lane, tid); }
    grid.sync();

#pragma nounroll
    for (int l = 0; l < 2; ++l) {
        PH(2) if (bx < BATCH) { FRESH_IDS(); cumsum_phase(lfa, c2, bx, (LAS float*)lds, tid, wave, lane); }
        REP(1) { if (rep_) GSYNC();
        PH(3) { pg8::Gemm g{XN, (const bf16*)(ws + WS_WIN) + (size_t)l * NPROJ * 1024, M, NPROJ, D}; pg8::StaticOrder S; S.init(M, NPROJ, G, bx);
          pg8::EpiProj E{slot0, P.hlb, l, attn_body::C2};
          pg8::gemm_phase<pg8::EpiProj, pg8::StaticOrder, PG8_ALIGN_, PG8_SP2_>(lds, g, S, E); } }
        GSYNC();
        PH(5) { FRESH_IDS(); fox_norms(slot0, slot0 + pg8::SLOT_ELEMS, ctl + CW_KMAX + 32 * l, ctl + CW_QMAX + 1024 * l, gw, lane); }
        REP(4) { if (rep_) GSYNC();
        PH(4) hg::hgrn_prep(bx, G, slot0 + 3 * pg8::SLOT_ELEMS, (float*)(slot0 + 4 * pg8::SLOT_ELEMS), slot0 + 6 * pg8::SLOT_ELEMS, slot0 + 7 * pg8::SLOT_ELEMS, nullptr, (bf16*)(ws + WS_HQS), (bf16*)(ws + WS_HOI), (float*)(ws + WS_HDL), lds); }
        GSYNC();
        PH(4) { FRESH_IDS(); hg::hgrn_scan(gw, (float*)(slot0 + 4 * pg8::SLOT_ELEMS), (const float*)(ws + WS_HDL), lane);
                if (gw >= 1024) fox_tstart(c2, ctl + CW_KMAX + 32 * l, ctl + CW_QMAX + 1024 * l, ctl + CW_TS + 1024 * l, gtid - 1024 * 64); }
        GSYNC();
#ifndef DUP_MIX
#define DUP_MIX 0
#endif
        for (int rep = 0; rep < (DUP_MIX ? 2 : 1); ++rep) { unsigned* ctr = ctl + 64 * (l + 2 * rep); const bool do_h = (rep == 0) || (DUP_MIX & 1), do_a = (rep == 0) || (DUP_MIX & 2);
          const bf16* QA = slot0; const bf16* KA = slot0 + pg8::SLOT_ELEMS; const bf16* VA = slot0 + 2 * pg8::SLOT_ELEMS;
          int nxt_it = 0, nxt_ts = 0; if (threadIdx.x == 0) { nxt_it = (int)atomicAdd(ctr, 1u); nxt_ts = (nxt_it < 1024) ? (int)ctl[CW_TS + 1024 * l + (nxt_it & 31) + 32 * (31 - (nxt_it >> 5))] : 0; }
          for (;;) {
              FRESH_IDS();
              if (tid == 0) { MISC[16] = nxt_it; MISC[17] = nxt_ts; }
              __syncthreads();
              const int it = MISC[16], its = MISC[17];
              __syncthreads();
              if (it >= 1024) break;
              if (tid == 0) { nxt_it = (int)atomicAdd(ctr, 1u); nxt_ts = (nxt_it < 1024) ? (int)ctl[CW_TS + 1024 * l + (nxt_it & 31) + 32 * (31 - (nxt_it >> 5))] : 0; }
              PH(5) if (do_a) { const int idx = it, qb = 31 - (idx >> 5), bh = idx & 31;
                     attn_body::attn_unit<60>(bh >> 3, bh & 7, qb, (const attn_body::bf16*)QA, (const attn_body::bf16*)KA, (const attn_body::bf16*)VA, (attn_body::bf16*)MIX, c2, P.fox_norm_g + l * 512, (int)__builtin_amdgcn_readfirstlane(its), (char*)lds_raw); }
          }
          PH(4) if (do_h) hg::hgrn_out_phase(bx, G, (const float*)(slot0 + 4 * pg8::SLOT_ELEMS), (const bf16*)(ws + WS_HQS), (const bf16*)(ws + WS_HOI), slot0 + 7 * pg8::SLOT_ELEMS, P.hgrn_norm_g + l * 512, MIX, lds);
          if (DUP_MIX && rep == 0) GSYNC(); }
        GSYNC();
        REP(6) { if (rep_) GSYNC();
        PH(6) { pg8::Gemm g{MIX, (const bf16*)(ws + WS_WO) + (size_t)l * 1024 * 1024, M, D, D}; pg8::StaticOrder S; S.init(M, D, G, bx);
          pg8::EpiBf16<0> E{SUB, D, nullptr, 0, 0, 1.f};
          pg8::gemm_phase<pg8::EpiBf16<0>, pg8::StaticOrder, PG8_ALIGN_, PG8_SP2_>(lds, g, S, E); } }
        GSYNC();
        REP(3) { if (rep_) GSYNC();
        PH(1) { FRESH_IDS(); ln_phase(nullptr, XN, SUB, DN_ALPHA, nullptr, (DUPP == 3 && rep_ == 0) ? (bf16*)(ws + 200 * MiB) : XN, P.ln_mix_g + l * D, P.ln_mix_b + l * D, nullptr, 0, nullptr, nullptr, (LAS float*)lds, gw, NGW, lane, tid); } }
        GSYNC();
        REP(2) { if (rep_) GSYNC();
        PH(7) { pg8::Gemm g{XN, (const bf16*)(ws + WS_WUP) + (size_t)l * 2 * DFF * 1024, M, 2 * DFF, D}; pg8::StaticOrder S; S.init(M, 2 * DFF, G, bx);
          pg8::EpiGate E{GB, (float*)(ws + WS_HALO), P.conv_w + (size_t)l * 3 * 2 * DFF, P.conv_b + (size_t)l * 2 * DFF};
          pg8::gemm_phase<pg8::EpiGate, pg8::StaticOrder, PG8_ALIGN_UP, PG8_SP2_>(lds, g, S, E); } }
        GSYNC();
        REP(8) { if (rep_) GSYNC();
        PH(8) { FRESH_IDS(); gate_fixup((const float*)(ws + WS_HALO), P.conv_w + (size_t)l * 3 * 2 * DFF, P.conv_b + (size_t)l * 2 * DFF, GB, gtid, nthr); } }
        GSYNC();
        REP(7) { if (rep_) GSYNC();
        PH(6) { pg8::Gemm g{GB, (const bf16*)(ws + WS_WDN) + (size_t)l * 1024 * DFF, M, D, DFF}; pg8::StaticOrder S; S.init(M, D, G, bx);
          pg8::EpiBf16<0> E{SUB, D, nullptr, 0, 0, 1.f};
          pg8::gemm_phase<pg8::EpiBf16<0>, pg8::StaticOrder, PG8_ALIGN_, PG8_SP2_>(lds, g, S, E); } }
        GSYNC();
        if (l == 0) { PH(1) { FRESH_IDS(); ln_phase(nullptr, XN, SUB, DN_ALPHA, nullptr, XN, P.ln_ffn_g, P.ln_ffn_b, wfa + 8 * 1024, 0, P.fox_f_bias + 8, lfa, (LAS float*)lds, gw, NGW, lane, tid); } GSYNC(); }
        else PH(1) { FRESH_IDS(); ln_phase(nullptr, XN, SUB, DN_ALPHA, P.out, nullptr, P.ln_ffn_g + D, P.ln_ffn_b + D, nullptr, 0, nullptr, nullptr, (LAS float*)lds, gw, NGW, lane, tid); }
    }
}

extern "C" void kernel_launch(void* const* d_in, const int* in_sizes, int n_in, void* d_out, int out_size, void* d_ws, size_t ws_size, hipStream_t stream) {
    static int grid = 0;
    if (grid == 0) {
        if (n_in != 17 || in_sizes[0] != M * D || out_size != M * D || ws_size < WS_END) { fprintf(stderr, "kernel_launch: unexpected shapes: n_in %d in0 %d out %d ws %zu\n", n_in, n_in > 0 ? in_sizes[0] : -1, out_size, ws_size); grid = -1; return; }
        int dev = 0, cus = 0, per_cu = 0;
        if (hipGetDevice(&dev) != hipSuccess || hipDeviceGetAttribute(&cus, hipDeviceAttributeMultiprocessorCount, dev) != hipSuccess) { fprintf(stderr, "kernel_launch: device query failed\n"); grid = -1; return; }
        if (hipFuncSetAttribute((const void*)fwd_megakernel, hipFuncAttributeMaxDynamicSharedMemorySize, LDS_BYTES) != hipSuccess) { fprintf(stderr, "kernel_launch: hipFuncSetAttribute failed\n"); grid = -1; return; }
        if (hipOccupancyMaxActiveBlocksPerMultiprocessor(&per_cu, (const void*)fwd_megakernel, NWAVES * 64, LDS_BYTES) != hipSuccess || per_cu < 1) { fprintf(stderr, "kernel_launch: occupancy query says %d blocks/CU\n", per_cu); per_cu = 1; }
        (void)hipGetLastError();
        grid = cus;
    }
    if (grid < 0) return;
    (void)hipMemsetAsync((char*)d_ws + WS_CTL, 0, CTL_ZERO_BYTES, stream);
    Args a{};
    const float** pp = (const float**)&a.p;
    for (int i = 0; i < 17; ++i) pp[i] = (const float*)d_in[i];
    a.p.out = (float*)d_out; a.p.ws = (unsigned char*)d_ws;
    void* kargs[] = {&a};
    const hipError_t e = hipLaunchCooperativeKernel((const void*)fwd_megakernel, dim3(grid), dim3(NWAVES * 64), kargs, LDS_BYTES, stream);
    if (e != hipSuccess) fprintf(stderr, "kernel_launch: cooperative launch failed: %s (grid %d)\n", hipGetErrorString(e), grid);
}
```

```cpp
#include <hip/hip_runtime.h>
#include <hip/hip_cooperative_groups.h>
#include <hip/hip_bf16.h>
#include <cstdio>
#include <cstdint>
#include <cmath>
namespace pg8 {
#define PG8_LAS __attribute__((address_space(3)))
typedef unsigned short bf16_t;
typedef short bf16x8 __attribute__((ext_vector_type(8)));
typedef float f32x4 __attribute__((ext_vector_type(4)));
typedef unsigned u32x4 __attribute__((ext_vector_type(4)));
constexpr int BM = 256, BK = 64, HALF = 128, HTB = HALF * BK * 2  , STAGE_BYTES = 8 * HTB, NXCD = 8, WGM = 4;

__host__ __device__ __forceinline__ int lds_byte(int r, int c) { const int st = (r >> 4) * 2 + (c >> 5), rr = r & 15, cc = c & 31, ob = rr * 64 + cc * 2; return st * 1024 + (ob ^ (((ob >> 9) & 1) << 5)); }
__host__ __device__ __forceinline__ void stage_rc(int b, int& R, int& C) { const int st = b / 1024, sb = b % 1024, swz = sb ^ (((sb >> 9) & 1) << 5); R = (st >> 1) * 16 + swz / 64; C = (st & 1) * 32 + (swz % 64) / 2; }
__host__ __device__ __forceinline__ int perm32(int rho) { const int n = rho >> 4, i = rho & 15; return 8 * (i >> 2) + 4 * n + (i & 3); }

struct Unit { int pm, pn; };
struct Gemm { const bf16_t* A; const bf16_t* Bt; int M, N, K; };

struct StaticOrder {
    int nM, nN, nwg, G, c;
    __host__ __device__ void init(int M, int N, int G_, int c_) { nM = M / BM; nN = N / BM; nwg = nM * nN; G = G_; c = c_; }
    __host__ __device__ bool next(int i, Unit& u) const {
        const long L = (long)i * G + c; if (L >= nwg) return false;
        int wgid = (int)L; { const int q = nwg / NXCD, r = nwg % NXCD, xcd = wgid % NXCD, off = wgid / NXCD; wgid = (xcd < r ? xcd * (q + 1) : r * (q + 1) + (xcd - r) * q) + off; }
        const int nig = WGM * nN, gid = wgid / nig, fm = gid * WGM, gsz = (nM - fm) < WGM ? (nM - fm) : WGM;
        u.pm = fm + ((wgid % nig) % gsz); u.pn = (wgid % nig) / gsz; return true;
    }
    __device__ __forceinline__ void a_ready(const Unit&) const {}
    __device__ __forceinline__ void done(const Unit&) const {}
};

typedef float f32x2c __attribute__((ext_vector_type(2))); typedef __bf16 bf16x2c __attribute__((ext_vector_type(2)));
__device__ __forceinline__ unsigned cvt_pk_bf16(float lo, float hi) { f32x2c v = {lo, hi}; bf16x2c b = __builtin_convertvector(v, bf16x2c); return __builtin_bit_cast(unsigned, b); }
typedef float f32x2 __attribute__((ext_vector_type(2)));
__device__ __forceinline__ f32x2 gelu_pk(f32x2 v) {
    const f32x2 av = __builtin_elementwise_abs(v), d = av * 0.2316418882f + 1.0f;
    f32x2 t; t.x = __builtin_amdgcn_rcpf(d.x); t.y = __builtin_amdgcn_rcpf(d.y);
    f32x2 q = t * 0.5307027145f + (-0.7265760135f); q = q * t + 0.7107068705f; q = q * t + (-0.142248368f); q = q * t + 0.127414796f; q = q * t;
    const f32x2 s = (v * v) * (-0.72134752044f);
    f32x2 e; e.x = __builtin_amdgcn_exp2f(s.x); e.y = __builtin_amdgcn_exp2f(s.y);
    f32x2 p; p.x = fmaxf(v.x, 0.f); p.y = fmaxf(v.y, 0.f);
    return p - av * (q * e);
}

template <int ACT  > struct EpiBf16 {
    static constexpr bool PERM = true, AFTER_DRAIN = false; static_assert(ACT == 0 || ACT == 1, "EpiBf16: ACT is 0 (none) or 1 (gelu_pk)");
    bf16_t* O; int ldc; const float* bias; int split_cols; size_t split_stride; float scale0;
    __device__ __forceinline__ void operator()(const f32x4 (&acc)[2][2][4][2], const Unit& u, int wr, int wc, int fr, int fq) const {
        const int row0 = u.pm * BM + wr * 64 + fr; int colt = u.pn * BM; bf16_t* base = O;
        float sc = 1.f; if (split_cols) { const int t = colt / split_cols; base += (size_t)t * split_stride; colt -= t * split_cols; if (t == 0) sc = scale0; }
        const int col0 = colt + wc * 32 + 8 * fq, bcol0 = u.pn * BM + wc * 32 + 8 * fq;
        f32x4 bv[2][2];
#pragma unroll
        for (int bj = 0; bj < 2; ++bj)
#pragma unroll
            for (int n = 0; n < 2; ++n) bv[bj][n] = bias ? *(const f32x4*)(bias + bcol0 + bj * HALF + 4 * n) : (f32x4){0.f, 0.f, 0.f, 0.f};
#pragma unroll
        for (int ai = 0; ai < 2; ++ai)
#pragma unroll
            for (int m = 0; m < 4; ++m) { bf16_t* rowp = base + (size_t)(row0 + ai * HALF + m * 16) * ldc + col0;
#pragma unroll
                for (int bj = 0; bj < 2; ++bj) { f32x4 v0 = acc[ai][bj][m][0] + bv[bj][0], v1 = acc[ai][bj][m][1] + bv[bj][1];
                    if (ACT == 1) { f32x2 a = gelu_pk((f32x2){v0[0], v0[1]}), b = gelu_pk((f32x2){v0[2], v0[3]}), c = gelu_pk((f32x2){v1[0], v1[1]}), d = gelu_pk((f32x2){v1[2], v1[3]});
                        v0 = (f32x4){a.x, a.y, b.x, b.y}; v1 = (f32x4){c.x, c.y, d.x, d.y}; }
                    v0 = v0 * sc; v1 = v1 * sc; u32x4 w; w.x = cvt_pk_bf16(v0[0], v0[1]); w.y = cvt_pk_bf16(v0[2], v0[3]); w.z = cvt_pk_bf16(v1[0], v1[1]); w.w = cvt_pk_bf16(v1[2], v1[3]);
                    *(u32x4*)(rowp + bj * HALF) = w; } }
    }
};
__device__ __forceinline__ float silu_f(float x) { return x * __builtin_amdgcn_rcpf(1.0f + __expf(-x)); }
constexpr size_t SLOT_ELEMS = (size_t)32768 * 512;
struct EpiProj {
    static constexpr bool PERM = true, AFTER_DRAIN = false;
    bf16_t* base0; const float* hlb; int layer; float qscale;
    template <int MODE  > __device__ __forceinline__ void st_bf16(const f32x4 (&acc)[2][2][4][2], bf16_t* base, int row0, int col0, float sc) const {
#pragma unroll
        for (int ai = 0; ai < 2; ++ai)
#pragma unroll
            for (int m = 0; m < 4; ++m) { bf16_t* rowp = base + (size_t)(row0 + ai * HALF + m * 16) * 512 + col0;
#pragma unroll
                for (int bj = 0; bj < 2; ++bj) { f32x4 v0 = acc[ai][bj][m][0], v1 = acc[ai][bj][m][1];
                    if (MODE == 2) { v0 = (f32x4){silu_f(v0[0]), silu_f(v0[1]), silu_f(v0[2]), silu_f(v0[3])}; v1 = (f32x4){silu_f(v1[0]), silu_f(v1[1]), silu_f(v1[2]), silu_f(v1[3])}; }
                    if (MODE == 1) { v0 = v0 * sc; v1 = v1 * sc; }
                    u32x4 w; w.x = cvt_pk_bf16(v0[0], v0[1]); w.y = cvt_pk_bf16(v0[2], v0[3]); w.z = cvt_pk_bf16(v1[0], v1[1]); w.w = cvt_pk_bf16(v1[2], v1[3]);
                    *(u32x4*)(rowp + bj * HALF) = w; } }
    }
    template <bool LB0> static __device__ __forceinline__ float logf_gate(float z, float l) {
        const float e = __expf(-fabsf(z));
        if (LB0) return fminf(z, 0.f) - __logf(1.0f + e);
        const float r = __builtin_amdgcn_rcpf(1.0f + e); const float sg = (z >= 0.f) ? r : e * r;
        return __logf(l + (1.0f - l) * sg);
    }
    template <bool LB0> static __device__ __forceinline__ f32x4 logf_gate4(f32x4 v, f32x4 l) { return (f32x4){logf_gate<LB0>(v[0], l[0]), logf_gate<LB0>(v[1], l[1]), logf_gate<LB0>(v[2], l[2]), logf_gate<LB0>(v[3], l[3])}; }
    __device__ __forceinline__ f32x4 lb4(int c) const {
        const f32x4 h0 = *(const f32x4*)(hlb + c), h1 = *(const f32x4*)(hlb + 512 + c);
        return (f32x4){__builtin_amdgcn_rcpf(1.0f + __expf(h0[0] - h1[0])), __builtin_amdgcn_rcpf(1.0f + __expf(h0[1] - h1[1])), __builtin_amdgcn_rcpf(1.0f + __expf(h0[2] - h1[2])), __builtin_amdgcn_rcpf(1.0f + __expf(h0[3] - h1[3]))};
    }
    template <bool LB0> __device__ __forceinline__ void st_logf(const f32x4 (&acc)[2][2][4][2], float* base, int row0, int col0) const {
        const f32x4 z4 = (f32x4){0.f, 0.f, 0.f, 0.f};
        const f32x4 lA0 = LB0 ? z4 : lb4(col0), lA1 = LB0 ? z4 : lb4(col0 + 4), lB0 = LB0 ? z4 : lb4(col0 + HALF), lB1 = LB0 ? z4 : lb4(col0 + HALF + 4);
#pragma unroll
        for (int ai = 0; ai < 2; ++ai)
#pragma unroll
            for (int m = 0; m < 4; ++m) { float* rowp = base + (size_t)(row0 + ai * HALF + m * 16) * 512 + col0;
                *(f32x4*)(rowp) = logf_gate4<LB0>(acc[ai][0][m][0], lA0); *(f32x4*)(rowp + 4) = logf_gate4<LB0>(acc[ai][0][m][1], lA1);
                *(f32x4*)(rowp + HALF) = logf_gate4<LB0>(acc[ai][1][m][0], lB0); *(f32x4*)(rowp + HALF + 4) = logf_gate4<LB0>(acc[ai][1][m][1], lB1); }
    }
    __device__ __forceinline__ void operator()(const f32x4 (&acc)[2][2][4][2], const Unit& u, int wr, int wc, int fr, int fq) const {
        const int t = u.pn >> 1, colt = (u.pn & 1) * 256, slot = t < 5 ? t : t + 1;
        const int row0 = u.pm * BM + wr * 64 + fr, col0 = colt + wc * 32 + 8 * fq;
        bf16_t* base = base0 + (size_t)slot * SLOT_ELEMS;
        if (t == 4) { if (layer == 0) st_logf<true>(acc, (float*)base, row0, col0); else st_logf<false>(acc, (float*)base, row0, col0); }
        else if (t == 0) st_bf16<1>(acc, base, row0, col0, qscale);
        else if (t == 3 || t == 6) st_bf16<2>(acc, base, row0, col0, 1.f);
        else st_bf16<0>(acc, base, row0, col0, 1.f);
    }
};
struct EpiRes {
    static constexpr bool PERM = false, AFTER_DRAIN = false;
    const float* ysrc; float* ydst; const float* stats; const float* g; const float* b; float alpha;
    __device__ __forceinline__ void operator()(const f32x4 (&acc)[2][2][4][2], const Unit& u, int wr, int wc, int fr, int fq) const {
        const int col0 = u.pn * BM + wc * 32 + 4 * fq, rowb = u.pm * BM + wr * 64 + fr;
        float mu[2][4], rs[2][4];
#pragma unroll
        for (int ai = 0; ai < 2; ++ai)
#pragma unroll
            for (int m = 0; m < 4; ++m) { const f32x2 st = *(const f32x2*)(stats + 2 * (rowb + ai * HALF + m * 16)); mu[ai][m] = st.x; rs[ai][m] = st.y; }
#pragma unroll
        for (int bj = 0; bj < 2; ++bj)
#pragma unroll
            for (int n = 0; n < 2; ++n) { const int c = col0 + bj * HALF + n * 16;
                f32x4 y[2][4];
#pragma unroll
                for (int ai = 0; ai < 2; ++ai)
#pragma unroll
                    for (int m = 0; m < 4; ++m) y[ai][m] = *(const f32x4*)(ysrc + (size_t)(rowb + ai * HALF + m * 16) * 1024 + c);
                const f32x4 gv = *(const f32x4*)(g + c), bv = *(const f32x4*)(b + c);
#pragma unroll
                for (int ai = 0; ai < 2; ++ai)
#pragma unroll
                    for (int m = 0; m < 4; ++m) { const f32x4 o = (((y[ai][m] - mu[ai][m]) * rs[ai][m]) * gv + bv) * alpha + acc[ai][bj][m][n];
                        *(f32x4*)(ydst + (size_t)(rowb + ai * HALF + m * 16) * 1024 + c) = o; }
                asm volatile("" ::: "memory"); }
    }
};
struct EpiGate {
    static constexpr bool PERM = true, AFTER_DRAIN = false;
    bf16_t* G; float* halo; const float* cw; const float* cb;
    static __device__ __forceinline__ float ror1(float v) { return __builtin_bit_cast(float, __builtin_amdgcn_mov_dpp(__builtin_bit_cast(int, v), 0x121, 0xf, 0xf, false)); }
    static __device__ __forceinline__ float ror2(float v) { return __builtin_bit_cast(float, __builtin_amdgcn_mov_dpp(__builtin_bit_cast(int, v), 0x122, 0xf, 0xf, false)); }
    static __device__ __forceinline__ f32x4 ror1v(f32x4 v) { return (f32x4){ror1(v[0]), ror1(v[1]), ror1(v[2]), ror1(v[3])}; }
    static __device__ __forceinline__ f32x4 ror2v(f32x4 v) { return (f32x4){ror2(v[0]), ror2(v[1]), ror2(v[2]), ror2(v[3])}; }
    __device__ __forceinline__ void operator()(const f32x4 (&acc)[2][2][4][2], const Unit& u, int wr, int wc, int fr, int fq) const {
        const int rowb = u.pm * BM + wr * 64 + fr;
#pragma unroll
        for (int n = 0; n < 2; ++n) {
            const int ch = u.pn * 128 + wc * 32 + 8 * fq + 4 * n;
            const f32x4 wa0 = *(const f32x4*)(cw + ch), wa1 = *(const f32x4*)(cw + 5632 + ch), wa2 = *(const f32x4*)(cw + 2 * 5632 + ch), ba = *(const f32x4*)(cb + ch);
            const f32x4 wu0 = *(const f32x4*)(cw + 2816 + ch), wu1 = *(const f32x4*)(cw + 5632 + 2816 + ch), wu2 = *(const f32x4*)(cw + 2 * 5632 + 2816 + ch), bu = *(const f32x4*)(cb + 2816 + ch);
#pragma unroll
            for (int ai = 0; ai < 2; ++ai) {
                f32x4 pa1 = (f32x4){0.f, 0.f, 0.f, 0.f}, pa2 = pa1, pu1 = pa1, pu2 = pa1;
#pragma unroll
                for (int m = 0; m < 4; ++m) {
                    const f32x4 a = acc[ai][0][m][n], uu = acc[ai][1][m][n];
                    const f32x4 ra1 = ror1v(a), ra2 = ror2v(a), ru1 = ror1v(uu), ru2 = ror2v(uu);
                    const f32x4 a1 = (fr >= 1) ? ra1 : pa1, a2 = (fr >= 2) ? ra2 : pa2, u1 = (fr >= 1) ? ru1 : pu1, u2 = (fr >= 2) ? ru2 : pu2;
                    const f32x4 ya = wa0 * a2 + wa1 * a1 + wa2 * a + ba, yu = wu0 * u2 + wu1 * u1 + wu2 * uu + bu;
                    const f32x2 g0 = gelu_pk((f32x2){ya[0], ya[1]}), g1 = gelu_pk((f32x2){ya[2], ya[3]});
                    const int row = rowb + ai * HALF + m * 16;
                    if (m > 0 || fr >= 2) { typedef unsigned u32x2 __attribute__((ext_vector_type(2)));
                        u32x2 w; w.x = cvt_pk_bf16(g0.x * yu[0], g0.y * yu[1]); w.y = cvt_pk_bf16(g1.x * yu[2], g1.y * yu[3]); *(u32x2*)(G + (size_t)row * 2816 + ch) = w; }
                    if (m == 0 && fr < 2) { float* hp = halo + ((size_t)(row >> 6) * 4 + fr) * 5632 + ch; *(f32x4*)hp = a; *(f32x4*)(hp + 2816) = uu; }
                    if (m == 3 && fr >= 14) { float* hp = halo + ((size_t)(row >> 6) * 4 + (fr - 12)) * 5632 + ch; *(f32x4*)hp = a; *(f32x4*)(hp + 2816) = uu; }
                    pa1 = ra1; pa2 = ra2; pu1 = ru1; pu2 = ru2;
                }
            }
        }
    }
};
template <class Epi, class Sched, bool ALIGN_EPI = false, bool SP2 = false>
__device__ __forceinline__ void gemm_phase(PG8_LAS unsigned char* lds, const Gemm g, const Sched& S, const Epi& E) {
    int tid_ = threadIdx.x; asm volatile("" : "+v"(tid_)); const int tid = tid_, wid = __builtin_amdgcn_readfirstlane(tid >> 6), lane = tid & 63, wr = wid >> 2, wc = wid & 3, fr = lane & 15, fq = lane >> 4;
    const int K = g.K, nt = K / BK;
    unsigned voffA[2], voffB[2];
#pragma unroll
    for (int i = 0; i < 2; ++i) { int R, C; stage_rc(tid * 16 + i * 8192, R, C); const int Rb = Epi::PERM ? ((R & ~31) + perm32(R & 31)) : R;
        voffA[i] = (unsigned)(R * K + C) * 2u; voffB[i] = (unsigned)(Rb * K + C) * 2u; }
    const size_t kstep = (size_t)(BK * 2);
    const size_t hstep = (size_t)HALF * K * 2;
    const size_t tstep = 2 * hstep;
    const unsigned ldsw = (unsigned)wid * 1024u;
    const int aoff = lds_byte(wr * 64 + fr, fq * 8), boff = lds_byte(wc * 32 + fr, fq * 8);
#define PG8_SA(b, h) (((b) * 2 + (h)) * HTB)
#define PG8_SB(b, h) ((4 + (b) * 2 + (h)) * HTB)
#define PG8_STAGE(bufoff, gbase, voff) do { _Pragma("unroll") for (int _i = 0; _i < 2; ++_i) \
        __builtin_amdgcn_global_load_lds((const unsigned*)((const char*)(gbase) + (voff)[_i]), (PG8_LAS unsigned*)(lds + (bufoff) + ldsw + _i * 8192), 16, 0, 0); } while (0)
#define PG8_LDA(dst, b, h) do { _Pragma("unroll") for (int m = 0; m < 4; ++m) _Pragma("unroll") for (int k = 0; k < 2; ++k) dst[m][k] = *(const PG8_LAS bf16x8*)(lds + PG8_SA(b, h) + aoff + m * 2048 + k * 1024); } while (0)
#define PG8_LDB(dst, b, h) do { _Pragma("unroll") for (int n = 0; n < 2; ++n) _Pragma("unroll") for (int k = 0; k < 2; ++k) dst[n][k] = *(const PG8_LAS bf16x8*)(lds + PG8_SB(b, h) + boff + n * 2048 + k * 1024); } while (0)
#define PG8_MMA(ai, bj, At, Bt) do { __builtin_amdgcn_s_setprio(1); _Pragma("unroll") for (int m = 0; m < 4; ++m) _Pragma("unroll") for (int n = 0; n < 2; ++n) _Pragma("unroll") for (int k = 0; k < 2; ++k) \
        acc[ai][bj][m][n] = __builtin_amdgcn_mfma_f32_16x16x32_bf16(Bt[n][k], At[m][k], acc[ai][bj][m][n], 0, 0, 0); __builtin_amdgcn_s_setprio(0); } while (0)
#define PG8_WAIT_V(n) asm volatile("s_waitcnt vmcnt(" #n ")" ::: "memory")
#define PG8_WAIT_L(n) asm volatile("s_waitcnt lgkmcnt(" #n ")" ::: "memory")
#define PG8_BAR __builtin_amdgcn_s_barrier()
#define PG8_SCHED __builtin_amdgcn_sched_barrier(0)
    Unit cur, nxt; int ui = 0;
    if (!S.next(0, cur)) return;
    f32x4 acc[2][2][4][2];
#pragma unroll
    for (int a = 0; a < 2; ++a)
#pragma unroll
        for (int b = 0; b < 2; ++b)
#pragma unroll
            for (int m = 0; m < 4; ++m)
#pragma unroll
                for (int n = 0; n < 2; ++n) acc[a][b][m][n] = (f32x4){0.f, 0.f, 0.f, 0.f};
    bf16x8 At[4][2], B0[2][2], B1[2][2];
    const char* cA = (const char*)g.A + (size_t)cur.pm * tstep; const char* cB = (const char*)g.Bt + (size_t)cur.pn * tstep;
    S.a_ready(cur);
    if constexpr (SP2) {
        PG8_STAGE(PG8_SB(0, 0), cB, voffB); PG8_STAGE(PG8_SB(0, 1), cB + hstep, voffB); PG8_STAGE(PG8_SA(0, 0), cA, voffA); PG8_STAGE(PG8_SA(0, 1), cA + hstep, voffA);
        if (wr == 1) PG8_BAR;
        PG8_WAIT_V(2); PG8_BAR;
        PG8_STAGE(PG8_SB(1, 0), cB + kstep, voffB); PG8_STAGE(PG8_SA(1, 0), cA + kstep, voffA); PG8_STAGE(PG8_SB(1, 1), cB + hstep + kstep, voffB);
        PG8_WAIT_V(6); PG8_BAR;
    } else {
        PG8_STAGE(PG8_SB(0, 0), cB, voffB); PG8_STAGE(PG8_SA(0, 0), cA, voffA); PG8_STAGE(PG8_SB(0, 1), cB + hstep, voffB); PG8_STAGE(PG8_SA(0, 1), cA + hstep, voffA);
        if (wr == 1) PG8_BAR;
        PG8_WAIT_V(4); PG8_BAR;
        PG8_STAGE(PG8_SB(1, 0), cB + kstep, voffB); PG8_STAGE(PG8_SA(1, 0), cA + kstep, voffA); PG8_STAGE(PG8_SB(1, 1), cB + hstep + kstep, voffB);
        PG8_WAIT_V(6); PG8_BAR;
    }
    for (;;) {
        const bool has_next = S.next(ui + 1, nxt);
        const char* nA = has_next ? (const char*)g.A + (size_t)nxt.pm * tstep : cA; const char* nB = has_next ? (const char*)g.Bt + (size_t)nxt.pn * tstep : cB;
        for (int t = 0; t < nt; t += 2) {
            const bool last = (t == nt - 2);
            const char* a1 = cA + (size_t)(t + 1) * kstep;
            const char* a2 = last ? nA : cA + (size_t)(t + 2) * kstep; const char* b2 = last ? nB : cB + (size_t)(t + 2) * kstep;
            const char* a3 = a2 + kstep; const char* b3 = b2 + kstep;
            if (last && has_next) S.a_ready(nxt);
            if constexpr (SP2) {
            PG8_LDB(B0, 0, 0); PG8_LDB(B1, 0, 1); PG8_SCHED; PG8_LDA(At, 0, 0); PG8_STAGE(PG8_SA(1, 1), a1 + hstep, voffA);
            PG8_WAIT_V(8); PG8_WAIT_L(0); PG8_BAR; PG8_MMA(0, 0, At, B0); PG8_MMA(0, 1, At, B1); PG8_BAR; PG8_SCHED;
            PG8_LDA(At, 0, 1); PG8_STAGE(PG8_SB(0, 0), b2, voffB); PG8_STAGE(PG8_SB(0, 1), b2 + hstep, voffB); PG8_STAGE(PG8_SA(0, 0), a2, voffA);
            PG8_WAIT_V(8); PG8_WAIT_L(0); PG8_BAR; PG8_MMA(1, 0, At, B0); PG8_MMA(1, 1, At, B1); PG8_BAR; PG8_SCHED;
            PG8_LDB(B0, 1, 0); PG8_LDB(B1, 1, 1); PG8_SCHED; PG8_LDA(At, 1, 0); PG8_STAGE(PG8_SA(0, 1), a2 + hstep, voffA);
            PG8_WAIT_V(8); PG8_WAIT_L(0); PG8_BAR; PG8_MMA(0, 0, At, B0); PG8_MMA(0, 1, At, B1); PG8_BAR; PG8_SCHED;
            PG8_LDA(At, 1, 1); PG8_STAGE(PG8_SB(1, 0), b3, voffB); PG8_STAGE(PG8_SB(1, 1), b3 + hstep, voffB); PG8_STAGE(PG8_SA(1, 0), a3, voffA);
            PG8_WAIT_V(8); PG8_WAIT_L(0); PG8_BAR; PG8_MMA(1, 0, At, B0); PG8_MMA(1, 1, At, B1); PG8_BAR; PG8_SCHED;
            } else {
            PG8_LDB(B0, 0, 0); PG8_SCHED; PG8_LDA(At, 0, 0); PG8_STAGE(PG8_SA(1, 1), a1 + hstep, voffA);
            PG8_WAIT_L(8); PG8_BAR; PG8_WAIT_L(0); PG8_MMA(0, 0, At, B0); PG8_BAR; PG8_SCHED;
            PG8_LDB(B1, 0, 1); PG8_STAGE(PG8_SB(0, 0), b2, voffB);
            PG8_BAR; PG8_WAIT_L(0); PG8_MMA(0, 1, At, B1); PG8_BAR;
            PG8_LDA(At, 0, 1); PG8_STAGE(PG8_SA(0, 0), a2, voffA);
            PG8_BAR; PG8_WAIT_L(0); PG8_MMA(1, 0, At, B0); PG8_BAR; PG8_SCHED;
            PG8_STAGE(PG8_SB(0, 1), b2 + hstep, voffB);
            PG8_WAIT_V(6); PG8_BAR; PG8_MMA(1, 1, At, B1); PG8_BAR;
            PG8_LDB(B0, 1, 0); PG8_SCHED; PG8_LDA(At, 1, 0); PG8_STAGE(PG8_SA(0, 1), a2 + hstep, voffA);
            PG8_WAIT_L(8); PG8_BAR; PG8_WAIT_L(0); PG8_MMA(0, 0, At, B0); PG8_BAR; PG8_SCHED;
            PG8_LDB(B1, 1, 1); PG8_STAGE(PG8_SB(1, 0), b3, voffB);
            PG8_BAR; PG8_WAIT_L(0); PG8_MMA(0, 1, At, B1); PG8_BAR;
            PG8_LDA(At, 1, 1); PG8_STAGE(PG8_SA(1, 0), a3, voffA);
            PG8_BAR; PG8_WAIT_L(0); PG8_MMA(1, 0, At, B0); PG8_BAR; PG8_SCHED;
            PG8_STAGE(PG8_SB(1, 1), b3 + hstep, voffB);
            PG8_WAIT_V(6); PG8_BAR; PG8_MMA(1, 1, At, B1); PG8_BAR;
            }
        }
        if constexpr (ALIGN_EPI) { if (wr == 0) PG8_BAR; }
        if constexpr (!Epi::AFTER_DRAIN) { E(acc, cur, wr, wc, fr, fq); S.done(cur); }
        if (!has_next) break;
#pragma unroll
        for (int a = 0; a < 2; ++a)
#pragma unroll
            for (int b = 0; b < 2; ++b)
#pragma unroll
                for (int m = 0; m < 4; ++m)
#pragma unroll
                    for (int n = 0; n < 2; ++n) acc[a][b][m][n] = (f32x4){0.f, 0.f, 0.f, 0.f};
        cur = nxt; cA = nA; cB = nB; ++ui;
        if constexpr (ALIGN_EPI) { if (wr == 1) PG8_BAR; }
    }
    PG8_WAIT_V(0);
    if constexpr (!ALIGN_EPI) { if (wr == 0) PG8_BAR; }
    PG8_BAR;
    if constexpr (Epi::AFTER_DRAIN) { E.fused(acc, cur, wr, wc, fr, fq, lds, wid, lane); S.done(cur); }
#undef PG8_SA
#undef PG8_SB
#undef PG8_STAGE
#undef PG8_LDA
#undef PG8_LDB
#undef PG8_MMA
#undef PG8_WAIT_V
#undef PG8_WAIT_L
#undef PG8_BAR
#undef PG8_SCHED
}
}
namespace attn_body {
using bf16=__hip_bfloat16;
using bf16x8=__attribute__((ext_vector_type(8)))short;
using s16x4=__attribute__((ext_vector_type(4)))short;
using f32x16=__attribute__((ext_vector_type(16)))float;
using u32x4=__attribute__((ext_vector_type(4)))unsigned;
constexpr int BATCH=4,NHEAD=8,SEQ=8192,D=64,DM=NHEAD*D,OPITCH=1024;
constexpr int NW=8,QBLK=32,QB=QBLK*NW,KVBLK=64,NQB=SEQ/QB;
constexpr int ATTN_PITCH=DM, ATTN_UNIT_ROWS=QB;
__device__ __forceinline__ int crow(int r,int hi){return (r&3)+8*(r>>2)+4*hi;}
#define SBAR() __builtin_amdgcn_sched_barrier(0)
__device__ __forceinline__ void cmask(f32x16&p0,f32x16&p1,int jb,int qrel,int hi){
  const float NEG=-INFINITY; int kb=64*jb+4*hi;
  #pragma unroll
  for(int r=0;r<16;++r){int kv=kb+(r&3)+8*(r>>2); if(kv>qrel)p0[r]=NEG; if(kv+32>qrel)p1[r]=NEG;}
}

constexpr int NSLOT=3, SLOTB=8192;
constexpr int LDS_K=0, LDS_V=NSLOT*SLOTB, LDS_WS=2*NSLOT*SLOTB, LDS_OST=LDS_WS+NW*64*4, LDS_CK=LDS_OST+NW*4096, LDS_BYTES=LDS_CK+SEQ*4;
constexpr float C2=0.125f*1.4426950408889634f;
__device__ __forceinline__ void glds16(const void*gsrc,unsigned lds_dst){unsigned keep;
  asm volatile("s_mov_b32 %0, m0\n\ts_mov_b32 m0, %2\n\ts_nop 0\n\tglobal_load_lds_dwordx4 %1, off\n\ts_mov_b32 m0, %0":"=&s"(keep):"v"(gsrc),"s"(lds_dst):"memory");}
__device__ __forceinline__ float max3f(float a,float b,float c){float r;asm("v_max3_f32 %0, %1, %2, %3":"=v"(r):"v"(a),"v"(b),"v"(c));return r;}
__device__ __forceinline__ float max2f(float a,float b){float r;asm("v_max_f32_e32 %0, %1, %2":"=v"(r):"v"(a),"v"(b));return r;}
__device__ __forceinline__ float fadd_s(float a,float b){float r;asm("v_add_f32_e32 %0, %1, %2":"=v"(r):"v"(a),"v"(b));return r;}
__device__ __forceinline__ float fsub_s(float a,float b){float r;asm("v_sub_f32_e32 %0, %1, %2":"=v"(r):"v"(a),"v"(b));return r;}
typedef float f32x2_t __attribute__((ext_vector_type(2))); typedef __bf16 bf16x2_t __attribute__((ext_vector_type(2)));
__device__ __forceinline__ unsigned cvtpk_s(float lo,float hi){f32x2_t v={lo,hi};bf16x2_t b=__builtin_convertvector(v,bf16x2_t);return __builtin_bit_cast(unsigned,b);}
#define WAIT_BAR(N) asm volatile("s_waitcnt vmcnt(" #N ") lgkmcnt(0)\n\ts_barrier":::"memory")

__device__ __forceinline__ void qkt(f32x16&p0,f32x16&p1,const char*Kslot,const bf16x8*qr,const f32x16&negm,int r32,int hi){
  const char*kb=Kslot+hi*1024+r32*16;
  #pragma unroll
  for(int d0=0;d0<4;++d0){
    const bf16x8 b0=*reinterpret_cast<const bf16x8*>(kb+d0*2048);
    const bf16x8 b1=*reinterpret_cast<const bf16x8*>(kb+d0*2048+512);
    if(d0==0){p0=__builtin_amdgcn_mfma_f32_32x32x16_bf16(b0,qr[0],negm,0,0,0);p1=__builtin_amdgcn_mfma_f32_32x32x16_bf16(b1,qr[0],negm,0,0,0);}
    else{p0=__builtin_amdgcn_mfma_f32_32x32x16_bf16(b0,qr[d0],p0,0,0,0);p1=__builtin_amdgcn_mfma_f32_32x32x16_bf16(b1,qr[d0],p1,0,0,0);}}
}
typedef __attribute__((address_space(3))) const char* lds_cptr;
typedef short v4i16_t __attribute__((ext_vector_type(4)));
__device__ __forceinline__ void kload8(bf16x8*kf,lds_cptr kp){
  kf[0]=*(const __attribute__((address_space(3))) bf16x8*)(kp);      kf[1]=*(const __attribute__((address_space(3))) bf16x8*)(kp+512);
  kf[2]=*(const __attribute__((address_space(3))) bf16x8*)(kp+2048); kf[3]=*(const __attribute__((address_space(3))) bf16x8*)(kp+2560);
  kf[4]=*(const __attribute__((address_space(3))) bf16x8*)(kp+4096); kf[5]=*(const __attribute__((address_space(3))) bf16x8*)(kp+4608);
  kf[6]=*(const __attribute__((address_space(3))) bf16x8*)(kp+6144); kf[7]=*(const __attribute__((address_space(3))) bf16x8*)(kp+6656);
}
__device__ __forceinline__ void kload2(bf16x8*kf,lds_cptr kp,int j){ kf[2*j]=*(const __attribute__((address_space(3))) bf16x8*)(kp+j*2048); kf[2*j+1]=*(const __attribute__((address_space(3))) bf16x8*)(kp+j*2048+512); }
__device__ __forceinline__ s16x4 vtr(lds_cptr p){ return __builtin_bit_cast(s16x4,__builtin_amdgcn_ds_read_tr16_b64_v4i16((__attribute__((address_space(3))) v4i16_t*)p)); }
__device__ __forceinline__ float rowmax(const f32x16&p0,const f32x16&p1){
  float a=max3f(p0[0],p0[1],p1[0]),b=max3f(p0[2],p0[3],p1[1]);a=max3f(a,p1[2],p1[3]);
  #pragma unroll
  for(int r=4;r<16;r+=4){a=max3f(a,p0[r],p0[r+1]);b=max3f(b,p0[r+2],p0[r+3]);a=max3f(a,p1[r],p1[r+1]);b=max3f(b,p1[r+2],p1[r+3]);}
  const float m=max2f(a,b);
  auto rr=__builtin_amdgcn_permlane32_swap(__float_as_uint(m),__float_as_uint(m),false,false);
  return max2f(__uint_as_float(rr[0]),__uint_as_float(rr[1]));
}
__device__ __forceinline__ void pv(f32x16*o,int vb,bf16x8 pa0,bf16x8 pa1,bf16x8 pa2,bf16x8 pa3){
  #pragma unroll
  for(int d0=0;d0<2;++d0){s16x4 lo[4],hi[4];
    #pragma unroll
    for(int ks=0;ks<4;++ks){
      asm volatile("ds_read_b64_tr_b16 %0,%1 offset:%c2":"=&v"(lo[ks]):"v"(vb),"i"(d0*4096+ks*1024):"memory");
      asm volatile("ds_read_b64_tr_b16 %0,%1 offset:%c2":"=&v"(hi[ks]):"v"(vb),"i"(d0*4096+ks*1024+512):"memory");}
    asm volatile("s_waitcnt lgkmcnt(0)":::"memory");SBAR();
    #define PK(k) (bf16x8){lo[k][0],lo[k][1],lo[k][2],lo[k][3],hi[k][0],hi[k][1],hi[k][2],hi[k][3]}
    o[d0]=__builtin_amdgcn_mfma_f32_32x32x16_bf16(pa0,PK(0),o[d0],0,0,0);
    o[d0]=__builtin_amdgcn_mfma_f32_32x32x16_bf16(pa1,PK(1),o[d0],0,0,0);
    o[d0]=__builtin_amdgcn_mfma_f32_32x32x16_bf16(pa2,PK(2),o[d0],0,0,0);
    o[d0]=__builtin_amdgcn_mfma_f32_32x32x16_bf16(pa3,PK(3),o[d0],0,0,0);
    #undef PK
  }
}

#ifndef ATTN_STORE16
#define ATTN_STORE16(p,v) (*(u32x4*)(p)=(v))
#endif
template<int THRL> __device__ __forceinline__ void attn_unit(int b,int h,int qb,const bf16*Q,const bf16*__restrict__ K,const bf16*__restrict__ V,bf16*O,const float*__restrict__ c2,const float*__restrict__ gnorm,int ts,char*shm){
  int tid_=threadIdx.x; asm volatile("":"+v"(tid_)); const int tid=tid_,lane=tid&63,r32=lane&31,hi=lane>>5; const int wid=__builtin_amdgcn_readfirstlane(tid>>6);
  const long rowbase=(long)b*SEQ; const int q0=qb*QB;
  const bf16*Qw=Q+(rowbase+q0+wid*QBLK)*DM+h*D;
  const bf16*Kh=K+(rowbase+(long)ts*KVBLK)*DM+h*D,*Vh=V+(rowbase+(long)ts*KVBLK)*DM+h*D;
  const unsigned lds0=(unsigned)(uintptr_t)shm;
  float*wsf=(float*)(shm+LDS_WS)+wid*64;
  const bf16*ksrc=Kh+(long)lane*DM+wid*8;
  const bf16*vsrc=Vh+(long)(16*(wid&3)+(lane>>2))*DM+(wid>>2)*32+(lane&3)*8;
  const unsigned kdst=lds0+LDS_K+wid*1024, vdst=lds0+LDS_V+wid*1024;
  #define DMA_K(t,slot) glds16(ksrc+(long)(t)*KVBLK*DM,(unsigned)__builtin_amdgcn_readfirstlane(kdst+(slot)))
  #define DMA_V(t,slot) glds16(vsrc+(long)(t)*KVBLK*DM,(unsigned)__builtin_amdgcn_readfirstlane(vdst+(slot)))
  const int vb0=(int)(lds0+LDS_V)+((lane>>4)&1)*32+(lane&3)*8+(4*hi+((lane&15)>>2))*64;
  const char*Kbase=shm+LDS_K; bf16x8 kf[8];
  const lds_cptr shm3=(lds_cptr)shm; const lds_cptr kp0=shm3+LDS_K+hi*1024+r32*16; const lds_cptr vp0=shm3+LDS_V+((lane>>4)&1)*32+(lane&3)*8+(4*hi+((lane&15)>>2))*64;
  const int NT=(q0+QB)/KVBLK-ts;
  DMA_K(0,0);DMA_V(0,0);DMA_K(1,SLOTB);
  bf16x8 qr[4];
  #pragma unroll
  for(int d0=0;d0<4;++d0)qr[d0]=*reinterpret_cast<const bf16x8*>(&Qw[(long)r32*DM+d0*16+hi*8]);
  float mhat=0.f,l_reg=0.f;f32x16 o[2];o[0]=f32x16{};o[1]=f32x16{};f32x16 negm=f32x16{};asm volatile("":"+v"(negm));
  const int qrel=wid*QBLK+r32;
  #define CMASK(P0,P1,t) do{int jb_=(t)-(NT-4); if(jb_>=0)cmask(P0,P1,jb_,qrel,hi);}while(0)
  bool resc=false;
  #define START(P0,P1) do{ const float rm=*(const __attribute__((address_space(3))) float*)(shm3+LDS_CK+4*(q0-ts*KVBLK+wid*QBLK+r32)); resc=false; \
    { const float dl=rm; mhat=fadd_s(mhat,dl); \
      _Pragma("unroll") for(int r=0;r<16;++r){P0[r]=fsub_s(P0[r],dl);P1[r]=fsub_s(P1[r],dl);} \
      _Pragma("unroll") for(int r=0;r<16;++r)negm[r]=-mhat; asm volatile("":"+v"(negm)); } \
    _Pragma("unroll") for(int r=0;r<16;++r)P0[r]=__builtin_amdgcn_exp2f(P0[r]); }while(0)
  #define RESC() do{ if(resc){ asm volatile("s_waitcnt lgkmcnt(0)":::"memory"); \
      _Pragma("unroll") for(int d_=0;d_<2;++d_) _Pragma("unroll") for(int r=0;r<16;++r)o[d_][r]*=wsf[crow(r,hi)]; } }while(0)
  f32x16 pA0,pA1,pB0,pB1;
  int sl_prev=0,sl_cur=0,sl_next=SLOTB;
  #define ROT() do{sl_prev=sl_cur;sl_cur=sl_next;sl_next=(sl_next==(NSLOT-1)*SLOTB)?0:sl_next+SLOTB;}while(0)
  { typedef float f32x4v __attribute__((ext_vector_type(4)));
    const float*cb=c2+((long)(b*NHEAD+h))*SEQ; const float cref=cb[q0+QB-1];
    for(int i=tid;i<(q0+QB)/4-ts*16;i+=NW*64){ const f32x4v v=*(const f32x4v*)(cb+ts*64+4*i); *(__attribute__((address_space(3))) f32x4v*)((lds_cptr)shm+LDS_CK+16*i)=(f32x4v){cref-v[0],cref-v[1],cref-v[2],cref-v[3]}; } }
  DMA_K(2,2*SLOTB);
  WAIT_BAR(3);
  typedef float f32x4w __attribute__((ext_vector_type(4)));
  #define CKADD(P0,P1,t) do{ const __attribute__((address_space(3))) f32x4w*cp_=(const __attribute__((address_space(3))) f32x4w*)(shm3+LDS_CK)+(t)*16+hi; \
    { SBAR(); const f32x4w a0_=cp_[0],a1_=cp_[2],a2_=cp_[4],a3_=cp_[6]; \
      P0[0]+=a0_[0];P0[1]+=a0_[1];P0[2]+=a0_[2];P0[3]+=a0_[3]; P0[4]+=a1_[0];P0[5]+=a1_[1];P0[6]+=a1_[2];P0[7]+=a1_[3]; \
      P0[8]+=a2_[0];P0[9]+=a2_[1];P0[10]+=a2_[2];P0[11]+=a2_[3]; P0[12]+=a3_[0];P0[13]+=a3_[1];P0[14]+=a3_[2];P0[15]+=a3_[3]; } \
    { SBAR(); const f32x4w b0_=cp_[8],b1_=cp_[10],b2_=cp_[12],b3_=cp_[14]; \
      P1[0]+=b0_[0];P1[1]+=b0_[1];P1[2]+=b0_[2];P1[3]+=b0_[3]; P1[4]+=b1_[0];P1[5]+=b1_[1];P1[6]+=b1_[2];P1[7]+=b1_[3]; \
      P1[8]+=b2_[0];P1[9]+=b2_[1];P1[10]+=b2_[2];P1[11]+=b2_[3]; P1[12]+=b3_[0];P1[13]+=b3_[1];P1[14]+=b3_[2];P1[15]+=b3_[3]; } }while(0)
  qkt(pA0,pA1,Kbase,qr,negm,r32,hi);asm volatile("s_nop 15\n\ts_nop 7":"+v"(pA0),"+v"(pA1));CKADD(pA0,pA1,0);CMASK(pA0,pA1,0);
  START(pA0,pA1);
  _Pragma("unroll") for(int r=0;r<16;++r)pA1[r]=__builtin_amdgcn_exp2f(pA1[r]);
  WAIT_BAR(0);
  DMA_K(3,0);DMA_V(1,SLOTB);
  ROT();
  kload8(kf,kp0+sl_cur);
  WAIT_BAR(2);
  s16x4 vlo[8],vhi[8]; u32x4 pw0,pw1,pw2,pw3;
  #define PKW(P,B) cvtpk_s(P[B],P[B+1])
  #define PAF(k) __builtin_bit_cast(bf16x8,pw##k)
  #define VFR(i) (bf16x8){vlo[i][0],vlo[i][1],vlo[i][2],vlo[i][3],vhi[i][0],vhi[i][1],vhi[i][2],vhi[i][3]}
  #define PIN(x) asm volatile("":"+v"(x))
  #define MX3(a,b,c) __builtin_fmaxf(__builtin_fmaxf((a),(b)),(c))
  #define GAPA(MF,A0,A1,A2,A3,W0,W1,PW) do{ MF; sacc+=A0; sacc+=A1; sacc+=A2; sacc+=A3; PIN(sacc); W0; W1; PIN(PW); SBAR(); }while(0)
  #define EX(v) __builtin_amdgcn_exp2f(v)
  #define GAPB(MF,X,B) do{ MF; X[B]=EX(X[B]); X[B+1]=EX(X[B+1]); X[B+2]=EX(X[B+2]); X[B+3]=EX(X[B+3]); PIN(X); SBAR(); }while(0)
  #define VRD(i) do{ vlo[i]=vtr(vp_+(((i)>>2)*4096+((i)&3)*1024)); vhi[i]=vtr(vp_+(((i)>>2)*4096+((i)&3)*1024+512)); }while(0)
  #define KRD(G,j) do{ if(G){ kload2(kf,kp0+sl_next,j); SBAR(); } }while(0)
  #define STEP(C0,C1,P0,P1,t,GK,GV,GL) do{ SBAR(); \
    const lds_cptr vp_=vp0+sl_prev; \
    VRD(0); SBAR(); float sacc=(P0[0]+P0[1]); \
    GAPA(C0=__builtin_amdgcn_mfma_f32_32x32x16_bf16(kf[0],qr[0],negm,0,0,0), P0[2],P0[3],P0[4],P0[5],     pw0[0]=PKW(P0,0), pw0[1]=PKW(P0,2), pw0); \
    VRD(4); SBAR(); GAPA(C1=__builtin_amdgcn_mfma_f32_32x32x16_bf16(kf[1],qr[0],negm,0,0,0), P0[6],P0[7],P0[8],P0[9],     pw0[2]=PKW(P0,4), pw0[3]=PKW(P0,6), pw0); \
    VRD(1); SBAR(); GAPA(C0=__builtin_amdgcn_mfma_f32_32x32x16_bf16(kf[2],qr[1],C0,0,0,0),   P0[10],P0[11],P0[12],P0[13], pw1[0]=PKW(P0,8), pw1[1]=PKW(P0,10), pw1); \
    VRD(5); SBAR(); GAPA(C1=__builtin_amdgcn_mfma_f32_32x32x16_bf16(kf[3],qr[1],C1,0,0,0),   P0[14],P0[15],P1[0],P1[1],   pw1[2]=PKW(P0,12),pw1[3]=PKW(P0,14), pw1); \
    VRD(2); SBAR(); GAPA(C0=__builtin_amdgcn_mfma_f32_32x32x16_bf16(kf[4],qr[2],C0,0,0,0),   P1[2],P1[3],P1[4],P1[5],     pw2[0]=PKW(P1,0), pw2[1]=PKW(P1,2), pw2); \
    VRD(6); SBAR(); GAPA(C1=__builtin_amdgcn_mfma_f32_32x32x16_bf16(kf[5],qr[2],C1,0,0,0),   P1[6],P1[7],P1[8],P1[9],     pw2[2]=PKW(P1,4), pw2[3]=PKW(P1,6), pw2); \
    VRD(3); SBAR(); GAPA(C0=__builtin_amdgcn_mfma_f32_32x32x16_bf16(kf[6],qr[3],C0,0,0,0),   P1[10],P1[11],P1[12],P1[13], pw3[0]=PKW(P1,8), pw3[1]=PKW(P1,10), pw3); \
    VRD(7); SBAR(); GAPA(C1=__builtin_amdgcn_mfma_f32_32x32x16_bf16(kf[7],qr[3],C1,0,0,0),   P1[14],P1[15],0.f,0.f,       pw3[2]=PKW(P1,12),pw3[3]=PKW(P1,14), pw3); \
    l_reg+=sacc; \
    if(GK){DMA_K((t)+3,sl_cur);} if(GV){DMA_V((t)+1,sl_next);} \
    CKADD(C0,C1,t); CMASK(C0,C1,t); \
    { float a=MX3(C0[0],C0[1],C1[0]),b=MX3(C0[2],C0[3],C1[1]); a=MX3(a,C1[2],C1[3]); \
      _Pragma("unroll") for(int r=4;r<16;r+=4){a=MX3(a,C0[r],C0[r+1]);b=MX3(b,C0[r+2],C0[r+3]);a=MX3(a,C1[r],C1[r+1]);b=MX3(b,C1[r+2],C1[r+3]);} \
      float rm=__builtin_fmaxf(a,b); { auto rr=__builtin_amdgcn_permlane32_swap(__float_as_uint(rm),__float_as_uint(rm),false,false); rm=__builtin_fmaxf(__uint_as_float(rr[0]),__uint_as_float(rr[1])); } \
      resc=false; \
      if(__builtin_expect(__any(rm>(float)THRL),0)){ const float dl=__builtin_fmaxf(rm,0.f); mhat+=dl; \
        _Pragma("unroll") for(int r=0;r<16;++r){C0[r]-=dl;C1[r]-=dl;} \
        _Pragma("unroll") for(int r=0;r<16;++r)negm[r]=-mhat; asm volatile("":"+v"(negm)); \
        const float f=__builtin_amdgcn_exp2f(-dl); l_reg*=f; if(hi==0)wsf[r32]=f; resc=true; } } \
    SBAR(); \
    GAPB(o[0]=__builtin_amdgcn_mfma_f32_32x32x16_bf16(PAF(0),VFR(0),o[0],0,0,0), C0,0); \
    GAPB(o[1]=__builtin_amdgcn_mfma_f32_32x32x16_bf16(PAF(0),VFR(4),o[1],0,0,0), C0,4); \
    KRD(GL,0); GAPB(o[0]=__builtin_amdgcn_mfma_f32_32x32x16_bf16(PAF(1),VFR(1),o[0],0,0,0), C0,8); \
    KRD(GL,1); GAPB(o[1]=__builtin_amdgcn_mfma_f32_32x32x16_bf16(PAF(1),VFR(5),o[1],0,0,0), C0,12); \
    KRD(GL,2); GAPB(o[0]=__builtin_amdgcn_mfma_f32_32x32x16_bf16(PAF(2),VFR(2),o[0],0,0,0), C1,0); \
    KRD(GL,3); GAPB(o[1]=__builtin_amdgcn_mfma_f32_32x32x16_bf16(PAF(2),VFR(6),o[1],0,0,0), C1,4); \
    GAPB(o[0]=__builtin_amdgcn_mfma_f32_32x32x16_bf16(PAF(3),VFR(3),o[0],0,0,0), C1,8); \
    GAPB(o[1]=__builtin_amdgcn_mfma_f32_32x32x16_bf16(PAF(3),VFR(7),o[1],0,0,0), C1,12); \
    }while(0)
  int t=1;
  #undef CMASK
  #define CMASK(P0,P1,t) do{}while(0)
  for(;t+5<NT;t+=2){
    STEP(pB0,pB1,pA0,pA1,t,true,true,true);     WAIT_BAR(2); RESC(); ROT();
    STEP(pA0,pA1,pB0,pB1,t+1,true,true,true);   WAIT_BAR(2); RESC(); ROT();
  }
  #undef CMASK
  #define CMASK(P0,P1,t) do{int jb_=(t)-(NT-4); if(jb_>=0)cmask(P0,P1,jb_,qrel,hi);}while(0)
  #define ENDW(tt) do{ if((tt)+3<NT){WAIT_BAR(2);} else if((tt)+2<NT){WAIT_BAR(1);} else {WAIT_BAR(0);} }while(0)
  for(;t+1<NT;t+=2){
    STEP(pB0,pB1,pA0,pA1,t,(t+3<NT),(t+1<NT),(t+1<NT));       ENDW(t);   RESC(); ROT();
    STEP(pA0,pA1,pB0,pB1,t+1,(t+4<NT),(t+2<NT),(t+2<NT));     ENDW(t+1); RESC(); ROT();
  }
  STEP(pB0,pB1,pA0,pA1,NT-1,false,false,false); RESC();
  { float sacc=pB0[0]+pB0[1]; _Pragma("unroll") for(int r=2;r<16;++r)sacc+=pB0[r]; _Pragma("unroll") for(int r=0;r<16;++r)sacc+=pB1[r]; l_reg+=sacc;
    pw0=(u32x4){PKW(pB0,0),PKW(pB0,2),PKW(pB0,4),PKW(pB0,6)};pw1=(u32x4){PKW(pB0,8),PKW(pB0,10),PKW(pB0,12),PKW(pB0,14)};pw2=(u32x4){PKW(pB1,0),PKW(pB1,2),PKW(pB1,4),PKW(pB1,6)};pw3=(u32x4){PKW(pB1,8),PKW(pB1,10),PKW(pB1,12),PKW(pB1,14)};
    SBAR(); pv(o,vb0+sl_cur,PAF(0),PAF(1),PAF(2),PAF(3)); }
  #undef PKW
  #undef PAF
  #undef VFR
  #undef PIN
  #undef MX3
  #undef GAPA
  #undef GAPB
  #undef EX
  #undef VRD
  #undef KRD
  #undef STEP
  #undef ENDW
  {auto rr=__builtin_amdgcn_permlane32_swap(__float_as_uint(l_reg),__float_as_uint(l_reg),false,false);l_reg=__uint_as_float(rr[0])+__uint_as_float(rr[1]);}
  if(hi==0)wsf[32+r32]=l_reg;asm volatile("s_waitcnt lgkmcnt(0)":::"memory");
  float rli[16];
  #pragma unroll
  for(int r=0;r<16;++r)rli[r]=__builtin_amdgcn_rcpf(wsf[32+crow(r,hi)]);
  { const float g0=gnorm[h*D+r32],g1=gnorm[h*D+32+r32];
    #pragma unroll
    for(int r=0;r<16;++r){ const float x0=o[0][r]*rli[r],x1=o[1][r]*rli[r]; float s=x0*x0+x1*x1;
      s+=__shfl_xor(s,1);s+=__shfl_xor(s,2);s+=__shfl_xor(s,4);s+=__shfl_xor(s,8);s+=__shfl_xor(s,16);
      const float sc=1.0f/sqrtf(s*(1.0f/64.0f)+1e-6f); o[0][r]=x0*sc*g0; o[1][r]=x1*sc*g1; rli[r]=1.0f; } }
  bf16*Ow=O+(rowbase+q0+wid*QBLK)*OPITCH+h*D;
  { bf16*stg=(bf16*)(shm+LDS_OST)+wid*2048;
    #pragma unroll
    for(int r=0;r<16;++r){const int orow=crow(r,hi);
      #pragma unroll
      for(int d0=0;d0<2;++d0)stg[orow*64+d0*32+r32]=__float2bfloat16(o[d0][r]*rli[r]);}
    asm volatile("s_waitcnt lgkmcnt(0)":::"memory");
    #pragma unroll
    for(int i=0;i<4;++i){const int row=i*8+(lane>>3),ch=lane&7; const u32x4 v=*(const u32x4*)(stg+row*64+ch*8); ATTN_STORE16(Ow+(long)row*OPITCH+ch*8,v);} }
  asm volatile("s_waitcnt lgkmcnt(0)\n\ts_barrier":::"memory");
  #undef DMA_K
  #undef DMA_V
  #undef CMASK
  #undef CKADD
  #undef START
  #undef RESC
  #undef ROT
}
constexpr int ATTN_LDS_BYTES=LDS_BYTES;
#undef SBAR
#undef WAIT_BAR
}
constexpr int NWAVES = 8;
constexpr int BATCH = 4, SEQ = 8192, M = BATCH * SEQ, D = 1024, DFF = 2816, INC = 3592, NPROJ = 3584;
constexpr int NP1 = 1536, NP2 = 1280;
constexpr float LN_EPS = 1e-5f, RMS_EPS = 1e-6f;
constexpr float DN_ALPHA = 1.4142135623730951f;
constexpr float LOG2E = 1.4426950408889634f;
constexpr size_t MiB = 1u << 20;
constexpr size_t WS_CTL = 0, CTL_ZERO_BYTES = 49152;
constexpr int CW_BAR = 8192;
constexpr int CW_KMAX = 1024, CW_QMAX = 2048, CW_TS = 4096;
constexpr size_t WS_WFA = 1 * MiB;
constexpr size_t WS_STATS = 2 * MiB;
constexpr size_t WS_C2 = 4 * MiB;
constexpr size_t WS_LFA = 5 * MiB;
constexpr size_t WS_WIN = 8 * MiB, WS_WO = 22 * MiB, WS_WUP = 26 * MiB, WS_WDN = 48 * MiB;
constexpr size_t WS_XN = 60 * MiB;
constexpr size_t WS_SLOT0 = 124 * MiB;
constexpr size_t WS_MIX = 380 * MiB;
constexpr size_t WS_HALO = 124 * MiB;
constexpr size_t WS_SUB = 124 * MiB;
constexpr size_t WS_G = 316 * MiB;
constexpr size_t WS_HQS = 444 * MiB, WS_HOI = 476 * MiB, WS_HDL = 508 * MiB;
constexpr size_t WS_END = 512 * MiB;
static_assert(WS_G + (size_t)M * DFF * 2 <= WS_END && WS_HALO + (size_t)(M / 64) * 4 * 5632 * 4 <= WS_G && WS_MIX + (size_t)M * 1024 * 2 <= WS_END, "ws map");
constexpr int RING_BYTES = 131072, MISC_OFF = RING_BYTES + 320, LDS_BYTES = 147456;

#define GAS __attribute__((address_space(1)))
#define LAS __attribute__((address_space(3)))
typedef unsigned short bf16;
typedef unsigned v4u __attribute__((ext_vector_type(4)));
typedef float f32x4 __attribute__((ext_vector_type(4)));
typedef short bf16x8 __attribute__((ext_vector_type(8)));
typedef short bf16x4 __attribute__((ext_vector_type(4)));
#define LDS_WAIT() asm volatile("s_waitcnt lgkmcnt(0)" ::: "memory")
__device__ __forceinline__ unsigned f2bf(float f) { unsigned u = __builtin_bit_cast(unsigned, f); return (u + 0x7fffu + ((u >> 16) & 1u)) >> 16; }
__device__ __forceinline__ unsigned pk2(float lo, float hi) { return f2bf(lo) | (f2bf(hi) << 16); }
__device__ __forceinline__ float bf2f(unsigned short v) { return __uint_as_float((unsigned)v << 16); }
__device__ __forceinline__ float wave_sum(float v) {
#pragma unroll
    for (int o = 1; o < 64; o <<= 1) v += __shfl_xor(v, o);
    return v;
}
__device__ __forceinline__ void p0_transpose_item(const float* W, int ldw, int K, int N, bf16* WT, int row_off, LAS float* scr, int item, int lane) {
    const int nblk = N / 32, kb = item / nblk, nb = item % nblk, k0 = 64 * kb, n0 = 32 * nb;
#pragma unroll
    for (int i = 0; i < 8; ++i) { const int kk = 8 * i + (lane >> 3), c4 = (lane & 7) * 4; const f32x4 v = *(const f32x4*)(W + (size_t)(k0 + kk) * ldw + n0 + c4);
        scr[kk * 33 + c4] = v.x; scr[kk * 33 + c4 + 1] = v.y; scr[kk * 33 + c4 + 2] = v.z; scr[kk * 33 + c4 + 3] = v.w; }
    LDS_WAIT(); asm volatile("" ::: "memory");
    const int c = lane & 7;
#pragma unroll
    for (int j = 0; j < 4; ++j) { const int n = (lane >> 3) + 8 * j; const LAS float* s = scr + (8 * c) * 33 + n;
        v4u o; o.x = pk2(s[0 * 33], s[1 * 33]); o.y = pk2(s[2 * 33], s[3 * 33]); o.z = pk2(s[4 * 33], s[5 * 33]); o.w = pk2(s[6 * 33], s[7 * 33]);
        *(GAS v4u*)(WT + (size_t)(row_off + n0 + n) * K + k0 + 8 * c) = o; }
    LDS_WAIT(); asm volatile("" ::: "memory");
}

typedef GAS unsigned gu32;
#define RLX_AGENT __ATOMIC_RELAXED, __HIP_MEMORY_SCOPE_AGENT
#define XB_TMO      128
#define XB_XCNT(j)  (256  + 64 * (j))
#define XB_XSUB(j)  (1280 + 64 * (j))
#define XB_XGEN(j)  (2304 + 64 * (j))
#define XB_TOP      3328
#define XB_TOPGEN   3392
#define XCD_BAR_WORDS 3456
#define XB_SPIN_CAP (1u << 18)

__device__ __forceinline__ unsigned xb_ld(unsigned* p)              { return __hip_atomic_load(p, __ATOMIC_RELAXED, __HIP_MEMORY_SCOPE_AGENT); }
__device__ __forceinline__ unsigned xb_add(unsigned* p, unsigned v) { return __hip_atomic_fetch_add(p, v, __ATOMIC_RELAXED, __HIP_MEMORY_SCOPE_AGENT); }
__device__ __forceinline__ unsigned xb_xcc_id() { return (unsigned)__builtin_amdgcn_s_getreg((3 << 11) | 20) & 0xFu; }
#define XB_SPIN(cond, bar) do { unsigned _sp = 0; while (cond) { __builtin_amdgcn_s_sleep(1); \
    if ((++_sp & 255u) == 0u) { if (xb_ld(&(bar)[XB_TMO])) break; if (_sp > XB_SPIN_CAP) { atomicAdd(&(bar)[XB_TMO], 1u); break; } } } } while (0)

struct XcdBarrier {
    unsigned* bar; unsigned x;
    volatile LAS unsigned* st;
};

__device__ __forceinline__ XcdBarrier xcd_barrier_post(unsigned* bar, volatile LAS unsigned* st) {
    XcdBarrier b; b.bar = bar; b.x = xb_xcc_id(); b.st = st;
    if (threadIdx.x == 0) (void)xb_add(&bar[XB_XCNT(b.x)], 1u);
    return b;
}
__device__ __forceinline__ void xcd_barrier_complete(unsigned* bar, unsigned x, unsigned& nloc, unsigned& nx) {
    const unsigned G = gridDim.x * gridDim.y * gridDim.z;
    unsigned sum, cnt, mine, sp = 0u;
    for (;;) {
        sum = 0u; cnt = 0u; mine = 0u;
#pragma unroll
        for (unsigned j = 0; j < 16; ++j) { const unsigned c = xb_ld(&bar[XB_XCNT(j)]); sum += c; cnt += (c > 0u) ? 1u : 0u; mine = (j == x) ? c : mine; }
        if (sum == G) break;
        __builtin_amdgcn_s_sleep(1);
        if ((++sp & 255u) == 0u) { if (xb_ld(&bar[XB_TMO])) break; if (sp > XB_SPIN_CAP) { atomicAdd(&bar[XB_TMO], 1u); break; } }
    }
    nloc = mine > 0u ? mine : 1u; nx = cnt > 0u ? cnt : 1u;
}

__device__ __forceinline__ void xcd_barrier(const XcdBarrier& b) {
    asm volatile("s_waitcnt vmcnt(0)" ::: "memory");
    __syncthreads();
    if (threadIdx.x == 0) {
        unsigned* bar = b.bar; unsigned xq = b.x; asm volatile("" : "+s"(bar), "+s"(xq));
        __builtin_amdgcn_s_waitcnt(0);
        unsigned nloc = b.st[0], nx = b.st[1];
        if (nloc == 0u) { xcd_barrier_complete(bar, xq, nloc, nx); b.st[0] = nloc; b.st[1] = nx; }
        const unsigned old = xb_add(&bar[XB_XSUB(xq)], 1u);
        const unsigned gen = old / nloc;
        if (old + 1u == (gen + 1u) * nloc) {
            __builtin_amdgcn_fence(__ATOMIC_RELEASE, "agent");
            asm volatile("s_waitcnt vmcnt(0)" ::: "memory");
            const unsigned og = xb_add(&bar[XB_TOP], 1u);
            const unsigned tg = og / nx;
            if (og + 1u == (tg + 1u) * nx) xb_add(&bar[XB_TOPGEN], 1u);
            else XB_SPIN(xb_ld(&bar[XB_TOPGEN]) == tg, bar);
            __builtin_amdgcn_fence(__ATOMIC_ACQUIRE, "agent");
            xb_add(&bar[XB_XGEN(xq)], 1u);
            asm volatile("s_waitcnt vmcnt(0)" ::: "memory");
        } else {
            XB_SPIN(xb_ld(&bar[XB_XGEN(xq)]) == gen, bar);
            __builtin_amdgcn_fence(__ATOMIC_ACQUIRE, "agent");
            asm volatile("s_waitcnt vmcnt(0)" ::: "memory");
        }
    }
    __syncthreads();
}

struct Ptrs {
    const float *x, *ln_emb_g, *ln_emb_b, *w_in, *fox_f_bias, *fox_norm_g, *hlb, *hgrn_norm_g, *w_o, *ln_mix_g, *ln_mix_b, *w_up, *conv_w, *conv_b, *w_down, *ln_ffn_g, *ln_ffn_b;
    float* out; unsigned char* ws;
};

__device__ __forceinline__ void prologue_weights(const Ptrs& P, LAS unsigned char* lds, int gw, int NGW, int wave, int lane, int gtid, int nthr) {
    LAS float* scr = (LAS float*)(lds + wave * 16384);
    bf16* win = (bf16*)(P.ws + WS_WIN); bf16* wo = (bf16*)(P.ws + WS_WO); bf16* wup = (bf16*)(P.ws + WS_WUP); bf16* wdn = (bf16*)(P.ws + WS_WDN);
    constexpr int IT0 = 16 * 48, IT1 = 16 * 64, IT2 = 16 * 32, IT3 = 44 * 16 * 4, IT7 = 44 * 32;
    constexpr int PER_LAYER = IT0 + IT1 + IT2 + IT3 + IT7;
    for (int it = gw; it < 2 * PER_LAYER; it += NGW) {
        const int l = it / PER_LAYER; int r = it % PER_LAYER;
        const float* wi = P.w_in + (size_t)l * 1024 * INC; const float* wu = P.w_up + (size_t)l * 1024 * 2 * DFF;
        bf16* winl = win + (size_t)l * NPROJ * 1024; bf16* wupl = wup + (size_t)l * 2 * DFF * 1024;
        if (r < IT0) { p0_transpose_item(wi, INC, 1024, 1536, winl, 0, scr, r, lane); continue; } r -= IT0;
        if (r < IT1) { p0_transpose_item(wi + 1544, INC, 1024, 2048, winl, 1536, scr, r, lane); continue; } r -= IT1;
        if (r < IT2) { p0_transpose_item(P.w_o + (size_t)l * 1024 * 1024, 1024, 1024, 1024, wo + (size_t)l * 1024 * 1024, 0, scr, r, lane); continue; } r -= IT2;
        if (r < IT3) { const int sgm = r >> 6, ri = r & 63; p0_transpose_item(wu + ((sgm & 1) ? DFF : 0) + (sgm >> 1) * 128, 2 * DFF, 1024, 128, wupl, sgm * 128, scr, ri, lane); continue; } r -= IT3;
        p0_transpose_item(P.w_down + (size_t)l * DFF * 1024, 1024, DFF, 1024, wdn + (size_t)l * 1024 * DFF, 0, scr, r, lane);
    }
    float* wfa = (float*)(P.ws + WS_WFA);
    for (int i = gtid; i < 2 * 8 * 1024; i += nthr) { const int l = i >> 13, j = (i >> 10) & 7, k = i & 1023; wfa[i] = P.w_in[(size_t)l * 1024 * INC + (size_t)k * INC + 1536 + j]; }
}


template <int LN_NR, bool FA> __device__ __forceinline__ void ln_phase(const float* xsrc, const bf16* xsrcb, const bf16* add, float alpha, float* xdst, bf16* XN, const float* g, const float* bta, const float* wfa, int wfa_ld, const float* fbias, float* lfa,
                                         LAS float* wl, int gw, int NGW, int lane, int tid) {
    if (FA && wfa_ld == 0) { for (int i = tid; i < 8 * 1024 / 4; i += NWAVES * 64) ((LAS f32x4*)wl)[i] = ((const f32x4*)wfa)[i]; __syncthreads(); }
    else if (FA) {
        for (int k = tid; k < 1024; k += NWAVES * 64) { const f32x4 a = *(const f32x4*)(wfa + (size_t)k * wfa_ld), b = *(const f32x4*)(wfa + (size_t)k * wfa_ld + 4);
            wl[k] = a.x; wl[1024 + k] = a.y; wl[2048 + k] = a.z; wl[3072 + k] = a.w; wl[4096 + k] = b.x; wl[5120 + k] = b.y; wl[6144 + k] = b.z; wl[7168 + k] = b.w; }
        __syncthreads(); }
    f32x4 gv[4], bv[4];
#pragma unroll
    for (int j = 0; j < 4; ++j) { gv[j] = ((const f32x4*)g)[lane + 64 * j]; bv[j] = ((const f32x4*)bta)[lane + 64 * j]; }
    const float fb = (FA && lane < 8) ? fbias[lane] : 0.f;
#pragma nounroll
    for (int m0 = gw; m0 < M; m0 += LN_NR * NGW) {
        f32x4 v[LN_NR][4]; unsigned long long av[LN_NR][4];
#pragma unroll
        for (int r = 0; r < LN_NR; ++r) { const int m = m0 + r * NGW;
            if (xsrc) { const GAS f32x4* xr = (const GAS f32x4*)(xsrc + (size_t)m * D) + lane;
#pragma unroll
                for (int j = 0; j < 4; ++j) v[r][j] = xr[64 * j]; }
            else { const GAS unsigned long long* xr = (const GAS unsigned long long*)(xsrcb + (size_t)m * D) + lane;
#pragma unroll
                for (int j = 0; j < 4; ++j) { const unsigned long long a = xr[64 * j]; const unsigned lo = (unsigned)a, hi = (unsigned)(a >> 32);
                    v[r][j] = (f32x4){__uint_as_float(lo << 16), __uint_as_float(lo & 0xffff0000u), __uint_as_float(hi << 16), __uint_as_float(hi & 0xffff0000u)}; } }
            if (add) { const GAS unsigned long long* ar = (const GAS unsigned long long*)(add + (size_t)m * D) + lane;
#pragma unroll
                for (int j = 0; j < 4; ++j) av[r][j] = ar[64 * j]; } }
#pragma unroll
        for (int r = 0; r < LN_NR; ++r) { const int m = m0 + r * NGW; float s = 0.f;
            if (add) {
#pragma unroll
                for (int j = 0; j < 4; ++j) { const unsigned lo = (unsigned)av[r][j], hi = (unsigned)(av[r][j] >> 32);
                    v[r][j] = v[r][j] * alpha + (f32x4){__uint_as_float(lo << 16), __uint_as_float(lo & 0xffff0000u), __uint_as_float(hi << 16), __uint_as_float(hi & 0xffff0000u)}; } }
#pragma unroll
            for (int j = 0; j < 4; ++j) s += (v[r][j].x + v[r][j].y) + (v[r][j].z + v[r][j].w);
            const float mean = wave_sum(s) * (1.f / D); float s2 = 0.f;
#pragma unroll
            for (int j = 0; j < 4; ++j) { v[r][j] = v[r][j] - mean; s2 += (v[r][j].x * v[r][j].x + v[r][j].y * v[r][j].y) + (v[r][j].z * v[r][j].z + v[r][j].w * v[r][j].w); }
            const float rstd = 1.f / sqrtf(wave_sum(s2) * (1.f / D) + LN_EPS);
#pragma unroll
            for (int j = 0; j < 4; ++j) v[r][j] = (v[r][j] * rstd) * gv[j] + bv[j];
            if (XN) { GAS unsigned long long* o8 = (GAS unsigned long long*)(XN + (size_t)m * D) + lane;
#pragma unroll
                for (int j = 0; j < 4; ++j) o8[64 * j] = (unsigned long long)pk2(v[r][j].x, v[r][j].y) | ((unsigned long long)pk2(v[r][j].z, v[r][j].w) << 32); }
            if (xdst) { GAS f32x4* o = (GAS f32x4*)(xdst + (size_t)m * D) + lane;
#pragma unroll
                for (int j = 0; j < 4; ++j) o[64 * j] = v[r][j]; }
            if (FA) { float mine = 0.f;
#pragma unroll
                for (int h = 0; h < 8; ++h) { float d = 0.f;
#pragma unroll
                    for (int j = 0; j < 4; ++j) { const f32x4 w = ((const LAS f32x4*)wl)[h * 256 + lane + 64 * j]; d += (v[r][j].x * w.x + v[r][j].y * w.y) + (v[r][j].z * w.z + v[r][j].w * w.w); }
                    d = wave_sum(d); if (lane == h) mine = d; }
                if (lane < 8) { const float z = mine + fb; lfa[(size_t)m * 8 + lane] = fminf(z, 0.f) - __logf(1.0f + __expf(-fabsf(z))); } } }
    }
}

__device__ __forceinline__ void cumsum_phase(const float* lfa, float* c2, int b, LAS float* scr, int tid, int wave, int lane) {
    const f32x4* src = (const f32x4*)(lfa + ((size_t)b * SEQ + 16 * tid) * 8);
    float a[16][8];
#pragma unroll
    for (int i = 0; i < 16; ++i) { const f32x4 p = src[2 * i], q = src[2 * i + 1]; a[i][0] = p.x; a[i][1] = p.y; a[i][2] = p.z; a[i][3] = p.w; a[i][4] = q.x; a[i][5] = q.y; a[i][6] = q.z; a[i][7] = q.w; }
#pragma unroll
    for (int i = 1; i < 16; ++i)
#pragma unroll
        for (int h = 0; h < 8; ++h) a[i][h] += a[i - 1][h];
    float off[8];
#pragma unroll
    for (int h = 0; h < 8; ++h) { float t = a[15][h], inc = t;
#pragma unroll
        for (int o = 1; o < 64; o <<= 1) { const float u = __shfl_up(inc, o); if (lane >= o) inc += u; }
        off[h] = inc - t; if (lane == 63) scr[wave * 8 + h] = inc; }
    __syncthreads();
#pragma unroll
    for (int h = 0; h < 8; ++h) { float p = 0.f; for (int w = 0; w < wave; ++w) p += scr[w * 8 + h]; off[h] += p; }
#pragma unroll
    for (int h = 0; h < 8; ++h) { f32x4* dst = (f32x4*)(c2 + ((size_t)(b * 8 + h)) * SEQ + 16 * tid);
#pragma unroll
        for (int i4 = 0; i4 < 4; ++i4) dst[i4] = (f32x4){(a[4 * i4][h] + off[h]) * LOG2E, (a[4 * i4 + 1][h] + off[h]) * LOG2E, (a[4 * i4 + 2][h] + off[h]) * LOG2E, (a[4 * i4 + 3][h] + off[h]) * LOG2E}; }
    __syncthreads();
}

#ifndef THR_EXTRA
#define THR_EXTRA 0.0f
#endif
__device__ __forceinline__ void fox_norms(const bf16* QA, const bf16* KA, unsigned* kmax, unsigned* qmax, int gw, int lane) {
    if (gw >= M / 16) return;
    float kq = 0.f, qq = 0.f;
#pragma unroll 4
    for (int i = 0; i < 16; ++i) { const size_t off = ((size_t)(16 * gw + i)) * 512 + lane * 8;
        const v4u kv = *(const v4u*)(KA + off), qv = *(const v4u*)(QA + off); float sk = 0.f, sq = 0.f;
#pragma unroll
        for (int j = 0; j < 4; ++j) { const float k0 = __uint_as_float(kv[j] << 16), k1 = __uint_as_float(kv[j] & 0xffff0000u), q0 = __uint_as_float(qv[j] << 16), q1 = __uint_as_float(qv[j] & 0xffff0000u); sk += k0 * k0 + k1 * k1; sq += q0 * q0 + q1 * q1; }
        sk += __shfl_xor(sk, 1); sk += __shfl_xor(sk, 2); sk += __shfl_xor(sk, 4); sq += __shfl_xor(sq, 1); sq += __shfl_xor(sq, 2); sq += __shfl_xor(sq, 4);
        kq = fmaxf(kq, sk); qq = fmaxf(qq, sq); }
    if ((lane & 7) == 0) { const int row0 = 16 * gw, b = row0 / SEQ, qb = (row0 % SEQ) / 256, h = lane >> 3;
        atomicMax(kmax + b * 8 + h, __float_as_uint(kq)); atomicMax(qmax + (b * 8 + h) * 32 + qb, __float_as_uint(qq)); }
}
__device__ __forceinline__ void fox_tstart(const float* c2, const unsigned* kmax, const unsigned* qmax, unsigned* tsout, int u) {
    if (u >= 1024) return;
    const int bh = u & 31, qb = u >> 5, q0 = qb * 256;
    const float kn = sqrtf(__uint_as_float(kmax[bh])) * 1.01f, qn = sqrtf(__uint_as_float(qmax[bh * 32 + qb])) * 1.01f;
    const float* cb = c2 + (size_t)bh * SEQ; const float thr = -170.0f - 2.0f * qn * kn - THR_EXTRA;
    const float cq0 = cb[q0];
    int T = q0 / 64 - 1;
    while (T >= 0 && !(cq0 - cb[64 * T + 63] < thr)) --T;
    int ts = (T + 1) & ~1; const int NTabs = q0 / 64 + 4; if (ts > NTabs - 4) ts = NTabs - 4;
    tsout[u] = (unsigned)ts;
}

__device__ __forceinline__ void gate_fixup(const float* halo, const float* cw, const float* cb, bf16* G, int gtid, int nthr) {
    const int ngrp = DFF / 4, nitems = (M / 64) * ngrp;
    for (int item = gtid; item < nitems; item += nthr) {
        const int blk = item / ngrp, ch = (item % ngrp) * 4;
        const float* h0 = halo + (size_t)blk * 4 * 5632 + ch;
        const f32x4 a0 = *(const f32x4*)(h0), u0 = *(const f32x4*)(h0 + 2816), a1 = *(const f32x4*)(h0 + 5632), u1 = *(const f32x4*)(h0 + 5632 + 2816);
        f32x4 pa62 = (f32x4){0.f, 0.f, 0.f, 0.f}, pa63 = pa62, pu62 = pa62, pu63 = pa62;
        if ((blk & 127) != 0) { const float* hp = h0 - 2 * 5632; pa62 = *(const f32x4*)(hp); pu62 = *(const f32x4*)(hp + 2816); pa63 = *(const f32x4*)(hp + 5632); pu63 = *(const f32x4*)(hp + 5632 + 2816); }
        const f32x4 wa0 = *(const f32x4*)(cw + ch), wa1 = *(const f32x4*)(cw + 5632 + ch), wa2 = *(const f32x4*)(cw + 2 * 5632 + ch), ba = *(const f32x4*)(cb + ch);
        const f32x4 wu0 = *(const f32x4*)(cw + 2816 + ch), wu1 = *(const f32x4*)(cw + 5632 + 2816 + ch), wu2 = *(const f32x4*)(cw + 2 * 5632 + 2816 + ch), bu = *(const f32x4*)(cb + 2816 + ch);
        const f32x4 ya0 = wa0 * pa62 + wa1 * pa63 + wa2 * a0 + ba, yu0 = wu0 * pu62 + wu1 * pu63 + wu2 * u0 + bu;
        const f32x4 ya1 = wa0 * pa63 + wa1 * a0 + wa2 * a1 + ba, yu1 = wu0 * pu63 + wu1 * u0 + wu2 * u1 + bu;
        const pg8::f32x2 g00 = pg8::gelu_pk((pg8::f32x2){ya0[0], ya0[1]}), g01 = pg8::gelu_pk((pg8::f32x2){ya0[2], ya0[3]}), g10 = pg8::gelu_pk((pg8::f32x2){ya1[0], ya1[1]}), g11 = pg8::gelu_pk((pg8::f32x2){ya1[2], ya1[3]});
        typedef unsigned u32x2f __attribute__((ext_vector_type(2)));
        *(u32x2f*)(G + (size_t)(blk * 64) * DFF + ch) = (u32x2f){pk2(g00.x * yu0[0], g00.y * yu0[1]), pk2(g01.x * yu0[2], g01.y * yu0[3])};
        *(u32x2f*)(G + (size_t)(blk * 64 + 1) * DFF + ch) = (u32x2f){pk2(g10.x * yu1[0], g10.y * yu1[1]), pk2(g11.x * yu1[2], g11.y * yu1[3])};
    }
}

namespace hg {
constexpr int QT_P = 272, KH_P = 144;
constexpr int O_QT = 0, O_KT = O_QT + 64 * QT_P, O_KH = O_KT + 64 * QT_P, O_VT = O_KH + 128 * KH_P, O_PB = O_VT + 128 * KH_P, O_BT = O_PB + 64 * KH_P, O_RS = O_BT + 2048, O_END = O_RS + 4096;
static_assert(O_END <= RING_BYTES, "hgrn lds");
constexpr int NITEMS = 16 * 128;
#define MFMA16(a, b, c) __builtin_amdgcn_mfma_f32_16x16x32_bf16((a), (b), (c), 0, 0, 0)
typedef float f32x2_t __attribute__((ext_vector_type(2))); typedef __bf16 bf16x2_t __attribute__((ext_vector_type(2)));
__device__ __forceinline__ unsigned cvtpk(float lo, float hi) { f32x2_t v = {lo, hi}; bf16x2_t b = __builtin_convertvector(v, bf16x2_t); return __builtin_bit_cast(unsigned, b); }
__device__ __forceinline__ void hgrn_prep(int first, int stride, bf16* QR, float* LF, const bf16* IR, const bf16* GR, bf16* U, bf16* QS, bf16* OI, float* DLg, LAS unsigned char* lds) {
    int tid_ = threadIdx.x; asm volatile("" : "+v"(tid_)); const int tid = tid_, lane = tid & 63, w = __builtin_amdgcn_readfirstlane(tid >> 6), n16 = lane & 15, g = lane >> 4;
    const int col = tid & 127, tq = tid >> 7;
    LAS unsigned char* QT = lds + O_QT; LAS unsigned char* KT = lds + O_KT; LAS unsigned char* KH = lds + O_KH; LAS unsigned char* VT = lds + O_VT; LAS unsigned char* PB = lds + O_PB;
    LAS float* BT = (LAS float*)(lds + O_BT);
    const int r32 = col & 31, qpos = (col & ~31) + ((r32 < 16) ? (8 * (r32 >> 2) + (r32 & 3)) : (8 * ((r32 - 16) >> 2) + 4 + (r32 & 3)));
    if (first >= NITEMS) return;
    float lf[16]; unsigned short qv[16], vv[16];
    { const int bh = first >> 7, c = first & 127; const size_t base = ((size_t)(bh >> 2) * SEQ + 64 * c + 16 * tq) * 512 + (bh & 3) * 128 + col;
#pragma unroll
      for (int i = 0; i < 16; ++i) { lf[i] = LF[base + (size_t)i * 512]; qv[i] = QR[base + (size_t)i * 512]; vv[i] = IR[base + (size_t)i * 512]; } }
    for (int it = first; it < NITEMS; it += stride) {
        float bl[16]; bl[0] = lf[0];
#pragma unroll
        for (int i = 1; i < 16; ++i) bl[i] = bl[i - 1] + lf[i];
        BT[tq * 128 + col] = bl[15];
        __syncthreads();
        const float t0 = BT[col], t1 = BT[128 + col], t2 = BT[256 + col], t3 = BT[384 + col];
        const float off = (tq == 0) ? 0.f : (tq == 1) ? t0 : (tq == 2) ? (t0 + t1) : (t0 + t1 + t2);
        const float bref = t0 + t1, blast = (t0 + t1) + (t2 + t3);
        unsigned khp[8], vtp[8];
        bf16* qsrow = QS + (size_t)it * 8192 + (size_t)(16 * tq) * 128 + qpos;
#pragma unroll
        for (int i = 0; i < 16; i += 2) {
            const float bb0 = bl[i] + off, bb1 = bl[i + 1] + off, k0 = 1.0f - __expf(lf[i]), k1 = 1.0f - __expf(lf[i + 1]), q0 = bf2f(qv[i]), q1 = bf2f(qv[i + 1]);
            const unsigned qs = cvtpk(q0 * __expf(fminf(bb0 - bref, 80.f)), q1 * __expf(fminf(bb1 - bref, 80.f)));
            const unsigned ks = cvtpk(k0 * __expf(fminf(bref - bb0, 80.f)), k1 * __expf(fminf(bref - bb1, 80.f)));
            const unsigned qa = cvtpk(q0 * __expf(bb0), q1 * __expf(bb1));
            khp[i >> 1] = cvtpk(k0 * __expf(blast - bb0), k1 * __expf(blast - bb1));
            vtp[i >> 1] = (unsigned)vv[i] | ((unsigned)vv[i + 1] << 16);
            *(LAS unsigned short*)(QT + (16 * tq + i) * QT_P + col * 2) = (unsigned short)qs; *(LAS unsigned short*)(QT + (16 * tq + i + 1) * QT_P + col * 2) = (unsigned short)(qs >> 16);
            *(LAS unsigned short*)(KT + (16 * tq + i) * QT_P + col * 2) = (unsigned short)ks; *(LAS unsigned short*)(KT + (16 * tq + i + 1) * QT_P + col * 2) = (unsigned short)(ks >> 16);
            qsrow[(size_t)i * 128] = (unsigned short)qa; qsrow[(size_t)(i + 1) * 128] = (unsigned short)(qa >> 16);
        }
        *(LAS v4u*)(KH + col * KH_P + 32 * tq) = (v4u){khp[0], khp[1], khp[2], khp[3]}; *(LAS v4u*)(KH + col * KH_P + 32 * tq + 16) = (v4u){khp[4], khp[5], khp[6], khp[7]};
        *(LAS v4u*)(VT + col * KH_P + 32 * tq) = (v4u){vtp[0], vtp[1], vtp[2], vtp[3]}; *(LAS v4u*)(VT + col * KH_P + 32 * tq + 16) = (v4u){vtp[4], vtp[5], vtp[6], vtp[7]};
        if (tq == 0) DLg[(size_t)it * 128 + col] = __expf(blast);
        if (it + stride < NITEMS) { const int nx = it + stride, bh = nx >> 7, c = nx & 127; const size_t base = ((size_t)(bh >> 2) * SEQ + 64 * c + 16 * tq) * 512 + (bh & 3) * 128 + col;
#pragma unroll
            for (int i = 0; i < 16; ++i) { lf[i] = LF[base + (size_t)i * 512]; qv[i] = QR[base + (size_t)i * 512]; vv[i] = IR[base + (size_t)i * 512]; } }
        __syncthreads();
        { const int tb = w >> 1;
#pragma unroll
          for (int jj = 0; jj < 2; ++jj) { const int sb = 2 * (w & 1) + jj; f32x4 p = (f32x4){0.f, 0.f, 0.f, 0.f};
              if (sb <= tb) {
#pragma unroll
                  for (int kk = 0; kk < 4; ++kk) { const bf16x8 A = *(const LAS bf16x8*)(QT + (16 * tb + n16) * QT_P + (32 * kk + 8 * g) * 2), B = *(const LAS bf16x8*)(KT + (16 * sb + n16) * QT_P + (32 * kk + 8 * g) * 2); p = MFMA16(A, B, p); }
                  if (sb == tb) {
#pragma unroll
                      for (int i = 0; i < 4; ++i) if (n16 > 4 * g + i) p[i] = 0.f; } }
#pragma unroll
              for (int i = 0; i < 4; ++i) *(LAS unsigned short*)(PB + (16 * tb + 4 * g + i) * KH_P + (16 * sb + n16) * 2) = (unsigned short)f2bf(p[i]); } }
        __syncthreads();
        bf16x8 vB[2];
#pragma unroll
        for (int kk = 0; kk < 2; ++kk) vB[kk] = *(const LAS bf16x8*)(VT + (16 * w + n16) * KH_P + (32 * kk + 8 * g) * 2);
#pragma unroll
        for (int mt = 0; mt < 4; ++mt) { f32x4 acc = (f32x4){0.f, 0.f, 0.f, 0.f};
#pragma unroll
            for (int kk = 0; kk < 2; ++kk) { const bf16x8 A = *(const LAS bf16x8*)(PB + (16 * mt + n16) * KH_P + (32 * kk + 8 * g) * 2); acc = MFMA16(A, vB[kk], acc); }
            *(unsigned long long*)(OI + (((size_t)it * 8 + w) * 4 + mt) * 256 + lane * 4) = (unsigned long long)cvtpk(acc[0], acc[1]) | ((unsigned long long)cvtpk(acc[2], acc[3]) << 32); }
#pragma unroll
        for (int j = 0; j < 8; ++j) { f32x4 acc = (f32x4){0.f, 0.f, 0.f, 0.f};
#pragma unroll
            for (int kk = 0; kk < 2; ++kk) { const bf16x8 A = *(const LAS bf16x8*)(KH + (16 * j + n16) * KH_P + (32 * kk + 8 * g) * 2); acc = MFMA16(A, vB[kk], acc); }
            { const int bh_ = it >> 7; const size_t T0_ = (size_t)(bh_ >> 2) * SEQ + 64 * (it & 127);
              *(unsigned long long*)((bf16*)(LF + (T0_ + 8 * w + j) * 512 + (bh_ & 3) * 128) + lane * 4) = (unsigned long long)cvtpk(acc[0], acc[1]) | ((unsigned long long)cvtpk(acc[2], acc[3]) << 32); } }
    }
    __syncthreads();
}
typedef unsigned u32x2 __attribute__((ext_vector_type(2)));
__device__ __forceinline__ f32x4 up4(u32x2 v) { return (f32x4){__uint_as_float(v.x << 16), __uint_as_float(v.x & 0xffff0000u), __uint_as_float(v.y << 16), __uint_as_float(v.y & 0xffff0000u)}; }
__device__ __forceinline__ void hgrn_scan(int task, float* LF, const float* DLg, int lane) {
    if (task >= 16 * 64) return;
    const int bh = task >> 6, wj = task & 63, g = lane >> 4;
    bf16* up = (bf16*)(LF + ((size_t)(bh >> 2) * SEQ + wj) * 512 + (bh & 3) * 128) + lane * 4;
    const float* dlp = DLg + (size_t)bh * 128 * 128 + 16 * (wj & 7) + 4 * g;
    f32x4 S = (f32x4){0.f, 0.f, 0.f, 0.f};
    u32x2 ub[8]; f32x4 db[8];
#pragma unroll
    for (int k = 0; k < 8; ++k) { ub[k] = *(const u32x2*)(up + (size_t)k * 65536); db[k] = *(const f32x4*)(dlp + (size_t)k * 128); }
#pragma nounroll
    for (int c0 = 0; c0 < SEQ / 64; c0 += 8) {
        u32x2 un[8]; f32x4 dn[8];
        if (c0 + 8 < SEQ / 64) {
#pragma unroll
            for (int k = 0; k < 8; ++k) { un[k] = *(const u32x2*)(up + (size_t)(c0 + 8 + k) * 65536); dn[k] = *(const f32x4*)(dlp + (size_t)(c0 + 8 + k) * 128); } }
        else {
#pragma unroll
            for (int k = 0; k < 8; ++k) { un[k] = (u32x2){0u, 0u}; dn[k] = (f32x4){0.f, 0.f, 0.f, 0.f}; } }
#pragma unroll
        for (int k = 0; k < 8; ++k) { *(u32x2*)(up + (size_t)(c0 + k) * 65536) = (u32x2){cvtpk(S[0], S[1]), cvtpk(S[2], S[3])}; S = S * db[k] + up4(ub[k]); }
#pragma unroll
        for (int k = 0; k < 8; ++k) { ub[k] = un[k]; db[k] = dn[k]; }
    }
}
__device__ __forceinline__ void hgrn_out_phase(int first, int stride, const float* LF, const bf16* QS, const bf16* OI, const bf16* GQ, const float* gnorm, bf16* MIX, LAS unsigned char* lds) {
    int tid_ = threadIdx.x; asm volatile("" : "+v"(tid_)); const int tid = tid_, lane = tid & 63, w = __builtin_amdgcn_readfirstlane(tid >> 6), n16 = lane & 15, g = lane >> 4;
    if (first >= NITEMS) return;
    LAS float* RS = (LAS float*)(lds + O_RS);
    bf16x8 qf[4][4]; u32x2 oif[4], sp[8]; unsigned short gq[16];
#define HO_LOAD(IT) do { const int bh_ = (IT) >> 7, hc_ = (bh_ & 3) * 128; const size_t T0_ = (size_t)(bh_ >> 2) * SEQ + 64 * ((IT) & 127); \
      _Pragma("unroll") for (int mt = 0; mt < 4; ++mt) { _Pragma("unroll") for (int kk = 0; kk < 4; ++kk) qf[mt][kk] = *(const bf16x8*)(QS + (size_t)(IT) * 8192 + (16 * mt + n16) * 128 + 32 * kk + 8 * g); \
          oif[mt] = *(const u32x2*)(OI + (((size_t)(IT) * 8 + w) * 4 + mt) * 256 + lane * 4); \
          _Pragma("unroll") for (int i = 0; i < 4; ++i) gq[4 * mt + i] = GQ[(T0_ + 16 * mt + 4 * g + i) * 512 + hc_ + 16 * w + n16]; } \
      _Pragma("unroll") for (int j = 0; j < 8; ++j) sp[j] = *(const u32x2*)((const bf16*)(LF + (T0_ + 8 * w + j) * 512 + hc_) + lane * 4); } while (0)
    HO_LOAD(first);
    int par = 0;
    for (int it = first; it < NITEMS; it += stride, par ^= 1) {
        const int bh = it >> 7, hc = (bh & 3) * 128; const size_t T0 = (size_t)(bh >> 2) * SEQ + 64 * (it & 127);
        const float gn = gnorm[hc + 16 * w + n16];
        f32x4 o[4], gf[4];
#pragma unroll
        for (int mt = 0; mt < 4; ++mt) { f32x4 acc = up4(oif[mt]); gf[mt] = (f32x4){bf2f(gq[4 * mt]), bf2f(gq[4 * mt + 1]), bf2f(gq[4 * mt + 2]), bf2f(gq[4 * mt + 3])};
#pragma unroll
            for (int kk = 0; kk < 4; ++kk) acc = MFMA16(qf[mt][kk], __builtin_bit_cast(bf16x8, (v4u){sp[2 * kk].x, sp[2 * kk].y, sp[2 * kk + 1].x, sp[2 * kk + 1].y}), acc);
            o[mt] = acc; }
        asm volatile("" ::: "memory");
        if (it + stride < NITEMS) HO_LOAD(it + stride);
        LAS float* RSc = RS + par * 512;
#pragma unroll
        for (int mt = 0; mt < 4; ++mt) { f32x4 q = o[mt] * o[mt];
#pragma unroll
            for (int sh = 1; sh < 16; sh <<= 1) { q[0] += __shfl_xor(q[0], sh); q[1] += __shfl_xor(q[1], sh); q[2] += __shfl_xor(q[2], sh); q[3] += __shfl_xor(q[3], sh); }
            if (n16 == 0) *(LAS f32x4*)(RSc + w * 64 + 16 * mt + 4 * g) = q; }
        asm volatile("s_waitcnt lgkmcnt(0)\n\ts_barrier" ::: "memory");
#pragma unroll
        for (int mt = 0; mt < 4; ++mt) { f32x4 tot = (f32x4){0.f, 0.f, 0.f, 0.f};
#pragma unroll
            for (int ww = 0; ww < 8; ++ww) tot += *(const LAS f32x4*)(RSc + ww * 64 + 16 * mt + 4 * g);
#pragma unroll
            for (int i = 0; i < 4; ++i) { const float r = __builtin_amdgcn_rsqf(tot[i] * (1.f / 128.f) + RMS_EPS); const float val = o[mt][i] * r * gn * gf[mt][i];
                MIX[(T0 + 16 * mt + 4 * g + i) * 1024 + 512 + hc + 16 * w + n16] = (unsigned short)f2bf(val); } }
    }
    __syncthreads();
#undef HO_LOAD
}
}
namespace cg = cooperative_groups;
#ifndef PHM
#define PHM 0xffff
#endif
#define PH(b) if constexpr ((PHM >> (b)) & 1)
#ifndef DUPP
#define DUPP 0
#endif
#define GSYNC() do { xcd_barrier(xbar); if (DUPP == 9) xcd_barrier(xbar); } while (0)
#ifndef PG8_SP2_
#define PG8_SP2_ true
#endif
#ifndef PG8_ALIGN_UP
#define PG8_ALIGN_UP true
#endif
#ifndef PG8_ALIGN_
#define PG8_ALIGN_ true
#endif
#define REP(k) for (int rep_ = 0; rep_ < ((DUPP == (k)) ? 2 : 1); ++rep_)
struct Args { Ptrs p; };
#define FRESH_IDS() int tid = threadIdx.x; asm volatile("" : "+v"(tid)); const int lane = tid & 63, wave = __builtin_amdgcn_readfirstlane(tid >> 6); const int gw = bx * NWAVES + wave, gtid = bx * (NWAVES * 64) + tid; (void)lane; (void)gw; (void)gtid;
__global__ void __launch_bounds__(NWAVES * 64, 2) fwd_megakernel(Args args) {
    extern __shared__ __attribute__((aligned(16))) unsigned char lds_raw[];
    cg::grid_group grid = cg::this_grid();
    const Ptrs& P = args.p;
    LAS unsigned char* lds = (LAS unsigned char*)lds_raw;
    volatile LAS int* MISC = (volatile LAS int*)(lds + MISC_OFF);
    const int G = gridDim.x, bx = blockIdx.x;
    const int NGW = G * NWAVES, nthr = G * NWAVES * 64;
    unsigned char* ws = P.ws;
    unsigned* ctl = (unsigned*)(ws + WS_CTL);
    if (threadIdx.x < 32) ((LAS unsigned*)(lds + MISC_OFF))[threadIdx.x] = 0u;
    __syncthreads();
    const XcdBarrier xbar = xcd_barrier_post(ctl + CW_BAR, (volatile LAS unsigned*)(lds + MISC_OFF) + 8);
    float* c2 = (float*)(ws + WS_C2); float* lfa = (float*)(ws + WS_LFA); const float* wfa = (const float*)(ws + WS_WFA);
    bf16* XN = (bf16*)(ws + WS_XN); bf16* slot0 = (bf16*)(ws + WS_SLOT0); bf16* MIX = (bf16*)(ws + WS_MIX); bf16* GB = (bf16*)(ws + WS_G); bf16* SUB = (bf16*)(ws + WS_SUB);

    REP(5) PH(0) { FRESH_IDS(); prologue_weights(P, lds, gw, NGW, wave, lane, gtid, nthr); }
    __syncthreads();
    PH(1) { FRESH_IDS(); ln_phase<2, true>(P.x, nullptr, nullptr, 1.f, nullptr, XN, P.ln_emb_g, P.ln_emb_b, P.w_in + 1536, INC, P.fox_f_bias, lfa, (LAS float*)lds, gw, NGW, lane, tid); }
    grid.sync();

#pragma nounroll
    for (int l = 0; l < 2; ++l) {
        PH(2) if (bx < BATCH) { FRESH_IDS(); cumsum_phase(lfa, c2, bx, (LAS float*)lds, tid, wave, lane); }
        REP(1) { if (rep_) GSYNC();
        PH(3) { pg8::Gemm g{XN, (const bf16*)(ws + WS_WIN) + (size_t)l * NPROJ * 1024, M, NPROJ, D}; pg8::StaticOrder S; S.init(M, NPROJ, G, bx);
          pg8::EpiProj E{slot0, P.hlb, l, attn_body::C2};
          pg8::gemm_phase<pg8::EpiProj, pg8::StaticOrder, PG8_ALIGN_, PG8_SP2_>(lds, g, S, E); } }
        GSYNC();
        PH(5) { FRESH_IDS(); fox_norms(slot0, slot0 + pg8::SLOT_ELEMS, ctl + CW_KMAX + 32 * l, ctl + CW_QMAX + 1024 * l, gw, lane); }
        REP(4) { if (rep_) GSYNC();
        PH(4) hg::hgrn_prep(bx, G, slot0 + 3 * pg8::SLOT_ELEMS, (float*)(slot0 + 4 * pg8::SLOT_ELEMS), slot0 + 6 * pg8::SLOT_ELEMS, slot0 + 7 * pg8::SLOT_ELEMS, nullptr, (bf16*)(ws + WS_HQS), (bf16*)(ws + WS_HOI), (float*)(ws + WS_HDL), lds); }
        GSYNC();
        PH(4) { FRESH_IDS(); hg::hgrn_scan(gw, (float*)(slot0 + 4 * pg8::SLOT_ELEMS), (const float*)(ws + WS_HDL), lane);
                if (gw >= 1024) fox_tstart(c2, ctl + CW_KMAX + 32 * l, ctl + CW_QMAX + 1024 * l, ctl + CW_TS + 1024 * l, gtid - 1024 * 64); }
        GSYNC();
#ifndef DUP_MIX
#define DUP_MIX 0
#endif
        for (int rep = 0; rep < (DUP_MIX ? 2 : 1); ++rep) { unsigned* ctr = ctl + 64 * (l + 2 * rep); const bool do_h = (rep == 0) || (DUP_MIX & 1), do_a = (rep == 0) || (DUP_MIX & 2);
          const bf16* QA = slot0; const bf16* KA = slot0 + pg8::SLOT_ELEMS; const bf16* VA = slot0 + 2 * pg8::SLOT_ELEMS;
          int nxt_it = 0, nxt_ts = 0; if (threadIdx.x == 0) { nxt_it = (int)atomicAdd(ctr, 1u); nxt_ts = (nxt_it < 1024) ? (int)ctl[CW_TS + 1024 * l + (nxt_it & 31) + 32 * (31 - (nxt_it >> 5))] : 0; }
          for (;;) {
              FRESH_IDS();
              if (tid == 0) { MISC[16] = nxt_it; MISC[17] = nxt_ts; }
              __syncthreads();
              const int it = MISC[16], its = MISC[17];
              __syncthreads();
              if (it >= 1024) break;
              if (tid == 0) { nxt_it = (int)atomicAdd(ctr, 1u); nxt_ts = (nxt_it < 1024) ? (int)ctl[CW_TS + 1024 * l + (nxt_it & 31) + 32 * (31 - (nxt_it >> 5))] : 0; }
              PH(5) if (do_a) { const int idx = it, qb = 31 - (idx >> 5), bh = idx & 31;
                     attn_body::attn_unit<60>(bh >> 3, bh & 7, qb, (const attn_body::bf16*)QA, (const attn_body::bf16*)KA, (const attn_body::bf16*)VA, (attn_body::bf16*)MIX, c2, P.fox_norm_g + l * 512, (int)__builtin_amdgcn_readfirstlane(its), (char*)lds_raw); }
          }
          PH(4) if (do_h) hg::hgrn_out_phase(bx, G, (const float*)(slot0 + 4 * pg8::SLOT_ELEMS), (const bf16*)(ws + WS_HQS), (const bf16*)(ws + WS_HOI), slot0 + 7 * pg8::SLOT_ELEMS, P.hgrn_norm_g + l * 512, MIX, lds);
          if (DUP_MIX && rep == 0) GSYNC(); }
        GSYNC();
        REP(6) { if (rep_) GSYNC();
        PH(6) { pg8::Gemm g{MIX, (const bf16*)(ws + WS_WO) + (size_t)l * 1024 * 1024, M, D, D}; pg8::StaticOrder S; S.init(M, D, G, bx);
          pg8::EpiBf16<0> E{SUB, D, nullptr, 0, 0, 1.f};
          pg8::gemm_phase<pg8::EpiBf16<0>, pg8::StaticOrder, PG8_ALIGN_, PG8_SP2_>(lds, g, S, E); } }
        GSYNC();
        REP(3) { if (rep_) GSYNC();
        PH(1) { FRESH_IDS(); ln_phase<4, false>(nullptr, XN, SUB, DN_ALPHA, nullptr, (DUPP == 3 && rep_ == 0) ? (bf16*)(ws + 200 * MiB) : XN, P.ln_mix_g + l * D, P.ln_mix_b + l * D, nullptr, 0, nullptr, nullptr, (LAS float*)lds, gw, NGW, lane, tid); } }
        GSYNC();
        REP(2) { if (rep_) GSYNC();
        PH(7) { pg8::Gemm g{XN, (const bf16*)(ws + WS_WUP) + (size_t)l * 2 * DFF * 1024, M, 2 * DFF, D}; pg8::StaticOrder S; S.init(M, 2 * DFF, G, bx);
          pg8::EpiGate E{GB, (float*)(ws + WS_HALO), P.conv_w + (size_t)l * 3 * 2 * DFF, P.conv_b + (size_t)l * 2 * DFF};
          pg8::gemm_phase<pg8::EpiGate, pg8::StaticOrder, PG8_ALIGN_UP, PG8_SP2_>(lds, g, S, E); } }
        GSYNC();
        REP(8) { if (rep_) GSYNC();
        PH(8) { FRESH_IDS(); gate_fixup((const float*)(ws + WS_HALO), P.conv_w + (size_t)l * 3 * 2 * DFF, P.conv_b + (size_t)l * 2 * DFF, GB, gtid, nthr); } }
        GSYNC();
        REP(7) { if (rep_) GSYNC();
        PH(6) { pg8::Gemm g{GB, (const bf16*)(ws + WS_WDN) + (size_t)l * 1024 * DFF, M, D, DFF}; pg8::StaticOrder S; S.init(M, D, G, bx);
          pg8::EpiBf16<0> E{SUB, D, nullptr, 0, 0, 1.f};
          pg8::gemm_phase<pg8::EpiBf16<0>, pg8::StaticOrder, PG8_ALIGN_, PG8_SP2_>(lds, g, S, E); } }
        GSYNC();
        if (l == 0) { PH(1) { FRESH_IDS(); ln_phase<2, true>(nullptr, XN, SUB, DN_ALPHA, nullptr, XN, P.ln_ffn_g, P.ln_ffn_b, wfa + 8 * 1024, 0, P.fox_f_bias + 8, lfa, (LAS float*)lds, gw, NGW, lane, tid); } GSYNC(); }
        else PH(1) { FRESH_IDS(); ln_phase<4, false>(nullptr, XN, SUB, DN_ALPHA, P.out, nullptr, P.ln_ffn_g + D, P.ln_ffn_b + D, nullptr, 0, nullptr, nullptr, (LAS float*)lds, gw, NGW, lane, tid); }
    }
}

extern "C" void kernel_launch(void* const* d_in, const int* in_sizes, int n_in, void* d_out, int out_size, void* d_ws, size_t ws_size, hipStream_t stream) {
    static int grid = 0;
    if (grid == 0) {
        if (n_in != 17 || in_sizes[0] != M * D || out_size != M * D || ws_size < WS_END) { fprintf(stderr, "kernel_launch: unexpected shapes: n_in %d in0 %d out %d ws %zu\n", n_in, n_in > 0 ? in_sizes[0] : -1, out_size, ws_size); grid = -1; return; }
        int dev = 0, cus = 0, per_cu = 0;
        if (hipGetDevice(&dev) != hipSuccess || hipDeviceGetAttribute(&cus, hipDeviceAttributeMultiprocessorCount, dev) != hipSuccess) { fprintf(stderr, "kernel_launch: device query failed\n"); grid = -1; return; }
        if (hipFuncSetAttribute((const void*)fwd_megakernel, hipFuncAttributeMaxDynamicSharedMemorySize, LDS_BYTES) != hipSuccess) { fprintf(stderr, "kernel_launch: hipFuncSetAttribute failed\n"); grid = -1; return; }
        if (hipOccupancyMaxActiveBlocksPerMultiprocessor(&per_cu, (const void*)fwd_megakernel, NWAVES * 64, LDS_BYTES) != hipSuccess || per_cu < 1) { fprintf(stderr, "kernel_launch: occupancy query says %d blocks/CU\n", per_cu); per_cu = 1; }
        (void)hipGetLastError();
        grid = cus;
    }
    if (grid < 0) return;
    (void)hipMemsetAsync((char*)d_ws + WS_CTL, 0, CTL_ZERO_BYTES, stream);
    Args a{};
    const float** pp = (const float**)&a.p;
    for (int i = 0; i < 17; ++i) pp[i] = (const float*)d_in[i];
    a.p.out = (float*)d_out; a.p.ws = (unsigned char*)d_ws;
    void* kargs[] = {&a};
    const hipError_t e = hipLaunchCooperativeKernel((const void*)fwd_megakernel, dim3(grid), dim3(NWAVES * 64), kargs, LDS_BYTES, stream);
    if (e != hipSuccess) fprintf(stderr, "kernel_launch: cooperative launch failed: %s (grid %d)\n", hipGetErrorString(e), grid);
}
```

```cpp
#include <hip/hip_runtime.h>
#include <hip/hip_cooperative_groups.h>
#include <hip/hip_bf16.h>
#include <cstdio>
#include <cstdint>
#include <cmath>
namespace pg8 {
#define PG8_LAS __attribute__((address_space(3)))
typedef unsigned short bf16_t;
typedef short bf16x8 __attribute__((ext_vector_type(8)));
typedef float f32x4 __attribute__((ext_vector_type(4)));
typedef unsigned u32x4 __attribute__((ext_vector_type(4)));
constexpr int BM = 256, BK = 64, HALF = 128, HTB = HALF * BK * 2  , STAGE_BYTES = 8 * HTB, NXCD = 8, WGM = 4;

__host__ __device__ __forceinline__ int lds_byte(int r, int c) { const int st = (r >> 4) * 2 + (c >> 5), rr = r & 15, cc = c & 31, ob = rr * 64 + cc * 2; return st * 1024 + (ob ^ (((ob >> 9) & 1) << 5)); }
__host__ __device__ __forceinline__ void stage_rc(int b, int& R, int& C) { const int st = b / 1024, sb = b % 1024, swz = sb ^ (((sb >> 9) & 1) << 5); R = (st >> 1) * 16 + swz / 64; C = (st & 1) * 32 + (swz % 64) / 2; }
__host__ __device__ __forceinline__ int perm32(int rho) { const int n = rho >> 4, i = rho & 15; return 8 * (i >> 2) + 4 * n + (i & 3); }

struct Unit { int pm, pn; };
struct Gemm { const bf16_t* A; const bf16_t* Bt; int M, N, K; };

struct StaticOrder {
    int nM, nN, nwg, G, c;
    __host__ __device__ void init(int M, int N, int G_, int c_) { nM = M / BM; nN = N / BM; nwg = nM * nN; G = G_; c = c_; }
    __host__ __device__ bool next(int i, Unit& u) const {
        const long L = (long)i * G + c; if (L >= nwg) return false;
        int wgid = (int)L; { const int q = nwg / NXCD, r = nwg % NXCD, xcd = wgid % NXCD, off = wgid / NXCD; wgid = (xcd < r ? xcd * (q + 1) : r * (q + 1) + (xcd - r) * q) + off; }
        const int nig = WGM * nN, gid = wgid / nig, fm = gid * WGM, gsz = (nM - fm) < WGM ? (nM - fm) : WGM;
        u.pm = fm + ((wgid % nig) % gsz); u.pn = (wgid % nig) / gsz; return true;
    }
    __device__ __forceinline__ void a_ready(const Unit&) const {}
    __device__ __forceinline__ void done(const Unit&) const {}
};

typedef float f32x2c __attribute__((ext_vector_type(2))); typedef __bf16 bf16x2c __attribute__((ext_vector_type(2)));
__device__ __forceinline__ unsigned cvt_pk_bf16(float lo, float hi) { f32x2c v = {lo, hi}; bf16x2c b = __builtin_convertvector(v, bf16x2c); return __builtin_bit_cast(unsigned, b); }
typedef float f32x2 __attribute__((ext_vector_type(2)));
__device__ __forceinline__ f32x2 gelu_pk(f32x2 v) {
    const f32x2 av = __builtin_elementwise_abs(v), d = av * 0.2316418882f + 1.0f;
    f32x2 t; t.x = __builtin_amdgcn_rcpf(d.x); t.y = __builtin_amdgcn_rcpf(d.y);
    f32x2 q = t * 0.5307027145f + (-0.7265760135f); q = q * t + 0.7107068705f; q = q * t + (-0.142248368f); q = q * t + 0.127414796f; q = q * t;
    const f32x2 s = (v * v) * (-0.72134752044f);
    f32x2 e; e.x = __builtin_amdgcn_exp2f(s.x); e.y = __builtin_amdgcn_exp2f(s.y);
    f32x2 p; p.x = fmaxf(v.x, 0.f); p.y = fmaxf(v.y, 0.f);
    return p - av * (q * e);
}

template <int ACT  > struct EpiBf16 {
    static constexpr bool PERM = true, AFTER_DRAIN = false; static_assert(ACT == 0 || ACT == 1, "EpiBf16: ACT is 0 (none) or 1 (gelu_pk)");
    bf16_t* O; int ldc; const float* bias; int split_cols; size_t split_stride; float scale0;
    __device__ __forceinline__ void operator()(const f32x4 (&acc)[2][2][4][2], const Unit& u, int wr, int wc, int fr, int fq) const {
        const int row0 = u.pm * BM + wr * 64 + fr; int colt = u.pn * BM; bf16_t* base = O;
        float sc = 1.f; if (split_cols) { const int t = colt / split_cols; base += (size_t)t * split_stride; colt -= t * split_cols; if (t == 0) sc = scale0; }
        const int col0 = colt + wc * 32 + 8 * fq, bcol0 = u.pn * BM + wc * 32 + 8 * fq;
        f32x4 bv[2][2];
#pragma unroll
        for (int bj = 0; bj < 2; ++bj)
#pragma unroll
            for (int n = 0; n < 2; ++n) bv[bj][n] = bias ? *(const f32x4*)(bias + bcol0 + bj * HALF + 4 * n) : (f32x4){0.f, 0.f, 0.f, 0.f};
#pragma unroll
        for (int ai = 0; ai < 2; ++ai)
#pragma unroll
            for (int m = 0; m < 4; ++m) { bf16_t* rowp = base + (size_t)(row0 + ai * HALF + m * 16) * ldc + col0;
#pragma unroll
                for (int bj = 0; bj < 2; ++bj) { f32x4 v0 = acc[ai][bj][m][0] + bv[bj][0], v1 = acc[ai][bj][m][1] + bv[bj][1];
                    if (ACT == 1) { f32x2 a = gelu_pk((f32x2){v0[0], v0[1]}), b = gelu_pk((f32x2){v0[2], v0[3]}), c = gelu_pk((f32x2){v1[0], v1[1]}), d = gelu_pk((f32x2){v1[2], v1[3]});
                        v0 = (f32x4){a.x, a.y, b.x, b.y}; v1 = (f32x4){c.x, c.y, d.x, d.y}; }
                    v0 = v0 * sc; v1 = v1 * sc; u32x4 w; w.x = cvt_pk_bf16(v0[0], v0[1]); w.y = cvt_pk_bf16(v0[2], v0[3]); w.z = cvt_pk_bf16(v1[0], v1[1]); w.w = cvt_pk_bf16(v1[2], v1[3]);
                    *(u32x4*)(rowp + bj * HALF) = w; } }
    }
};
__device__ __forceinline__ float silu_f(float x) { return x * __builtin_amdgcn_rcpf(1.0f + __expf(-x)); }
constexpr size_t SLOT_ELEMS = (size_t)32768 * 512;
struct EpiProj {
    static constexpr bool PERM = true, AFTER_DRAIN = false;
    bf16_t* base0; const float* hlb; int layer; float qscale;
    template <int MODE  > __device__ __forceinline__ void st_bf16(const f32x4 (&acc)[2][2][4][2], bf16_t* base, int row0, int col0, float sc) const {
#pragma unroll
        for (int ai = 0; ai < 2; ++ai)
#pragma unroll
            for (int m = 0; m < 4; ++m) { bf16_t* rowp = base + (size_t)(row0 + ai * HALF + m * 16) * 512 + col0;
#pragma unroll
                for (int bj = 0; bj < 2; ++bj) { f32x4 v0 = acc[ai][bj][m][0], v1 = acc[ai][bj][m][1];
                    if (MODE == 2) { v0 = (f32x4){silu_f(v0[0]), silu_f(v0[1]), silu_f(v0[2]), silu_f(v0[3])}; v1 = (f32x4){silu_f(v1[0]), silu_f(v1[1]), silu_f(v1[2]), silu_f(v1[3])}; }
                    if (MODE == 1) { v0 = v0 * sc; v1 = v1 * sc; }
                    u32x4 w; w.x = cvt_pk_bf16(v0[0], v0[1]); w.y = cvt_pk_bf16(v0[2], v0[3]); w.z = cvt_pk_bf16(v1[0], v1[1]); w.w = cvt_pk_bf16(v1[2], v1[3]);
                    *(u32x4*)(rowp + bj * HALF) = w; } }
    }
    template <bool LB0> static __device__ __forceinline__ float logf_gate(float z, float l) {
        const float e = __expf(-fabsf(z));
        if (LB0) return fminf(z, 0.f) - __logf(1.0f + e);
        const float r = __builtin_amdgcn_rcpf(1.0f + e); const float sg = (z >= 0.f) ? r : e * r;
        return __logf(l + (1.0f - l) * sg);
    }
    template <bool LB0> static __device__ __forceinline__ f32x4 logf_gate4(f32x4 v, f32x4 l) { return (f32x4){logf_gate<LB0>(v[0], l[0]), logf_gate<LB0>(v[1], l[1]), logf_gate<LB0>(v[2], l[2]), logf_gate<LB0>(v[3], l[3])}; }
    __device__ __forceinline__ f32x4 lb4(int c) const {
        const f32x4 h0 = *(const f32x4*)(hlb + c), h1 = *(const f32x4*)(hlb + 512 + c);
        return (f32x4){__builtin_amdgcn_rcpf(1.0f + __expf(h0[0] - h1[0])), __builtin_amdgcn_rcpf(1.0f + __expf(h0[1] - h1[1])), __builtin_amdgcn_rcpf(1.0f + __expf(h0[2] - h1[2])), __builtin_amdgcn_rcpf(1.0f + __expf(h0[3] - h1[3]))};
    }
    template <bool LB0> __device__ __forceinline__ void st_logf(const f32x4 (&acc)[2][2][4][2], float* base, int row0, int col0) const {
        const f32x4 z4 = (f32x4){0.f, 0.f, 0.f, 0.f};
        const f32x4 lA0 = LB0 ? z4 : lb4(col0), lA1 = LB0 ? z4 : lb4(col0 + 4), lB0 = LB0 ? z4 : lb4(col0 + HALF), lB1 = LB0 ? z4 : lb4(col0 + HALF + 4);
#pragma unroll
        for (int ai = 0; ai < 2; ++ai)
#pragma unroll
            for (int m = 0; m < 4; ++m) { float* rowp = base + (size_t)(row0 + ai * HALF + m * 16) * 512 + col0;
                *(f32x4*)(rowp) = logf_gate4<LB0>(acc[ai][0][m][0], lA0); *(f32x4*)(rowp + 4) = logf_gate4<LB0>(acc[ai][0][m][1], lA1);
                *(f32x4*)(rowp + HALF) = logf_gate4<LB0>(acc[ai][1][m][0], lB0); *(f32x4*)(rowp + HALF + 4) = logf_gate4<LB0>(acc[ai][1][m][1], lB1); }
    }
    __device__ __forceinline__ void operator()(const f32x4 (&acc)[2][2][4][2], const Unit& u, int wr, int wc, int fr, int fq) const {
        const int t = u.pn >> 1, colt = (u.pn & 1) * 256, slot = t < 5 ? t : t + 1;
        const int row0 = u.pm * BM + wr * 64 + fr, col0 = colt + wc * 32 + 8 * fq;
        bf16_t* base = base0 + (size_t)slot * SLOT_ELEMS;
        if (t == 4) { if (layer == 0) st_logf<true>(acc, (float*)base, row0, col0); else st_logf<false>(acc, (float*)base, row0, col0); }
        else if (t == 0) st_bf16<1>(acc, base, row0, col0, qscale);
        else if (t == 3 || t == 6) st_bf16<2>(acc, base, row0, col0, 1.f);
        else st_bf16<0>(acc, base, row0, col0, 1.f);
    }
};
struct EpiRes {
    static constexpr bool PERM = false, AFTER_DRAIN = false;
    const float* ysrc; float* ydst; const float* stats; const float* g; const float* b; float alpha;
    __device__ __forceinline__ void operator()(const f32x4 (&acc)[2][2][4][2], const Unit& u, int wr, int wc, int fr, int fq) const {
        const int col0 = u.pn * BM + wc * 32 + 4 * fq, rowb = u.pm * BM + wr * 64 + fr;
        float mu[2][4], rs[2][4];
#pragma unroll
        for (int ai = 0; ai < 2; ++ai)
#pragma unroll
            for (int m = 0; m < 4; ++m) { const f32x2 st = *(const f32x2*)(stats + 2 * (rowb + ai * HALF + m * 16)); mu[ai][m] = st.x; rs[ai][m] = st.y; }
#pragma unroll
        for (int bj = 0; bj < 2; ++bj)
#pragma unroll
            for (int n = 0; n < 2; ++n) { const int c = col0 + bj * HALF + n * 16;
                f32x4 y[2][4];
#pragma unroll
                for (int ai = 0; ai < 2; ++ai)
#pragma unroll
                    for (int m = 0; m < 4; ++m) y[ai][m] = *(const f32x4*)(ysrc + (size_t)(rowb + ai * HALF + m * 16) * 1024 + c);
                const f32x4 gv = *(const f32x4*)(g + c), bv = *(const f32x4*)(b + c);
#pragma unroll
                for (int ai = 0; ai < 2; ++ai)
#pragma unroll
                    for (int m = 0; m < 4; ++m) { const f32x4 o = (((y[ai][m] - mu[ai][m]) * rs[ai][m]) * gv + bv) * alpha + acc[ai][bj][m][n];
                        *(f32x4*)(ydst + (size_t)(rowb + ai * HALF + m * 16) * 1024 + c) = o; }
                asm volatile("" ::: "memory"); }
    }
};
struct EpiGate {
    static constexpr bool PERM = true, AFTER_DRAIN = false;
    bf16_t* G; float* halo; const float* cw; const float* cb;
    static __device__ __forceinline__ float ror1(float v) { return __builtin_bit_cast(float, __builtin_amdgcn_mov_dpp(__builtin_bit_cast(int, v), 0x121, 0xf, 0xf, false)); }
    static __device__ __forceinline__ float ror2(float v) { return __builtin_bit_cast(float, __builtin_amdgcn_mov_dpp(__builtin_bit_cast(int, v), 0x122, 0xf, 0xf, false)); }
    static __device__ __forceinline__ f32x4 ror1v(f32x4 v) { return (f32x4){ror1(v[0]), ror1(v[1]), ror1(v[2]), ror1(v[3])}; }
    static __device__ __forceinline__ f32x4 ror2v(f32x4 v) { return (f32x4){ror2(v[0]), ror2(v[1]), ror2(v[2]), ror2(v[3])}; }
    __device__ __forceinline__ void operator()(const f32x4 (&acc)[2][2][4][2], const Unit& u, int wr, int wc, int fr, int fq) const {
        const int rowb = u.pm * BM + wr * 64 + fr;
#pragma unroll
        for (int n = 0; n < 2; ++n) {
            const int ch = u.pn * 128 + wc * 32 + 8 * fq + 4 * n;
            const f32x4 wa0 = *(const f32x4*)(cw + ch), wa1 = *(const f32x4*)(cw + 5632 + ch), wa2 = *(const f32x4*)(cw + 2 * 5632 + ch), ba = *(const f32x4*)(cb + ch);
            const f32x4 wu0 = *(const f32x4*)(cw + 2816 + ch), wu1 = *(const f32x4*)(cw + 5632 + 2816 + ch), wu2 = *(const f32x4*)(cw + 2 * 5632 + 2816 + ch), bu = *(const f32x4*)(cb + 2816 + ch);
#pragma unroll
            for (int ai = 0; ai < 2; ++ai) {
                f32x4 pa1 = (f32x4){0.f, 0.f, 0.f, 0.f}, pa2 = pa1, pu1 = pa1, pu2 = pa1;
#pragma unroll
                for (int m = 0; m < 4; ++m) {
                    const f32x4 a = acc[ai][0][m][n], uu = acc[ai][1][m][n];
                    const f32x4 ra1 = ror1v(a), ra2 = ror2v(a), ru1 = ror1v(uu), ru2 = ror2v(uu);
                    const f32x4 a1 = (fr >= 1) ? ra1 : pa1, a2 = (fr >= 2) ? ra2 : pa2, u1 = (fr >= 1) ? ru1 : pu1, u2 = (fr >= 2) ? ru2 : pu2;
                    const f32x4 ya = wa0 * a2 + wa1 * a1 + wa2 * a + ba, yu = wu0 * u2 + wu1 * u1 + wu2 * uu + bu;
                    const f32x2 g0 = gelu_pk((f32x2){ya[0], ya[1]}), g1 = gelu_pk((f32x2){ya[2], ya[3]});
                    const int row = rowb + ai * HALF + m * 16;
                    if (m > 0 || fr >= 2) { typedef unsigned u32x2 __attribute__((ext_vector_type(2)));
                        u32x2 w; w.x = cvt_pk_bf16(g0.x * yu[0], g0.y * yu[1]); w.y = cvt_pk_bf16(g1.x * yu[2], g1.y * yu[3]); *(u32x2*)(G + (size_t)row * 2816 + ch) = w; }
                    if (m == 0 && fr < 2) { float* hp = halo + ((size_t)(row >> 6) * 4 + fr) * 5632 + ch; *(f32x4*)hp = a; *(f32x4*)(hp + 2816) = uu; }
                    if (m == 3 && fr >= 14) { float* hp = halo + ((size_t)(row >> 6) * 4 + (fr - 12)) * 5632 + ch; *(f32x4*)hp = a; *(f32x4*)(hp + 2816) = uu; }
                    pa1 = ra1; pa2 = ra2; pu1 = ru1; pu2 = ru2;
                }
            }
        }
    }
};
template <class Epi, class Sched, bool ALIGN_EPI = false, bool SP2 = false>
__device__ __forceinline__ void gemm_phase(PG8_LAS unsigned char* lds, const Gemm g, const Sched& S, const Epi& E) {
    int tid_ = threadIdx.x; asm volatile("" : "+v"(tid_)); const int tid = tid_, wid = __builtin_amdgcn_readfirstlane(tid >> 6), lane = tid & 63, wr = wid >> 2, wc = wid & 3, fr = lane & 15, fq = lane >> 4;
    const int K = g.K, nt = K / BK;
    unsigned voffA[2], voffB[2];
#pragma unroll
    for (int i = 0; i < 2; ++i) { int R, C; stage_rc(tid * 16 + i * 8192, R, C); const int Rb = Epi::PERM ? ((R & ~31) + perm32(R & 31)) : R;
        voffA[i] = (unsigned)(R * K + C) * 2u; voffB[i] = (unsigned)(Rb * K + C) * 2u; }
    const size_t kstep = (size_t)(BK * 2);
    const size_t hstep = (size_t)HALF * K * 2;
    const size_t tstep = 2 * hstep;
    const unsigned ldsw = (unsigned)wid * 1024u;
    const int aoff = lds_byte(wr * 64 + fr, fq * 8), boff = lds_byte(wc * 32 + fr, fq * 8);
#define PG8_SA(b, h) (((b) * 2 + (h)) * HTB)
#define PG8_SB(b, h) ((4 + (b) * 2 + (h)) * HTB)
#define PG8_STAGE(bufoff, gbase, voff) do { _Pragma("unroll") for (int _i = 0; _i < 2; ++_i) \
        __builtin_amdgcn_global_load_lds((const unsigned*)((const char*)(gbase) + (voff)[_i]), (PG8_LAS unsigned*)(lds + (bufoff) + ldsw + _i * 8192), 16, 0, 0); } while (0)
#define PG8_LDA(dst, b, h) do { _Pragma("unroll") for (int m = 0; m < 4; ++m) _Pragma("unroll") for (int k = 0; k < 2; ++k) dst[m][k] = *(const PG8_LAS bf16x8*)(lds + PG8_SA(b, h) + aoff + m * 2048 + k * 1024); } while (0)
#define PG8_LDB(dst, b, h) do { _Pragma("unroll") for (int n = 0; n < 2; ++n) _Pragma("unroll") for (int k = 0; k < 2; ++k) dst[n][k] = *(const PG8_LAS bf16x8*)(lds + PG8_SB(b, h) + boff + n * 2048 + k * 1024); } while (0)
#define PG8_MMA(ai, bj, At, Bt) do { __builtin_amdgcn_s_setprio(1); _Pragma("unroll") for (int m = 0; m < 4; ++m) _Pragma("unroll") for (int n = 0; n < 2; ++n) _Pragma("unroll") for (int k = 0; k < 2; ++k) \
        acc[ai][bj][m][n] = __builtin_amdgcn_mfma_f32_16x16x32_bf16(Bt[n][k], At[m][k], acc[ai][bj][m][n], 0, 0, 0); __builtin_amdgcn_s_setprio(0); } while (0)
#define PG8_WAIT_V(n) asm volatile("s_waitcnt vmcnt(" #n ")" ::: "memory")
#define PG8_WAIT_L(n) asm volatile("s_waitcnt lgkmcnt(" #n ")" ::: "memory")
#define PG8_BAR __builtin_amdgcn_s_barrier()
#define PG8_SCHED __builtin_amdgcn_sched_barrier(0)
    Unit cur, nxt; int ui = 0;
    if (!S.next(0, cur)) return;
    f32x4 acc[2][2][4][2];
#pragma unroll
    for (int a = 0; a < 2; ++a)
#pragma unroll
        for (int b = 0; b < 2; ++b)
#pragma unroll
            for (int m = 0; m < 4; ++m)
#pragma unroll
                for (int n = 0; n < 2; ++n) acc[a][b][m][n] = (f32x4){0.f, 0.f, 0.f, 0.f};
    bf16x8 At[4][2], B0[2][2], B1[2][2];
    const char* cA = (const char*)g.A + (size_t)cur.pm * tstep; const char* cB = (const char*)g.Bt + (size_t)cur.pn * tstep;
    S.a_ready(cur);
    if constexpr (SP2) {
        PG8_STAGE(PG8_SB(0, 0), cB, voffB); PG8_STAGE(PG8_SB(0, 1), cB + hstep, voffB); PG8_STAGE(PG8_SA(0, 0), cA, voffA); PG8_STAGE(PG8_SA(0, 1), cA + hstep, voffA);
        if (wr == 1) PG8_BAR;
        PG8_WAIT_V(2); PG8_BAR;
        PG8_STAGE(PG8_SB(1, 0), cB + kstep, voffB); PG8_STAGE(PG8_SA(1, 0), cA + kstep, voffA); PG8_STAGE(PG8_SB(1, 1), cB + hstep + kstep, voffB);
        PG8_WAIT_V(6); PG8_BAR;
    } else {
        PG8_STAGE(PG8_SB(0, 0), cB, voffB); PG8_STAGE(PG8_SA(0, 0), cA, voffA); PG8_STAGE(PG8_SB(0, 1), cB + hstep, voffB); PG8_STAGE(PG8_SA(0, 1), cA + hstep, voffA);
        if (wr == 1) PG8_BAR;
        PG8_WAIT_V(4); PG8_BAR;
        PG8_STAGE(PG8_SB(1, 0), cB + kstep, voffB); PG8_STAGE(PG8_SA(1, 0), cA + kstep, voffA); PG8_STAGE(PG8_SB(1, 1), cB + hstep + kstep, voffB);
        PG8_WAIT_V(6); PG8_BAR;
    }
    for (;;) {
        const bool has_next = S.next(ui + 1, nxt);
        const char* nA = has_next ? (const char*)g.A + (size_t)nxt.pm * tstep : cA; const char* nB = has_next ? (const char*)g.Bt + (size_t)nxt.pn * tstep : cB;
        for (int t = 0; t < nt; t += 2) {
            const bool last = (t == nt - 2);
            const char* a1 = cA + (size_t)(t + 1) * kstep;
            const char* a2 = last ? nA : cA + (size_t)(t + 2) * kstep; const char* b2 = last ? nB : cB + (size_t)(t + 2) * kstep;
            const char* a3 = a2 + kstep; const char* b3 = b2 + kstep;
            if (last && has_next) S.a_ready(nxt);
            if constexpr (SP2) {
            PG8_LDB(B0, 0, 0); PG8_LDB(B1, 0, 1); PG8_SCHED; PG8_LDA(At, 0, 0); PG8_STAGE(PG8_SA(1, 1), a1 + hstep, voffA);
            PG8_WAIT_V(8); PG8_WAIT_L(0); PG8_BAR; PG8_MMA(0, 0, At, B0); PG8_MMA(0, 1, At, B1); PG8_BAR; PG8_SCHED;
            PG8_LDA(At, 0, 1); PG8_STAGE(PG8_SB(0, 0), b2, voffB); PG8_STAGE(PG8_SB(0, 1), b2 + hstep, voffB); PG8_STAGE(PG8_SA(0, 0), a2, voffA);
            PG8_WAIT_V(8); PG8_WAIT_L(0); PG8_BAR; PG8_MMA(1, 0, At, B0); PG8_MMA(1, 1, At, B1); PG8_BAR; PG8_SCHED;
            PG8_LDB(B0, 1, 0); PG8_LDB(B1, 1, 1); PG8_SCHED; PG8_LDA(At, 1, 0); PG8_STAGE(PG8_SA(0, 1), a2 + hstep, voffA);
            PG8_WAIT_V(8); PG8_WAIT_L(0); PG8_BAR; PG8_MMA(0, 0, At, B0); PG8_MMA(0, 1, At, B1); PG8_BAR; PG8_SCHED;
            PG8_LDA(At, 1, 1); PG8_STAGE(PG8_SB(1, 0), b3, voffB); PG8_STAGE(PG8_SB(1, 1), b3 + hstep, voffB); PG8_STAGE(PG8_SA(1, 0), a3, voffA);
            PG8_WAIT_V(8); PG8_WAIT_L(0); PG8_BAR; PG8_MMA(1, 0, At, B0); PG8_MMA(1, 1, At, B1); PG8_BAR; PG8_SCHED;
            } else {
            PG8_LDB(B0, 0, 0); PG8_SCHED; PG8_LDA(At, 0, 0); PG8_STAGE(PG8_SA(1, 1), a1 + hstep, voffA);
            PG8_WAIT_L(8); PG8_BAR; PG8_WAIT_L(0); PG8_MMA(0, 0, At, B0); PG8_BAR; PG8_SCHED;
            PG8_LDB(B1, 0, 1); PG8_STAGE(PG8_SB(0, 0), b2, voffB);
            PG8_BAR; PG8_WAIT_L(0); PG8_MMA(0, 1, At, B1); PG8_BAR;
            PG8_LDA(At, 0, 1); PG8_STAGE(PG8_SA(0, 0), a2, voffA);
            PG8_BAR; PG8_WAIT_L(0); PG8_MMA(1, 0, At, B0); PG8_BAR; PG8_SCHED;
            PG8_STAGE(PG8_SB(0, 1), b2 + hstep, voffB);
            PG8_WAIT_V(6); PG8_BAR; PG8_MMA(1, 1, At, B1); PG8_BAR;
            PG8_LDB(B0, 1, 0); PG8_SCHED; PG8_LDA(At, 1, 0); PG8_STAGE(PG8_SA(0, 1), a2 + hstep, voffA);
            PG8_WAIT_L(8); PG8_BAR; PG8_WAIT_L(0); PG8_MMA(0, 0, At, B0); PG8_BAR; PG8_SCHED;
            PG8_LDB(B1, 1, 1); PG8_STAGE(PG8_SB(1, 0), b3, voffB);
            PG8_BAR; PG8_WAIT_L(0); PG8_MMA(0, 1, At, B1); PG8_BAR;
            PG8_LDA(At, 1, 1); PG8_STAGE(PG8_SA(1, 0), a3, voffA);
            PG8_BAR; PG8_WAIT_L(0); PG8_MMA(1, 0, At, B0); PG8_BAR; PG8_SCHED;
            PG8_STAGE(PG8_SB(1, 1), b3 + hstep, voffB);
            PG8_WAIT_V(6); PG8_BAR; PG8_MMA(1, 1, At, B1); PG8_BAR;
            }
        }
        if constexpr (ALIGN_EPI) { if (wr == 0) PG8_BAR; }
        if constexpr (!Epi::AFTER_DRAIN) { E(acc, cur, wr, wc, fr, fq); S.done(cur); }
        if (!has_next) break;
#pragma unroll
        for (int a = 0; a < 2; ++a)
#pragma unroll
            for (int b = 0; b < 2; ++b)
#pragma unroll
                for (int m = 0; m < 4; ++m)
#pragma unroll
                    for (int n = 0; n < 2; ++n) acc[a][b][m][n] = (f32x4){0.f, 0.f, 0.f, 0.f};
        cur = nxt; cA = nA; cB = nB; ++ui;
        if constexpr (ALIGN_EPI) { if (wr == 1) PG8_BAR; }
    }
    PG8_WAIT_V(0);
    if constexpr (!ALIGN_EPI) { if (wr == 0) PG8_BAR; }
    PG8_BAR;
    if constexpr (Epi::AFTER_DRAIN) { E.fused(acc, cur, wr, wc, fr, fq, lds, wid, lane); S.done(cur); }
#undef PG8_SA
#undef PG8_SB
#undef PG8_STAGE
#undef PG8_LDA
#undef PG8_LDB
#undef PG8_MMA
#undef PG8_WAIT_V
#undef PG8_WAIT_L
#undef PG8_BAR
#undef PG8_SCHED
}
}
namespace attn_body {
using bf16=__hip_bfloat16;
using bf16x8=__attribute__((ext_vector_type(8)))short;
using s16x4=__attribute__((ext_vector_type(4)))short;
using f32x16=__attribute__((ext_vector_type(16)))float;
using u32x4=__attribute__((ext_vector_type(4)))unsigned;
constexpr int BATCH=4,NHEAD=8,SEQ=8192,D=64,DM=NHEAD*D,OPITCH=1024;
constexpr int NW=8,QBLK=32,QB=QBLK*NW,KVBLK=64,NQB=SEQ/QB;
constexpr int ATTN_PITCH=DM, ATTN_UNIT_ROWS=QB;
__device__ __forceinline__ int crow(int r,int hi){return (r&3)+8*(r>>2)+4*hi;}
#define SBAR() __builtin_amdgcn_sched_barrier(0)
__device__ __forceinline__ void cmask(f32x16&p0,f32x16&p1,int jb,int qrel,int hi){
  const float NEG=-INFINITY; int kb=64*jb+4*hi;
  #pragma unroll
  for(int r=0;r<16;++r){int kv=kb+(r&3)+8*(r>>2); if(kv>qrel)p0[r]=NEG; if(kv+32>qrel)p1[r]=NEG;}
}

constexpr int NSLOT=3, SLOTB=8192;
constexpr int LDS_K=0, LDS_V=NSLOT*SLOTB, LDS_WS=2*NSLOT*SLOTB, LDS_OST=LDS_WS+NW*64*4, LDS_CK=LDS_OST+NW*4096, LDS_BYTES=LDS_CK+SEQ*4;
constexpr float C2=0.125f*1.4426950408889634f;
__device__ __forceinline__ void glds16(const void*gsrc,unsigned lds_dst){unsigned keep;
  asm volatile("s_mov_b32 %0, m0\n\ts_mov_b32 m0, %2\n\ts_nop 0\n\tglobal_load_lds_dwordx4 %1, off\n\ts_mov_b32 m0, %0":"=&s"(keep):"v"(gsrc),"s"(lds_dst):"memory");}
__device__ __forceinline__ float max3f(float a,float b,float c){float r;asm("v_max3_f32 %0, %1, %2, %3":"=v"(r):"v"(a),"v"(b),"v"(c));return r;}
__device__ __forceinline__ float max2f(float a,float b){float r;asm("v_max_f32_e32 %0, %1, %2":"=v"(r):"v"(a),"v"(b));return r;}
__device__ __forceinline__ float fadd_s(float a,float b){float r;asm("v_add_f32_e32 %0, %1, %2":"=v"(r):"v"(a),"v"(b));return r;}
__device__ __forceinline__ float fsub_s(float a,float b){float r;asm("v_sub_f32_e32 %0, %1, %2":"=v"(r):"v"(a),"v"(b));return r;}
typedef float f32x2_t __attribute__((ext_vector_type(2))); typedef __bf16 bf16x2_t __attribute__((ext_vector_type(2)));
__device__ __forceinline__ unsigned cvtpk_s(float lo,float hi){f32x2_t v={lo,hi};bf16x2_t b=__builtin_convertvector(v,bf16x2_t);return __builtin_bit_cast(unsigned,b);}
#define WAIT_BAR(N) asm volatile("s_waitcnt vmcnt(" #N ") lgkmcnt(0)\n\ts_barrier":::"memory")

__device__ __forceinline__ void qkt(f32x16&p0,f32x16&p1,const char*Kslot,const bf16x8*qr,const f32x16&negm,int r32,int hi){
  const char*kb=Kslot+hi*1024+r32*16;
  #pragma unroll
  for(int d0=0;d0<4;++d0){
    const bf16x8 b0=*reinterpret_cast<const bf16x8*>(kb+d0*2048);
    const bf16x8 b1=*reinterpret_cast<const bf16x8*>(kb+d0*2048+512);
    if(d0==0){p0=__builtin_amdgcn_mfma_f32_32x32x16_bf16(b0,qr[0],negm,0,0,0);p1=__builtin_amdgcn_mfma_f32_32x32x16_bf16(b1,qr[0],negm,0,0,0);}
    else{p0=__builtin_amdgcn_mfma_f32_32x32x16_bf16(b0,qr[d0],p0,0,0,0);p1=__builtin_amdgcn_mfma_f32_32x32x16_bf16(b1,qr[d0],p1,0,0,0);}}
}
typedef __attribute__((address_space(3))) const char* lds_cptr;
typedef short v4i16_t __attribute__((ext_vector_type(4)));
__device__ __forceinline__ void kload8(bf16x8*kf,lds_cptr kp){
  kf[0]=*(const __attribute__((address_space(3))) bf16x8*)(kp);      kf[1]=*(const __attribute__((address_space(3))) bf16x8*)(kp+512);
  kf[2]=*(const __attribute__((address_space(3))) bf16x8*)(kp+2048); kf[3]=*(const __attribute__((address_space(3))) bf16x8*)(kp+2560);
  kf[4]=*(const __attribute__((address_space(3))) bf16x8*)(kp+4096); kf[5]=*(const __attribute__((address_space(3))) bf16x8*)(kp+4608);
  kf[6]=*(const __attribute__((address_space(3))) bf16x8*)(kp+6144); kf[7]=*(const __attribute__((address_space(3))) bf16x8*)(kp+6656);
}
__device__ __forceinline__ void kload2(bf16x8*kf,lds_cptr kp,int j){ kf[2*j]=*(const __attribute__((address_space(3))) bf16x8*)(kp+j*2048); kf[2*j+1]=*(const __attribute__((address_space(3))) bf16x8*)(kp+j*2048+512); }
__device__ __forceinline__ s16x4 vtr(lds_cptr p){ return __builtin_bit_cast(s16x4,__builtin_amdgcn_ds_read_tr16_b64_v4i16((__attribute__((address_space(3))) v4i16_t*)p)); }
__device__ __forceinline__ float rowmax(const f32x16&p0,const f32x16&p1){
  float a=max3f(p0[0],p0[1],p1[0]),b=max3f(p0[2],p0[3],p1[1]);a=max3f(a,p1[2],p1[3]);
  #pragma unroll
  for(int r=4;r<16;r+=4){a=max3f(a,p0[r],p0[r+1]);b=max3f(b,p0[r+2],p0[r+3]);a=max3f(a,p1[r],p1[r+1]);b=max3f(b,p1[r+2],p1[r+3]);}
  const float m=max2f(a,b);
  auto rr=__builtin_amdgcn_permlane32_swap(__float_as_uint(m),__float_as_uint(m),false,false);
  return max2f(__uint_as_float(rr[0]),__uint_as_float(rr[1]));
}
__device__ __forceinline__ void pv(f32x16*o,int vb,bf16x8 pa0,bf16x8 pa1,bf16x8 pa2,bf16x8 pa3){
  #pragma unroll
  for(int d0=0;d0<2;++d0){s16x4 lo[4],hi[4];
    #pragma unroll
    for(int ks=0;ks<4;++ks){
      asm volatile("ds_read_b64_tr_b16 %0,%1 offset:%c2":"=&v"(lo[ks]):"v"(vb),"i"(d0*4096+ks*1024):"memory");
      asm volatile("ds_read_b64_tr_b16 %0,%1 offset:%c2":"=&v"(hi[ks]):"v"(vb),"i"(d0*4096+ks*1024+512):"memory");}
    asm volatile("s_waitcnt lgkmcnt(0)":::"memory");SBAR();
    #define PK(k) (bf16x8){lo[k][0],lo[k][1],lo[k][2],lo[k][3],hi[k][0],hi[k][1],hi[k][2],hi[k][3]}
    o[d0]=__builtin_amdgcn_mfma_f32_32x32x16_bf16(pa0,PK(0),o[d0],0,0,0);
    o[d0]=__builtin_amdgcn_mfma_f32_32x32x16_bf16(pa1,PK(1),o[d0],0,0,0);
    o[d0]=__builtin_amdgcn_mfma_f32_32x32x16_bf16(pa2,PK(2),o[d0],0,0,0);
    o[d0]=__builtin_amdgcn_mfma_f32_32x32x16_bf16(pa3,PK(3),o[d0],0,0,0);
    #undef PK
  }
}

#ifndef ATTN_STORE16
#define ATTN_STORE16(p,v) (*(u32x4*)(p)=(v))
#endif
template<int THRL> __device__ __forceinline__ void attn_unit(int b,int h,int qb,const bf16*Q,const bf16*__restrict__ K,const bf16*__restrict__ V,bf16*O,const float*__restrict__ c2,const float*__restrict__ gnorm,int ts,char*shm){
  int tid_=threadIdx.x; asm volatile("":"+v"(tid_)); const int tid=tid_,lane=tid&63,r32=lane&31,hi=lane>>5; const int wid=__builtin_amdgcn_readfirstlane(tid>>6);
  const long rowbase=(long)b*SEQ; const int q0=qb*QB;
  const bf16*Qw=Q+(rowbase+q0+wid*QBLK)*DM+h*D;
  const bf16*Kh=K+(rowbase+(long)ts*KVBLK)*DM+h*D,*Vh=V+(rowbase+(long)ts*KVBLK)*DM+h*D;
  const unsigned lds0=(unsigned)(uintptr_t)shm;
  float*wsf=(float*)(shm+LDS_WS)+wid*64;
  const bf16*ksrc=Kh+(long)lane*DM+wid*8;
  const bf16*vsrc=Vh+(long)(16*(wid&3)+(lane>>2))*DM+(wid>>2)*32+(lane&3)*8;
  const unsigned kdst=lds0+LDS_K+wid*1024, vdst=lds0+LDS_V+wid*1024;
  #define DMA_K(t,slot) glds16(ksrc+(long)(t)*KVBLK*DM,(unsigned)__builtin_amdgcn_readfirstlane(kdst+(slot)))
  #define DMA_V(t,slot) glds16(vsrc+(long)(t)*KVBLK*DM,(unsigned)__builtin_amdgcn_readfirstlane(vdst+(slot)))
  const int vb0=(int)(lds0+LDS_V)+((lane>>4)&1)*32+(lane&3)*8+(4*hi+((lane&15)>>2))*64;
  const char*Kbase=shm+LDS_K; bf16x8 kf[8];
  const lds_cptr shm3=(lds_cptr)shm; const lds_cptr kp0=shm3+LDS_K+hi*1024+r32*16; const lds_cptr vp0=shm3+LDS_V+((lane>>4)&1)*32+(lane&3)*8+(4*hi+((lane&15)>>2))*64;
  const int NT=(q0+QB)/KVBLK-ts;
  DMA_K(0,0);DMA_V(0,0);DMA_K(1,SLOTB);
  bf16x8 qr[4];
  #pragma unroll
  for(int d0=0;d0<4;++d0)qr[d0]=*reinterpret_cast<const bf16x8*>(&Qw[(long)r32*DM+d0*16+hi*8]);
  float mhat=0.f,l_reg=0.f;f32x16 o[2];o[0]=f32x16{};o[1]=f32x16{};f32x16 negm=f32x16{};asm volatile("":"+v"(negm));
  const int qrel=wid*QBLK+r32;
  #define CMASK(P0,P1,t) do{int jb_=(t)-(NT-4); if(jb_>=0)cmask(P0,P1,jb_,qrel,hi);}while(0)
  bool resc=false;
  #define START(P0,P1) do{ const float rm=*(const __attribute__((address_space(3))) float*)(shm3+LDS_CK+4*(q0-ts*KVBLK+wid*QBLK+r32)); resc=false; \
    { const float dl=rm; mhat=fadd_s(mhat,dl); \
      _Pragma("unroll") for(int r=0;r<16;++r){P0[r]=fsub_s(P0[r],dl);P1[r]=fsub_s(P1[r],dl);} \
      _Pragma("unroll") for(int r=0;r<16;++r)negm[r]=-mhat; asm volatile("":"+v"(negm)); } \
    _Pragma("unroll") for(int r=0;r<16;++r)P0[r]=__builtin_amdgcn_exp2f(P0[r]); }while(0)
  #define RESC() do{ if(resc){ asm volatile("s_waitcnt lgkmcnt(0)":::"memory"); \
      _Pragma("unroll") for(int d_=0;d_<2;++d_) _Pragma("unroll") for(int r=0;r<16;++r)o[d_][r]*=wsf[crow(r,hi)]; } }while(0)
  f32x16 pA0,pA1,pB0,pB1;
  int sl_prev=0,sl_cur=0,sl_next=SLOTB;
  #define ROT() do{sl_prev=sl_cur;sl_cur=sl_next;sl_next=(sl_next==(NSLOT-1)*SLOTB)?0:sl_next+SLOTB;}while(0)
  { typedef float f32x4v __attribute__((ext_vector_type(4)));
    const float*cb=c2+((long)(b*NHEAD+h))*SEQ; const float cref=cb[q0+QB-1];
    for(int i=tid;i<(q0+QB)/4-ts*16;i+=NW*64){ const f32x4v v=*(const f32x4v*)(cb+ts*64+4*i); *(__attribute__((address_space(3))) f32x4v*)((lds_cptr)shm+LDS_CK+16*i)=(f32x4v){cref-v[0],cref-v[1],cref-v[2],cref-v[3]}; } }
  DMA_K(2,2*SLOTB);
  WAIT_BAR(3);
  typedef float f32x4w __attribute__((ext_vector_type(4)));
  #define CKADD(P0,P1,t) do{ const __attribute__((address_space(3))) f32x4w*cp_=(const __attribute__((address_space(3))) f32x4w*)(shm3+LDS_CK)+(t)*16+hi; \
    { SBAR(); const f32x4w a0_=cp_[0],a1_=cp_[2],a2_=cp_[4],a3_=cp_[6]; \
      P0[0]+=a0_[0];P0[1]+=a0_[1];P0[2]+=a0_[2];P0[3]+=a0_[3]; P0[4]+=a1_[0];P0[5]+=a1_[1];P0[6]+=a1_[2];P0[7]+=a1_[3]; \
      P0[8]+=a2_[0];P0[9]+=a2_[1];P0[10]+=a2_[2];P0[11]+=a2_[3]; P0[12]+=a3_[0];P0[13]+=a3_[1];P0[14]+=a3_[2];P0[15]+=a3_[3]; } \
    { SBAR(); const f32x4w b0_=cp_[8],b1_=cp_[10],b2_=cp_[12],b3_=cp_[14]; \
      P1[0]+=b0_[0];P1[1]+=b0_[1];P1[2]+=b0_[2];P1[3]+=b0_[3]; P1[4]+=b1_[0];P1[5]+=b1_[1];P1[6]+=b1_[2];P1[7]+=b1_[3]; \
      P1[8]+=b2_[0];P1[9]+=b2_[1];P1[10]+=b2_[2];P1[11]+=b2_[3]; P1[12]+=b3_[0];P1[13]+=b3_[1];P1[14]+=b3_[2];P1[15]+=b3_[3]; } }while(0)
  qkt(pA0,pA1,Kbase,qr,negm,r32,hi);asm volatile("s_nop 15\n\ts_nop 7":"+v"(pA0),"+v"(pA1));CKADD(pA0,pA1,0);CMASK(pA0,pA1,0);
  START(pA0,pA1);
  _Pragma("unroll") for(int r=0;r<16;++r)pA1[r]=__builtin_amdgcn_exp2f(pA1[r]);
  WAIT_BAR(0);
  DMA_K(3,0);DMA_V(1,SLOTB);
  ROT();
  kload8(kf,kp0+sl_cur);
  WAIT_BAR(2);
  s16x4 vlo[8],vhi[8]; u32x4 pw0,pw1,pw2,pw3;
  #define PKW(P,B) cvtpk_s(P[B],P[B+1])
  #define PAF(k) __builtin_bit_cast(bf16x8,pw##k)
  #define VFR(i) (bf16x8){vlo[i][0],vlo[i][1],vlo[i][2],vlo[i][3],vhi[i][0],vhi[i][1],vhi[i][2],vhi[i][3]}
  #define PIN(x) asm volatile("":"+v"(x))
  #define MX3(a,b,c) __builtin_fmaxf(__builtin_fmaxf((a),(b)),(c))
  #define GAPA(MF,A0,A1,A2,A3,W0,W1,PW) do{ MF; sacc+=A0; sacc+=A1; sacc+=A2; sacc+=A3; PIN(sacc); W0; W1; PIN(PW); SBAR(); }while(0)
  #define EX(v) __builtin_amdgcn_exp2f(v)
  #define GAPB(MF,X,B) do{ MF; X[B]=EX(X[B]); X[B+1]=EX(X[B+1]); X[B+2]=EX(X[B+2]); X[B+3]=EX(X[B+3]); PIN(X); SBAR(); }while(0)
  #define VRD(i) do{ vlo[i]=vtr(vp_+(((i)>>2)*4096+((i)&3)*1024)); vhi[i]=vtr(vp_+(((i)>>2)*4096+((i)&3)*1024+512)); }while(0)
  #define KRD(G,j) do{ if(G){ kload2(kf,kp0+sl_next,j); SBAR(); } }while(0)
  #define STEP(C0,C1,P0,P1,t,GK,GV,GL) do{ SBAR(); \
    const lds_cptr vp_=vp0+sl_prev; \
    VRD(0); SBAR(); float sacc=(P0[0]+P0[1]); \
    GAPA(C0=__builtin_amdgcn_mfma_f32_32x32x16_bf16(kf[0],qr[0],negm,0,0,0), P0[2],P0[3],P0[4],P0[5],     pw0[0]=PKW(P0,0), pw0[1]=PKW(P0,2), pw0); \
    VRD(4); SBAR(); GAPA(C1=__builtin_amdgcn_mfma_f32_32x32x16_bf16(kf[1],qr[0],negm,0,0,0), P0[6],P0[7],P0[8],P0[9],     pw0[2]=PKW(P0,4), pw0[3]=PKW(P0,6), pw0); \
    VRD(1); SBAR(); GAPA(C0=__builtin_amdgcn_mfma_f32_32x32x16_bf16(kf[2],qr[1],C0,0,0,0),   P0[10],P0[11],P0[12],P0[13], pw1[0]=PKW(P0,8), pw1[1]=PKW(P0,10), pw1); \
    VRD(5); SBAR(); GAPA(C1=__builtin_amdgcn_mfma_f32_32x32x16_bf16(kf[3],qr[1],C1,0,0,0),   P0[14],P0[15],P1[0],P1[1],   pw1[2]=PKW(P0,12),pw1[3]=PKW(P0,14), pw1); \
    VRD(2); SBAR(); GAPA(C0=__builtin_amdgcn_mfma_f32_32x32x16_bf16(kf[4],qr[2],C0,0,0,0),   P1[2],P1[3],P1[4],P1[5],     pw2[0]=PKW(P1,0), pw2[1]=PKW(P1,2), pw2); \
    VRD(6); SBAR(); GAPA(C1=__builtin_amdgcn_mfma_f32_32x32x16_bf16(kf[5],qr[2],C1,0,0,0),   P1[6],P1[7],P1[8],P1[9],     pw2[2]=PKW(P1,4), pw2[3]=PKW(P1,6), pw2); \
    VRD(3); SBAR(); GAPA(C0=__builtin_amdgcn_mfma_f32_32x32x16_bf16(kf[6],qr[3],C0,0,0,0),   P1[10],P1[11],P1[12],P1[13], pw3[0]=PKW(P1,8), pw3[1]=PKW(P1,10), pw3); \
    VRD(7); SBAR(); GAPA(C1=__builtin_amdgcn_mfma_f32_32x32x16_bf16(kf[7],qr[3],C1,0,0,0),   P1[14],P1[15],0.f,0.f,       pw3[2]=PKW(P1,12),pw3[3]=PKW(P1,14), pw3); \
    l_reg+=sacc; \
    if(GK){DMA_K((t)+3,sl_cur);} if(GV){DMA_V((t)+1,sl_next);} \
    CKADD(C0,C1,t); CMASK(C0,C1,t); \
    { float a=MX3(C0[0],C0[1],C1[0]),b=MX3(C0[2],C0[3],C1[1]); a=MX3(a,C1[2],C1[3]); \
      _Pragma("unroll") for(int r=4;r<16;r+=4){a=MX3(a,C0[r],C0[r+1]);b=MX3(b,C0[r+2],C0[r+3]);a=MX3(a,C1[r],C1[r+1]);b=MX3(b,C1[r+2],C1[r+3]);} \
      float rm=__builtin_fmaxf(a,b); { auto rr=__builtin_amdgcn_permlane32_swap(__float_as_uint(rm),__float_as_uint(rm),false,false); rm=__builtin_fmaxf(__uint_as_float(rr[0]),__uint_as_float(rr[1])); } \
      resc=false; \
      if(__builtin_expect(__any(rm>(float)THRL),0)){ const float dl=__builtin_fmaxf(rm,0.f); mhat+=dl; \
        _Pragma("unroll") for(int r=0;r<16;++r){C0[r]-=dl;C1[r]-=dl;} \
        _Pragma("unroll") for(int r=0;r<16;++r)negm[r]=-mhat; asm volatile("":"+v"(negm)); \
        const float f=__builtin_amdgcn_exp2f(-dl); l_reg*=f; if(hi==0)wsf[r32]=f; resc=true; } } \
    SBAR(); \
    GAPB(o[0]=__builtin_amdgcn_mfma_f32_32x32x16_bf16(PAF(0),VFR(0),o[0],0,0,0), C0,0); \
    GAPB(o[1]=__builtin_amdgcn_mfma_f32_32x32x16_bf16(PAF(0),VFR(4),o[1],0,0,0), C0,4); \
    KRD(GL,0); GAPB(o[0]=__builtin_amdgcn_mfma_f32_32x32x16_bf16(PAF(1),VFR(1),o[0],0,0,0), C0,8); \
    KRD(GL,1); GAPB(o[1]=__builtin_amdgcn_mfma_f32_32x32x16_bf16(PAF(1),VFR(5),o[1],0,0,0), C0,12); \
    KRD(GL,2); GAPB(o[0]=__builtin_amdgcn_mfma_f32_32x32x16_bf16(PAF(2),VFR(2),o[0],0,0,0), C1,0); \
    KRD(GL,3); GAPB(o[1]=__builtin_amdgcn_mfma_f32_32x32x16_bf16(PAF(2),VFR(6),o[1],0,0,0), C1,4); \
    GAPB(o[0]=__builtin_amdgcn_mfma_f32_32x32x16_bf16(PAF(3),VFR(3),o[0],0,0,0), C1,8); \
    GAPB(o[1]=__builtin_amdgcn_mfma_f32_32x32x16_bf16(PAF(3),VFR(7),o[1],0,0,0), C1,12); \
    }while(0)
  int t=1;
  #undef CMASK
  #define CMASK(P0,P1,t) do{}while(0)
  for(;t+5<NT;t+=2){
    STEP(pB0,pB1,pA0,pA1,t,true,true,true);     WAIT_BAR(2); RESC(); ROT();
    STEP(pA0,pA1,pB0,pB1,t+1,true,true,true);   WAIT_BAR(2); RESC(); ROT();
  }
  #undef CMASK
  #define CMASK(P0,P1,t) do{int jb_=(t)-(NT-4); if(jb_>=0)cmask(P0,P1,jb_,qrel,hi);}while(0)
  #define ENDW(tt) do{ if((tt)+3<NT){WAIT_BAR(2);} else if((tt)+2<NT){WAIT_BAR(1);} else {WAIT_BAR(0);} }while(0)
  for(;t+1<NT;t+=2){
    STEP(pB0,pB1,pA0,pA1,t,(t+3<NT),(t+1<NT),(t+1<NT));       ENDW(t);   RESC(); ROT();
    STEP(pA0,pA1,pB0,pB1,t+1,(t+4<NT),(t+2<NT),(t+2<NT));     ENDW(t+1); RESC(); ROT();
  }
  STEP(pB0,pB1,pA0,pA1,NT-1,false,false,false); RESC();
  { float sacc=pB0[0]+pB0[1]; _Pragma("unroll") for(int r=2;r<16;++r)sacc+=pB0[r]; _Pragma("unroll") for(int r=0;r<16;++r)sacc+=pB1[r]; l_reg+=sacc;
    pw0=(u32x4){PKW(pB0,0),PKW(pB0,2),PKW(pB0,4),PKW(pB0,6)};pw1=(u32x4){PKW(pB0,8),PKW(pB0,10),PKW(pB0,12),PKW(pB0,14)};pw2=(u32x4){PKW(pB1,0),PKW(pB1,2),PKW(pB1,4),PKW(pB1,6)};pw3=(u32x4){PKW(pB1,8),PKW(pB1,10),PKW(pB1,12),PKW(pB1,14)};
    SBAR(); pv(o,vb0+sl_cur,PAF(0),PAF(1),PAF(2),PAF(3)); }
  #undef PKW
  #undef PAF
  #undef VFR
  #undef PIN
  #undef MX3
  #undef GAPA
  #undef GAPB
  #undef EX
  #undef VRD
  #undef KRD
  #undef STEP
  #undef ENDW
  {auto rr=__builtin_amdgcn_permlane32_swap(__float_as_uint(l_reg),__float_as_uint(l_reg),false,false);l_reg=__uint_as_float(rr[0])+__uint_as_float(rr[1]);}
  if(hi==0)wsf[32+r32]=l_reg;asm volatile("s_waitcnt lgkmcnt(0)":::"memory");
  float rli[16];
  #pragma unroll
  for(int r=0;r<16;++r)rli[r]=__builtin_amdgcn_rcpf(wsf[32+crow(r,hi)]);
  { const float g0=gnorm[h*D+r32],g1=gnorm[h*D+32+r32];
    #pragma unroll
    for(int r=0;r<16;++r){ const float x0=o[0][r]*rli[r],x1=o[1][r]*rli[r]; float s=x0*x0+x1*x1;
      s+=__shfl_xor(s,1);s+=__shfl_xor(s,2);s+=__shfl_xor(s,4);s+=__shfl_xor(s,8);s+=__shfl_xor(s,16);
      const float sc=1.0f/sqrtf(s*(1.0f/64.0f)+1e-6f); o[0][r]=x0*sc*g0; o[1][r]=x1*sc*g1; rli[r]=1.0f; } }
  bf16*Ow=O+(rowbase+q0+wid*QBLK)*OPITCH+h*D;
  { bf16*stg=(bf16*)(shm+LDS_OST)+wid*2048;
    #pragma unroll
    for(int r=0;r<16;++r){const int orow=crow(r,hi);
      #pragma unroll
      for(int d0=0;d0<2;++d0)stg[orow*64+d0*32+r32]=__float2bfloat16(o[d0][r]*rli[r]);}
    asm volatile("s_waitcnt lgkmcnt(0)":::"memory");
    #pragma unroll
    for(int i=0;i<4;++i){const int row=i*8+(lane>>3),ch=lane&7; const u32x4 v=*(const u32x4*)(stg+row*64+ch*8); ATTN_STORE16(Ow+(long)row*OPITCH+ch*8,v);} }
  asm volatile("s_waitcnt lgkmcnt(0)\n\ts_barrier":::"memory");
  #undef DMA_K
  #undef DMA_V
  #undef CMASK
  #undef CKADD
  #undef START
  #undef RESC
  #undef ROT
}
constexpr int ATTN_LDS_BYTES=LDS_BYTES;
#undef SBAR
#undef WAIT_BAR
}
constexpr int NWAVES = 8;
constexpr int BATCH = 4, SEQ = 8192, M = BATCH * SEQ, D = 1024, DFF = 2816, INC = 3592, NPROJ = 3584;
constexpr int NP1 = 1536, NP2 = 1280;
constexpr float LN_EPS = 1e-5f, RMS_EPS = 1e-6f;
constexpr float DN_ALPHA = 1.4142135623730951f;
constexpr float LOG2E = 1.4426950408889634f;
constexpr size_t MiB = 1u << 20;
constexpr size_t WS_CTL = 0, CTL_ZERO_BYTES = 49152;
constexpr int CW_BAR = 8192;
constexpr int CW_KMAX = 1024, CW_QMAX = 2048, CW_TS = 4096;
constexpr size_t WS_WFA = 1 * MiB;
constexpr size_t WS_STATS = 2 * MiB;
constexpr size_t WS_C2 = 4 * MiB;
constexpr size_t WS_LFA = 5 * MiB;
constexpr size_t WS_WIN = 8 * MiB, WS_WO = 22 * MiB, WS_WUP = 26 * MiB, WS_WDN = 48 * MiB;
constexpr size_t WS_XN = 60 * MiB;
constexpr size_t WS_SLOT0 = 124 * MiB;
constexpr size_t WS_MIX = 380 * MiB;
constexpr size_t WS_HALO = 124 * MiB;
constexpr size_t WS_SUB = 124 * MiB;
constexpr size_t WS_G = 316 * MiB;
constexpr size_t WS_HQS = 444 * MiB, WS_HOI = 476 * MiB, WS_HDL = 508 * MiB;
constexpr size_t WS_END = 512 * MiB;
static_assert(WS_G + (size_t)M * DFF * 2 <= WS_END && WS_HALO + (size_t)(M / 64) * 4 * 5632 * 4 <= WS_G && WS_MIX + (size_t)M * 1024 * 2 <= WS_END, "ws map");
constexpr int RING_BYTES = 131072, MISC_OFF = RING_BYTES + 320, LDS_BYTES = 147456;

#define GAS __attribute__((address_space(1)))
#define LAS __attribute__((address_space(3)))
typedef unsigned short bf16;
typedef unsigned v4u __attribute__((ext_vector_type(4)));
typedef float f32x4 __attribute__((ext_vector_type(4)));
typedef short bf16x8 __attribute__((ext_vector_type(8)));
typedef short bf16x4 __attribute__((ext_vector_type(4)));
#define LDS_WAIT() asm volatile("s_waitcnt lgkmcnt(0)" ::: "memory")
__device__ __forceinline__ unsigned f2bf(float f) { unsigned u = __builtin_bit_cast(unsigned, f); return (u + 0x7fffu + ((u >> 16) & 1u)) >> 16; }
__device__ __forceinline__ unsigned pk2(float lo, float hi) { return f2bf(lo) | (f2bf(hi) << 16); }
__device__ __forceinline__ float bf2f(unsigned short v) { return __uint_as_float((unsigned)v << 16); }
__device__ __forceinline__ float wave_sum(float v) {
#pragma unroll
    for (int o = 1; o < 64; o <<= 1) v += __shfl_xor(v, o);
    return v;
}
__device__ __forceinline__ void p0_transpose_item(const float* W, int ldw, int K, int N, bf16* WT, int row_off, LAS float* scr, int item, int lane) {
    const int nblk = N / 32, kb = item / nblk, nb = item % nblk, k0 = 64 * kb, n0 = 32 * nb;
#pragma unroll
    for (int i = 0; i < 8; ++i) { const int kk = 8 * i + (lane >> 3), c4 = (lane & 7) * 4; const f32x4 v = *(const f32x4*)(W + (size_t)(k0 + kk) * ldw + n0 + c4);
        scr[kk * 33 + c4] = v.x; scr[kk * 33 + c4 + 1] = v.y; scr[kk * 33 + c4 + 2] = v.z; scr[kk * 33 + c4 + 3] = v.w; }
    LDS_WAIT(); asm volatile("" ::: "memory");
    const int c = lane & 7;
#pragma unroll
    for (int j = 0; j < 4; ++j) { const int n = (lane >> 3) + 8 * j; const LAS float* s = scr + (8 * c) * 33 + n;
        v4u o; o.x = pk2(s[0 * 33], s[1 * 33]); o.y = pk2(s[2 * 33], s[3 * 33]); o.z = pk2(s[4 * 33], s[5 * 33]); o.w = pk2(s[6 * 33], s[7 * 33]);
        *(GAS v4u*)(WT + (size_t)(row_off + n0 + n) * K + k0 + 8 * c) = o; }
    LDS_WAIT(); asm volatile("" ::: "memory");
}

typedef GAS unsigned gu32;
#define RLX_AGENT __ATOMIC_RELAXED, __HIP_MEMORY_SCOPE_AGENT
#define XB_TMO      128
#define XB_XCNT(j)  (256  + 64 * (j))
#define XB_XSUB(j)  (1280 + 64 * (j))
#define XB_XGEN(j)  (2304 + 64 * (j))
#define XB_TOP      3328
#define XB_TOPGEN   3392
#define XCD_BAR_WORDS 3456
#define XB_SPIN_CAP (1u << 18)

__device__ __forceinline__ unsigned xb_ld(unsigned* p)              { return __hip_atomic_load(p, __ATOMIC_RELAXED, __HIP_MEMORY_SCOPE_AGENT); }
__device__ __forceinline__ unsigned xb_add(unsigned* p, unsigned v) { return __hip_atomic_fetch_add(p, v, __ATOMIC_RELAXED, __HIP_MEMORY_SCOPE_AGENT); }
__device__ __forceinline__ unsigned xb_xcc_id() { return (unsigned)__builtin_amdgcn_s_getreg((3 << 11) | 20) & 0xFu; }
#define XB_SPIN(cond, bar) do { unsigned _sp = 0; while (cond) { __builtin_amdgcn_s_sleep(1); \
    if ((++_sp & 255u) == 0u) { if (xb_ld(&(bar)[XB_TMO])) break; if (_sp > XB_SPIN_CAP) { atomicAdd(&(bar)[XB_TMO], 1u); break; } } } } while (0)

struct XcdBarrier {
    unsigned* bar; unsigned x;
    volatile LAS unsigned* st;
};

__device__ __forceinline__ XcdBarrier xcd_barrier_post(unsigned* bar, volatile LAS unsigned* st) {
    XcdBarrier b; b.bar = bar; b.x = xb_xcc_id(); b.st = st;
    if (threadIdx.x == 0) (void)xb_add(&bar[XB_XCNT(b.x)], 1u);
    return b;
}
__device__ __forceinline__ void xcd_barrier_complete(unsigned* bar, unsigned x, unsigned& nloc, unsigned& nx) {
    const unsigned G = gridDim.x * gridDim.y * gridDim.z;
    unsigned sum, cnt, mine, sp = 0u;
    for (;;) {
        sum = 0u; cnt = 0u; mine = 0u;
#pragma unroll
        for (unsigned j = 0; j < 16; ++j) { const unsigned c = xb_ld(&bar[XB_XCNT(j)]); sum += c; cnt += (c > 0u) ? 1u : 0u; mine = (j == x) ? c : mine; }
        if (sum == G) break;
        __builtin_amdgcn_s_sleep(1);
        if ((++sp & 255u) == 0u) { if (xb_ld(&bar[XB_TMO])) break; if (sp > XB_SPIN_CAP) { atomicAdd(&bar[XB_TMO], 1u); break; } }
    }
    nloc = mine > 0u ? mine : 1u; nx = cnt > 0u ? cnt : 1u;
}

__device__ __forceinline__ void xcd_barrier(const XcdBarrier& b) {
    asm volatile("s_waitcnt vmcnt(0)" ::: "memory");
    __syncthreads();
    if (threadIdx.x == 0) {
        unsigned* bar = b.bar; unsigned xq = b.x; asm volatile("" : "+s"(bar), "+s"(xq));
        __builtin_amdgcn_s_waitcnt(0);
        unsigned nloc = b.st[0], nx = b.st[1];
        if (nloc == 0u) { xcd_barrier_complete(bar, xq, nloc, nx); b.st[0] = nloc; b.st[1] = nx; }
        const unsigned old = xb_add(&bar[XB_XSUB(xq)], 1u);
        const unsigned gen = old / nloc;
        if (old + 1u == (gen + 1u) * nloc) {
            __builtin_amdgcn_fence(__ATOMIC_RELEASE, "agent");
            asm volatile("s_waitcnt vmcnt(0)" ::: "memory");
            const unsigned og = xb_add(&bar[XB_TOP], 1u);
            const unsigned tg = og / nx;
            if (og + 1u == (tg + 1u) * nx) xb_add(&bar[XB_TOPGEN], 1u);
            else XB_SPIN(xb_ld(&bar[XB_TOPGEN]) == tg, bar);
            __builtin_amdgcn_fence(__ATOMIC_ACQUIRE, "agent");
            xb_add(&bar[XB_XGEN(xq)], 1u);
            asm volatile("s_waitcnt vmcnt(0)" ::: "memory");
        } else {
            XB_SPIN(xb_ld(&bar[XB_XGEN(xq)]) == gen, bar);
            __builtin_amdgcn_fence(__ATOMIC_ACQUIRE, "agent");
            asm volatile("s_waitcnt vmcnt(0)" ::: "memory");
        }
    }
    __syncthreads();
}

struct Ptrs {
    const float *x, *ln_emb_g, *ln_emb_b, *w_in, *fox_f_bias, *fox_norm_g, *hlb, *hgrn_norm_g, *w_o, *ln_mix_g, *ln_mix_b, *w_up, *conv_w, *conv_b, *w_down, *ln_ffn_g, *ln_ffn_b;
    float* out; unsigned char* ws;
};

__device__ __forceinline__ void prologue_weights(const Ptrs& P, LAS unsigned char* lds, int gw, int NGW, int wave, int lane, int gtid, int nthr) {
    LAS float* scr = (LAS float*)(lds + wave * 16384);
    bf16* win = (bf16*)(P.ws + WS_WIN); bf16* wo = (bf16*)(P.ws + WS_WO); bf16* wup = (bf16*)(P.ws + WS_WUP); bf16* wdn = (bf16*)(P.ws + WS_WDN);
    constexpr int IT0 = 16 * 48, IT1 = 16 * 64, IT2 = 16 * 32, IT3 = 44 * 16 * 4, IT7 = 44 * 32;
    constexpr int PER_LAYER = IT0 + IT1 + IT2 + IT3 + IT7;
    for (int it = gw; it < 2 * PER_LAYER; it += NGW) {
        const int l = it / PER_LAYER; int r = it % PER_LAYER;
        const float* wi = P.w_in + (size_t)l * 1024 * INC; const float* wu = P.w_up + (size_t)l * 1024 * 2 * DFF;
        bf16* winl = win + (size_t)l * NPROJ * 1024; bf16* wupl = wup + (size_t)l * 2 * DFF * 1024;
        if (r < IT0) { p0_transpose_item(wi, INC, 1024, 1536, winl, 0, scr, r, lane); continue; } r -= IT0;
        if (r < IT1) { p0_transpose_item(wi + 1544, INC, 1024, 2048, winl, 1536, scr, r, lane); continue; } r -= IT1;
        if (r < IT2) { p0_transpose_item(P.w_o + (size_t)l * 1024 * 1024, 1024, 1024, 1024, wo + (size_t)l * 1024 * 1024, 0, scr, r, lane); continue; } r -= IT2;
        if (r < IT3) { const int sgm = r >> 6, ri = r & 63; p0_transpose_item(wu + ((sgm & 1) ? DFF : 0) + (sgm >> 1) * 128, 2 * DFF, 1024, 128, wupl, sgm * 128, scr, ri, lane); continue; } r -= IT3;
        p0_transpose_item(P.w_down + (size_t)l * DFF * 1024, 1024, DFF, 1024, wdn + (size_t)l * 1024 * DFF, 0, scr, r, lane);
    }
    float* wfa = (float*)(P.ws + WS_WFA);
    for (int i = gtid; i < 2 * 8 * 1024; i += nthr) { const int l = i >> 13, j = (i >> 10) & 7, k = i & 1023; wfa[i] = P.w_in[(size_t)l * 1024 * INC + (size_t)k * INC + 1536 + j]; }
}


template <int LN_NR, bool FA> __device__ __forceinline__ void ln_phase(const float* xsrc, const bf16* xsrcb, const bf16* add, float alpha, float* xdst, bf16* XN, const float* g, const float* bta, const float* wfa, int wfa_ld, const float* fbias, float* lfa,
                                         LAS float* wl, int gw, int NGW, int lane, int tid) {
    if (FA && wfa_ld == 0) { for (int i = tid; i < 8 * 1024 / 4; i += NWAVES * 64) ((LAS f32x4*)wl)[i] = ((const f32x4*)wfa)[i]; __syncthreads(); }
    else if (FA) {
        for (int k = tid; k < 1024; k += NWAVES * 64) { const f32x4 a = *(const f32x4*)(wfa + (size_t)k * wfa_ld), b = *(const f32x4*)(wfa + (size_t)k * wfa_ld + 4);
            wl[k] = a.x; wl[1024 + k] = a.y; wl[2048 + k] = a.z; wl[3072 + k] = a.w; wl[4096 + k] = b.x; wl[5120 + k] = b.y; wl[6144 + k] = b.z; wl[7168 + k] = b.w; }
        __syncthreads(); }
    f32x4 gv[4], bv[4];
#pragma unroll
    for (int j = 0; j < 4; ++j) { gv[j] = ((const f32x4*)g)[lane + 64 * j]; bv[j] = ((const f32x4*)bta)[lane + 64 * j]; }
    const float fb = (FA && lane < 8) ? fbias[lane] : 0.f;
#pragma nounroll
    for (int m0 = gw; m0 < M; m0 += LN_NR * NGW) {
        f32x4 v[LN_NR][4]; unsigned long long av[LN_NR][4];
#pragma unroll
        for (int r = 0; r < LN_NR; ++r) { const int m = m0 + r * NGW;
            if (xsrc) { const GAS f32x4* xr = (const GAS f32x4*)(xsrc + (size_t)m * D) + lane;
#pragma unroll
                for (int j = 0; j < 4; ++j) v[r][j] = xr[64 * j]; }
            else { const GAS unsigned long long* xr = (const GAS unsigned long long*)(xsrcb + (size_t)m * D) + lane;
#pragma unroll
                for (int j = 0; j < 4; ++j) { const unsigned long long a = xr[64 * j]; const unsigned lo = (unsigned)a, hi = (unsigned)(a >> 32);
                    v[r][j] = (f32x4){__uint_as_float(lo << 16), __uint_as_float(lo & 0xffff0000u), __uint_as_float(hi << 16), __uint_as_float(hi & 0xffff0000u)}; } }
            if (add) { const GAS unsigned long long* ar = (const GAS unsigned long long*)(add + (size_t)m * D) + lane;
#pragma unroll
                for (int j = 0; j < 4; ++j) av[r][j] = ar[64 * j]; } }
#pragma unroll
        for (int r = 0; r < LN_NR; ++r) { const int m = m0 + r * NGW; float s = 0.f;
            if (add) {
#pragma unroll
                for (int j = 0; j < 4; ++j) { const unsigned lo = (unsigned)av[r][j], hi = (unsigned)(av[r][j] >> 32);
                    v[r][j] = v[r][j] * alpha + (f32x4){__uint_as_float(lo << 16), __uint_as_float(lo & 0xffff0000u), __uint_as_float(hi << 16), __uint_as_float(hi & 0xffff0000u)}; } }
#pragma unroll
            for (int j = 0; j < 4; ++j) s += (v[r][j].x + v[r][j].y) + (v[r][j].z + v[r][j].w);
            const float mean = wave_sum(s) * (1.f / D); float s2 = 0.f;
#pragma unroll
            for (int j = 0; j < 4; ++j) { v[r][j] = v[r][j] - mean; s2 += (v[r][j].x * v[r][j].x + v[r][j].y * v[r][j].y) + (v[r][j].z * v[r][j].z + v[r][j].w * v[r][j].w); }
            const float rstd = 1.f / sqrtf(wave_sum(s2) * (1.f / D) + LN_EPS);
#pragma unroll
            for (int j = 0; j < 4; ++j) v[r][j] = (v[r][j] * rstd) * gv[j] + bv[j];
            if (XN) { GAS unsigned long long* o8 = (GAS unsigned long long*)(XN + (size_t)m * D) + lane;
#pragma unroll
                for (int j = 0; j < 4; ++j) o8[64 * j] = (unsigned long long)pk2(v[r][j].x, v[r][j].y) | ((unsigned long long)pk2(v[r][j].z, v[r][j].w) << 32); }
            if (xdst) { GAS f32x4* o = (GAS f32x4*)(xdst + (size_t)m * D) + lane;
#pragma unroll
                for (int j = 0; j < 4; ++j) o[64 * j] = v[r][j]; }
            if (FA) { float mine = 0.f;
#pragma unroll
                for (int h = 0; h < 8; ++h) { float d = 0.f;
#pragma unroll
                    for (int j = 0; j < 4; ++j) { const f32x4 w = ((const LAS f32x4*)wl)[h * 256 + lane + 64 * j]; d += (v[r][j].x * w.x + v[r][j].y * w.y) + (v[r][j].z * w.z + v[r][j].w * w.w); }
                    d = wave_sum(d); if (lane == h) mine = d; }
                if (lane < 8) { const float z = mine + fb; lfa[(size_t)m * 8 + lane] = fminf(z, 0.f) - __logf(1.0f + __expf(-fabsf(z))); } } }
    }
}

__device__ __forceinline__ void cumsum_phase(const float* lfa, float* c2, int b, LAS float* scr, int tid, int wave, int lane) {
    const f32x4* src = (const f32x4*)(lfa + ((size_t)b * SEQ + 16 * tid) * 8);
    float a[16][8];
#pragma unroll
    for (int i = 0; i < 16; ++i) { const f32x4 p = src[2 * i], q = src[2 * i + 1]; a[i][0] = p.x; a[i][1] = p.y; a[i][2] = p.z; a[i][3] = p.w; a[i][4] = q.x; a[i][5] = q.y; a[i][6] = q.z; a[i][7] = q.w; }
#pragma unroll
    for (int i = 1; i < 16; ++i)
#pragma unroll
        for (int h = 0; h < 8; ++h) a[i][h] += a[i - 1][h];
    float off[8];
#pragma unroll
    for (int h = 0; h < 8; ++h) { float t = a[15][h], inc = t;
#pragma unroll
        for (int o = 1; o < 64; o <<= 1) { const float u = __shfl_up(inc, o); if (lane >= o) inc += u; }
        off[h] = inc - t; if (lane == 63) scr[wave * 8 + h] = inc; }
    __syncthreads();
#pragma unroll
    for (int h = 0; h < 8; ++h) { float p = 0.f; for (int w = 0; w < wave; ++w) p += scr[w * 8 + h]; off[h] += p; }
#pragma unroll
    for (int h = 0; h < 8; ++h) { f32x4* dst = (f32x4*)(c2 + ((size_t)(b * 8 + h)) * SEQ + 16 * tid);
#pragma unroll
        for (int i4 = 0; i4 < 4; ++i4) dst[i4] = (f32x4){(a[4 * i4][h] + off[h]) * LOG2E, (a[4 * i4 + 1][h] + off[h]) * LOG2E, (a[4 * i4 + 2][h] + off[h]) * LOG2E, (a[4 * i4 + 3][h] + off[h]) * LOG2E}; }
    __syncthreads();
}

#ifndef THR_EXTRA
#define THR_EXTRA 0.0f
#endif
__device__ __forceinline__ void fox_norms(const bf16* QA, const bf16* KA, unsigned* kmax, unsigned* qmax, int gw, int lane) {
    if (gw >= M / 16) return;
    float kq = 0.f, qq = 0.f;
#pragma unroll 4
    for (int i = 0; i < 16; ++i) { const size_t off = ((size_t)(16 * gw + i)) * 512 + lane * 8;
        const v4u kv = *(const v4u*)(KA + off), qv = *(const v4u*)(QA + off); float sk = 0.f, sq = 0.f;
#pragma unroll
        for (int j = 0; j < 4; ++j) { const float k0 = __uint_as_float(kv[j] << 16), k1 = __uint_as_float(kv[j] & 0xffff0000u), q0 = __uint_as_float(qv[j] << 16), q1 = __uint_as_float(qv[j] & 0xffff0000u); sk += k0 * k0 + k1 * k1; sq += q0 * q0 + q1 * q1; }
        sk += __shfl_xor(sk, 1); sk += __shfl_xor(sk, 2); sk += __shfl_xor(sk, 4); sq += __shfl_xor(sq, 1); sq += __shfl_xor(sq, 2); sq += __shfl_xor(sq, 4);
        kq = fmaxf(kq, sk); qq = fmaxf(qq, sq); }
    if ((lane & 7) == 0) { const int row0 = 16 * gw, b = row0 / SEQ, qb = (row0 % SEQ) / 256, h = lane >> 3;
        atomicMax(kmax + b * 8 + h, __float_as_uint(kq)); atomicMax(qmax + (b * 8 + h) * 32 + qb, __float_as_uint(qq)); }
}
__device__ __forceinline__ void fox_tstart(const float* c2, const unsigned* kmax, const unsigned* qmax, unsigned* tsout, int u) {
    if (u >= 1024) return;
    const int bh = u & 31, qb = u >> 5, q0 = qb * 256;
    const float kn = sqrtf(__uint_as_float(kmax[bh])) * 1.01f, qn = sqrtf(__uint_as_float(qmax[bh * 32 + qb])) * 1.01f;
    const float* cb = c2 + (size_t)bh * SEQ; const float thr = -170.0f - 2.0f * qn * kn - THR_EXTRA;
    const float cq0 = cb[q0];
    int T = q0 / 64 - 1;
    while (T >= 0 && !(cq0 - cb[64 * T + 63] < thr)) --T;
    int ts = (T + 1) & ~1; const int NTabs = q0 / 64 + 4; if (ts > NTabs - 4) ts = NTabs - 4;
    tsout[u] = (unsigned)ts;
}

__device__ __forceinline__ void gate_fixup(const float* halo, const float* cw, const float* cb, bf16* G, int gtid, int nthr) {
    const int ngrp = DFF / 4, nitems = (M / 64) * ngrp;
    for (int item = gtid; item < nitems; item += nthr) {
        const int blk = item / ngrp, ch = (item % ngrp) * 4;
        const float* h0 = halo + (size_t)blk * 4 * 5632 + ch;
        const f32x4 a0 = *(const f32x4*)(h0), u0 = *(const f32x4*)(h0 + 2816), a1 = *(const f32x4*)(h0 + 5632), u1 = *(const f32x4*)(h0 + 5632 + 2816);
        f32x4 pa62 = (f32x4){0.f, 0.f, 0.f, 0.f}, pa63 = pa62, pu62 = pa62, pu63 = pa62;
        if ((blk & 127) != 0) { const float* hp = h0 - 2 * 5632; pa62 = *(const f32x4*)(hp); pu62 = *(const f32x4*)(hp + 2816); pa63 = *(const f32x4*)(hp + 5632); pu63 = *(const f32x4*)(hp + 5632 + 2816); }
        const f32x4 wa0 = *(const f32x4*)(cw + ch), wa1 = *(const f32x4*)(cw + 5632 + ch), wa2 = *(const f32x4*)(cw + 2 * 5632 + ch), ba = *(const f32x4*)(cb + ch);
        const f32x4 wu0 = *(const f32x4*)(cw + 2816 + ch), wu1 = *(const f32x4*)(cw + 5632 + 2816 + ch), wu2 = *(const f32x4*)(cw + 2 * 5632 + 2816 + ch), bu = *(const f32x4*)(cb + 2816 + ch);
        const f32x4 ya0 = wa0 * pa62 + wa1 * pa63 + wa2 * a0 + ba, yu0 = wu0 * pu62 + wu1 * pu63 + wu2 * u0 + bu;
        const f32x4 ya1 = wa0 * pa63 + wa1 * a0 + wa2 * a1 + ba, yu1 = wu0 * pu63 + wu1 * u0 + wu2 * u1 + bu;
        const pg8::f32x2 g00 = pg8::gelu_pk((pg8::f32x2){ya0[0], ya0[1]}), g01 = pg8::gelu_pk((pg8::f32x2){ya0[2], ya0[3]}), g10 = pg8::gelu_pk((pg8::f32x2){ya1[0], ya1[1]}), g11 = pg8::gelu_pk((pg8::f32x2){ya1[2], ya1[3]});
        typedef unsigned u32x2f __attribute__((ext_vector_type(2)));
        *(u32x2f*)(G + (size_t)(blk * 64) * DFF + ch) = (u32x2f){pk2(g00.x * yu0[0], g00.y * yu0[1]), pk2(g01.x * yu0[2], g01.y * yu0[3])};
        *(u32x2f*)(G + (size_t)(blk * 64 + 1) * DFF + ch) = (u32x2f){pk2(g10.x * yu1[0], g10.y * yu1[1]), pk2(g11.x * yu1[2], g11.y * yu1[3])};
    }
}

namespace hg {
constexpr int QT_P = 272, KH_P = 144;
constexpr int O_QT = 0, O_KT = O_QT + 64 * QT_P, O_KH = O_KT + 64 * QT_P, O_VT = O_KH + 128 * KH_P, O_PB = O_VT + 128 * KH_P, O_BT = O_PB + 64 * KH_P, O_RS = O_BT + 2048, O_END = O_RS + 4096;
static_assert(O_END <= RING_BYTES, "hgrn lds");
constexpr int NITEMS = 16 * 128;
#define MFMA16(a, b, c) __builtin_amdgcn_mfma_f32_16x16x32_bf16((a), (b), (c), 0, 0, 0)
typedef float f32x2_t __attribute__((ext_vector_type(2))); typedef __bf16 bf16x2_t __attribute__((ext_vector_type(2)));
__device__ __forceinline__ unsigned cvtpk(float lo, float hi) { f32x2_t v = {lo, hi}; bf16x2_t b = __builtin_convertvector(v, bf16x2_t); return __builtin_bit_cast(unsigned, b); }
__device__ __forceinline__ void hgrn_prep(int first, int stride, bf16* QR, float* LF, const bf16* IR, const bf16* GR, bf16* U, bf16* QS, bf16* OI, float* DLg, LAS unsigned char* lds) {
    int tid_ = threadIdx.x; asm volatile("" : "+v"(tid_)); const int tid = tid_, lane = tid & 63, w = __builtin_amdgcn_readfirstlane(tid >> 6), n16 = lane & 15, g = lane >> 4;
    const int col = tid & 127, tq = tid >> 7;
    LAS unsigned char* QT = lds + O_QT; LAS unsigned char* KT = lds + O_KT; LAS unsigned char* KH = lds + O_KH; LAS unsigned char* VT = lds + O_VT; LAS unsigned char* PB = lds + O_PB;
    LAS float* BT = (LAS float*)(lds + O_BT);
    const int r32 = col & 31, qpos = (col & ~31) + ((r32 < 16) ? (8 * (r32 >> 2) + (r32 & 3)) : (8 * ((r32 - 16) >> 2) + 4 + (r32 & 3)));
    if (first >= NITEMS) return;
    float lf[16]; unsigned short qv[16], vv[16];
    { const int bh = first >> 7, c = first & 127; const size_t base = ((size_t)(bh >> 2) * SEQ + 64 * c + 16 * tq) * 512 + (bh & 3) * 128 + col;
#pragma unroll
      for (int i = 0; i < 16; ++i) { lf[i] = LF[base + (size_t)i * 512]; qv[i] = QR[base + (size_t)i * 512]; vv[i] = IR[base + (size_t)i * 512]; } }
    for (int it = first; it < NITEMS; it += stride) {
        float bl[16]; bl[0] = lf[0];
#pragma unroll
        for (int i = 1; i < 16; ++i) bl[i] = bl[i - 1] + lf[i];
        BT[tq * 128 + col] = bl[15];
        __syncthreads();
        const float t0 = BT[col], t1 = BT[128 + col], t2 = BT[256 + col], t3 = BT[384 + col];
        const float off = (tq == 0) ? 0.f : (tq == 1) ? t0 : (tq == 2) ? (t0 + t1) : (t0 + t1 + t2);
        const float bref = t0 + t1, blast = (t0 + t1) + (t2 + t3);
        unsigned khp[8], vtp[8];
        bf16* qsrow = QS + (size_t)it * 8192 + (size_t)(16 * tq) * 128 + qpos;
#pragma unroll
        for (int i = 0; i < 16; i += 2) {
            const float bb0 = bl[i] + off, bb1 = bl[i + 1] + off, k0 = 1.0f - __expf(lf[i]), k1 = 1.0f - __expf(lf[i + 1]), q0 = bf2f(qv[i]), q1 = bf2f(qv[i + 1]);
            const unsigned qs = cvtpk(q0 * __expf(fminf(bb0 - bref, 80.f)), q1 * __expf(fminf(bb1 - bref, 80.f)));
            const unsigned ks = cvtpk(k0 * __expf(fminf(bref - bb0, 80.f)), k1 * __expf(fminf(bref - bb1, 80.f)));
            const unsigned qa = cvtpk(q0 * __expf(bb0), q1 * __expf(bb1));
            khp[i >> 1] = cvtpk(k0 * __expf(blast - bb0), k1 * __expf(blast - bb1));
            vtp[i >> 1] = (unsigned)vv[i] | ((unsigned)vv[i + 1] << 16);
            *(LAS unsigned short*)(QT + (16 * tq + i) * QT_P + col * 2) = (unsigned short)qs; *(LAS unsigned short*)(QT + (16 * tq + i + 1) * QT_P + col * 2) = (unsigned short)(qs >> 16);
            *(LAS unsigned short*)(KT + (16 * tq + i) * QT_P + col * 2) = (unsigned short)ks; *(LAS unsigned short*)(KT + (16 * tq + i + 1) * QT_P + col * 2) = (unsigned short)(ks >> 16);
            qsrow[(size_t)i * 128] = (unsigned short)qa; qsrow[(size_t)(i + 1) * 128] = (unsigned short)(qa >> 16);
        }
        *(LAS v4u*)(KH + col * KH_P + 32 * tq) = (v4u){khp[0], khp[1], khp[2], khp[3]}; *(LAS v4u*)(KH + col * KH_P + 32 * tq + 16) = (v4u){khp[4], khp[5], khp[6], khp[7]};
        *(LAS v4u*)(VT + col * KH_P + 32 * tq) = (v4u){vtp[0], vtp[1], vtp[2], vtp[3]}; *(LAS v4u*)(VT + col * KH_P + 32 * tq + 16) = (v4u){vtp[4], vtp[5], vtp[6], vtp[7]};
        if (tq == 0) DLg[(size_t)it * 128 + col] = __expf(blast);
        if (it + stride < NITEMS) { const int nx = it + stride, bh = nx >> 7, c = nx & 127; const size_t base = ((size_t)(bh >> 2) * SEQ + 64 * c + 16 * tq) * 512 + (bh & 3) * 128 + col;
#pragma unroll
            for (int i = 0; i < 16; ++i) { lf[i] = LF[base + (size_t)i * 512]; qv[i] = QR[base + (size_t)i * 512]; vv[i] = IR[base + (size_t)i * 512]; } }
        __syncthreads();
        { const int tb = w >> 1;
#pragma unroll
          for (int jj = 0; jj < 2; ++jj) { const int sb = 2 * (w & 1) + jj; f32x4 p = (f32x4){0.f, 0.f, 0.f, 0.f};
              if (sb <= tb) {
#pragma unroll
                  for (int kk = 0; kk < 4; ++kk) { const bf16x8 A = *(const LAS bf16x8*)(QT + (16 * tb + n16) * QT_P + (32 * kk + 8 * g) * 2), B = *(const LAS bf16x8*)(KT + (16 * sb + n16) * QT_P + (32 * kk + 8 * g) * 2); p = MFMA16(A, B, p); }
                  if (sb == tb) {
#pragma unroll
                      for (int i = 0; i < 4; ++i) if (n16 > 4 * g + i) p[i] = 0.f; } }
#pragma unroll
              for (int i = 0; i < 4; ++i) *(LAS unsigned short*)(PB + (16 * tb + 4 * g + i) * KH_P + (16 * sb + n16) * 2) = (unsigned short)f2bf(p[i]); } }
        __syncthreads();
        bf16x8 vB[2];
#pragma unroll
        for (int kk = 0; kk < 2; ++kk) vB[kk] = *(const LAS bf16x8*)(VT + (16 * w + n16) * KH_P + (32 * kk + 8 * g) * 2);
#pragma unroll
        for (int mt = 0; mt < 4; ++mt) { f32x4 acc = (f32x4){0.f, 0.f, 0.f, 0.f};
#pragma unroll
            for (int kk = 0; kk < 2; ++kk) { const bf16x8 A = *(const LAS bf16x8*)(PB + (16 * mt + n16) * KH_P + (32 * kk + 8 * g) * 2); acc = MFMA16(A, vB[kk], acc); }
            *(unsigned long long*)(OI + (((size_t)it * 8 + w) * 4 + mt) * 256 + lane * 4) = (unsigned long long)cvtpk(acc[0], acc[1]) | ((unsigned long long)cvtpk(acc[2], acc[3]) << 32); }
#pragma unroll
        for (int j = 0; j < 8; ++j) { f32x4 acc = (f32x4){0.f, 0.f, 0.f, 0.f};
#pragma unroll
            for (int kk = 0; kk < 2; ++kk) { const bf16x8 A = *(const LAS bf16x8*)(KH + (16 * j + n16) * KH_P + (32 * kk + 8 * g) * 2); acc = MFMA16(A, vB[kk], acc); }
            { const int bh_ = it >> 7; const size_t T0_ = (size_t)(bh_ >> 2) * SEQ + 64 * (it & 127);
              *(unsigned long long*)((bf16*)(LF + (T0_ + 8 * w + j) * 512 + (bh_ & 3) * 128) + lane * 4) = (unsigned long long)cvtpk(acc[0], acc[1]) | ((unsigned long long)cvtpk(acc[2], acc[3]) << 32); } }
    }
    __syncthreads();
}
typedef unsigned u32x2 __attribute__((ext_vector_type(2)));
__device__ __forceinline__ f32x4 up4(u32x2 v) { return (f32x4){__uint_as_float(v.x << 16), __uint_as_float(v.x & 0xffff0000u), __uint_as_float(v.y << 16), __uint_as_float(v.y & 0xffff0000u)}; }
__device__ __forceinline__ void hgrn_scan(int task, float* LF, const float* DLg, int lane) {
    if (task >= 16 * 64) return;
    const int bh = task >> 6, wj = task & 63, g = lane >> 4;
    bf16* up = (bf16*)(LF + ((size_t)(bh >> 2) * SEQ + wj) * 512 + (bh & 3) * 128) + lane * 4;
    const float* dlp = DLg + (size_t)bh * 128 * 128 + 16 * (wj & 7) + 4 * g;
    f32x4 S = (f32x4){0.f, 0.f, 0.f, 0.f};
    u32x2 ub[8]; f32x4 db[8];
#pragma unroll
    for (int k = 0; k < 8; ++k) { ub[k] = *(const u32x2*)(up + (size_t)k * 65536); db[k] = *(const f32x4*)(dlp + (size_t)k * 128); }
#pragma nounroll
    for (int c0 = 0; c0 < SEQ / 64; c0 += 8) {
        u32x2 un[8]; f32x4 dn[8];
        if (c0 + 8 < SEQ / 64) {
#pragma unroll
            for (int k = 0; k < 8; ++k) { un[k] = *(const u32x2*)(up + (size_t)(c0 + 8 + k) * 65536); dn[k] = *(const f32x4*)(dlp + (size_t)(c0 + 8 + k) * 128); } }
        else {
#pragma unroll
            for (int k = 0; k < 8; ++k) { un[k] = (u32x2){0u, 0u}; dn[k] = (f32x4){0.f, 0.f, 0.f, 0.f}; } }
#pragma unroll
        for (int k = 0; k < 8; ++k) { *(u32x2*)(up + (size_t)(c0 + k) * 65536) = (u32x2){cvtpk(S[0], S[1]), cvtpk(S[2], S[3])}; S = S * db[k] + up4(ub[k]); }
#pragma unroll
        for (int k = 0; k < 8; ++k) { ub[k] = un[k]; db[k] = dn[k]; }
    }
}
__device__ __forceinline__ void hgrn_out_phase(int first, int stride, const float* LF, const bf16* QS, const bf16* OI, const bf16* GQ, const float* gnorm, bf16* MIX, LAS unsigned char* lds) {
    int tid_ = threadIdx.x; asm volatile("" : "+v"(tid_)); const int tid = tid_, lane = tid & 63, w = __builtin_amdgcn_readfirstlane(tid >> 6), n16 = lane & 15, g = lane >> 4;
    if (first >= NITEMS) return;
    LAS float* RS = (LAS float*)(lds + O_RS);
    bf16x8 qf[4][4]; u32x2 oif[4], sp[8]; unsigned short gq[16];
#define HO_LOAD(IT) do { const int bh_ = (IT) >> 7, hc_ = (bh_ & 3) * 128; const size_t T0_ = (size_t)(bh_ >> 2) * SEQ + 64 * ((IT) & 127); \
      _Pragma("unroll") for (int mt = 0; mt < 4; ++mt) { _Pragma("unroll") for (int kk = 0; kk < 4; ++kk) qf[mt][kk] = *(const bf16x8*)(QS + (size_t)(IT) * 8192 + (16 * mt + n16) * 128 + 32 * kk + 8 * g); \
          oif[mt] = *(const u32x2*)(OI + (((size_t)(IT) * 8 + w) * 4 + mt) * 256 + lane * 4); \
          _Pragma("unroll") for (int i = 0; i < 4; ++i) gq[4 * mt + i] = GQ[(T0_ + 16 * mt + 4 * g + i) * 512 + hc_ + 16 * w + n16]; } \
      _Pragma("unroll") for (int j = 0; j < 8; ++j) sp[j] = *(const u32x2*)((const bf16*)(LF + (T0_ + 8 * w + j) * 512 + hc_) + lane * 4); } while (0)
    HO_LOAD(first);
    int par = 0;
    for (int it = first; it < NITEMS; it += stride, par ^= 1) {
        const int bh = it >> 7, hc = (bh & 3) * 128; const size_t T0 = (size_t)(bh >> 2) * SEQ + 64 * (it & 127);
        const float gn = gnorm[hc + 16 * w + n16];
        f32x4 o[4], gf[4];
#pragma unroll
        for (int mt = 0; mt < 4; ++mt) { f32x4 acc = up4(oif[mt]); gf[mt] = (f32x4){bf2f(gq[4 * mt]), bf2f(gq[4 * mt + 1]), bf2f(gq[4 * mt + 2]), bf2f(gq[4 * mt + 3])};
#pragma unroll
            for (int kk = 0; kk < 4; ++kk) acc = MFMA16(qf[mt][kk], __builtin_bit_cast(bf16x8, (v4u){sp[2 * kk].x, sp[2 * kk].y, sp[2 * kk + 1].x, sp[2 * kk + 1].y}), acc);
            o[mt] = acc; }
        asm volatile("" ::: "memory");
        if (it + stride < NITEMS) HO_LOAD(it + stride);
        LAS float* RSc = RS + par * 512;
#pragma unroll
        for (int mt = 0; mt < 4; ++mt) { f32x4 q = o[mt] * o[mt];
#pragma unroll
            for (int sh = 1; sh < 16; sh <<= 1) { q[0] += __shfl_xor(q[0], sh); q[1] += __shfl_xor(q[1], sh); q[2] += __shfl_xor(q[2], sh); q[3] += __shfl_xor(q[3], sh); }
            if (n16 == 0) *(LAS f32x4*)(RSc + w * 64 + 16 * mt + 4 * g) = q; }
        asm volatile("s_waitcnt lgkmcnt(0)\n\ts_barrier" ::: "memory");
#pragma unroll
        for (int mt = 0; mt < 4; ++mt) { f32x4 tot = (f32x4){0.f, 0.f, 0.f, 0.f};
#pragma unroll
            for (int ww = 0; ww < 8; ++ww) tot += *(const LAS f32x4*)(RSc + ww * 64 + 16 * mt + 4 * g);
#pragma unroll
            for (int i = 0; i < 4; ++i) { const float r = __builtin_amdgcn_rsqf(tot[i] * (1.f / 128.f) + RMS_EPS); const float val = o[mt][i] * r * gn * gf[mt][i];
                MIX[(T0 + 16 * mt + 4 * g + i) * 1024 + 512 + hc + 16 * w + n16] = (unsigned short)f2bf(val); } }
    }
    __syncthreads();
#undef HO_LOAD
}
}
namespace cg = cooperative_groups;
#ifndef PHM
#define PHM 0xffff
#endif
#define PH(b) if constexpr ((PHM >> (b)) & 1)
#ifndef DUPP
#define DUPP 0
#endif
#define GSYNC() do { xcd_barrier(xbar); if (DUPP == 9) xcd_barrier(xbar); } while (0)
#ifndef PG8_SP2_
#define PG8_SP2_ true
#endif
#ifndef PG8_ALIGN_UP
#define PG8_ALIGN_UP true
#endif
#ifndef PG8_ALIGN_
#define PG8_ALIGN_ true
#endif
#define REP(k) for (int rep_ = 0; rep_ < ((DUPP == (k)) ? 2 : 1); ++rep_)
struct Args { Ptrs p; };
#define FRESH_IDS() int tid = threadIdx.x; asm volatile("" : "+v"(tid)); const int lane = tid & 63, wave = __builtin_amdgcn_readfirstlane(tid >> 6); const int gw = bx * NWAVES + wave, gtid = bx * (NWAVES * 64) + tid; (void)lane; (void)gw; (void)gtid;
__global__ void __launch_bounds__(NWAVES * 64, 2) fwd_megakernel(Args args) {
    extern __shared__ __attribute__((aligned(16))) unsigned char lds_raw[];
    cg::grid_group grid = cg::this_grid();
    const Ptrs& P = args.p;
    LAS unsigned char* lds = (LAS unsigned char*)lds_raw;
    volatile LAS int* MISC = (volatile LAS int*)(lds + MISC_OFF);
    const int G = gridDim.x, bx = blockIdx.x;
    const int NGW = G * NWAVES, nthr = G * NWAVES * 64;
    unsigned char* ws = P.ws;
    unsigned* ctl = (unsigned*)(ws + WS_CTL);
    if (threadIdx.x < 32) ((LAS unsigned*)(lds + MISC_OFF))[threadIdx.x] = 0u;
    __syncthreads();
    const XcdBarrier xbar = xcd_barrier_post(ctl + CW_BAR, (volatile LAS unsigned*)(lds + MISC_OFF) + 8);
    float* c2 = (float*)(ws + WS_C2); float* lfa = (float*)(ws + WS_LFA); const float* wfa = (const float*)(ws + WS_WFA);
    bf16* XN = (bf16*)(ws + WS_XN); bf16* slot0 = (bf16*)(ws + WS_SLOT0); bf16* MIX = (bf16*)(ws + WS_MIX); bf16* GB = (bf16*)(ws + WS_G); bf16* SUB = (bf16*)(ws + WS_SUB);

    REP(5) PH(0) { FRESH_IDS(); prologue_weights(P, lds, gw, NGW, wave, lane, gtid, nthr); }
    __syncthreads();
    PH(1) { FRESH_IDS(); ln_phase<2, true>(P.x, nullptr, nullptr, 1.f, nullptr, XN, P.ln_emb_g, P.ln_emb_b, P.w_in + 1536, INC, P.fox_f_bias, lfa, (LAS float*)lds, gw, NGW, lane, tid); }
    grid.sync();

#pragma nounroll
    for (int l = 0; l < 2; ++l) {
        PH(2) if (bx < BATCH) { FRESH_IDS(); cumsum_phase(lfa, c2, bx, (LAS float*)lds, tid, wave, lane); }
        REP(1) { if (rep_) GSYNC();
        PH(3) { pg8::Gemm g{XN, (const bf16*)(ws + WS_WIN) + (size_t)l * NPROJ * 1024, M, NPROJ, D}; pg8::StaticOrder S; S.init(M, NPROJ, G, bx);
          pg8::EpiProj E{slot0, P.hlb, l, attn_body::C2};
          pg8::gemm_phase<pg8::EpiProj, pg8::StaticOrder, PG8_ALIGN_, PG8_SP2_>(lds, g, S, E); } }
        GSYNC();
        PH(5) { FRESH_IDS(); fox_norms(slot0, slot0 + pg8::SLOT_ELEMS, ctl + CW_KMAX + 32 * l, ctl + CW_QMAX + 1024 * l, gw, lane); }
        REP(4) { if (rep_) GSYNC();
        PH(4) hg::hgrn_prep(bx, G, slot0 + 3 * pg8::SLOT_ELEMS, (float*)(slot0 + 4 * pg8::SLOT_ELEMS), slot0 + 6 * pg8::SLOT_ELEMS, slot0 + 7 * pg8::SLOT_ELEMS, nullptr, (bf16*)(ws + WS_HQS), (bf16*)(ws + WS_HOI), (float*)(ws + WS_HDL), lds); }
        GSYNC();
        PH(4) { FRESH_IDS(); hg::hgrn_scan(gw, (float*)(slot0 + 4 * pg8::SLOT_ELEMS), (const float*)(ws + WS_HDL), lane);
                if (gw >= 1024) fox_tstart(c2, ctl + CW_KMAX + 32 * l, ctl + CW_QMAX + 1024 * l, ctl + CW_TS + 1024 * l, gtid - 1024 * 64); }
        GSYNC();
#ifndef DUP_MIX
#define DUP_MIX 0
#endif
        for (int rep = 0; rep < (DUP_MIX ? 2 : 1); ++rep) { unsigned* ctr = ctl + 64 * (l + 2 * rep); const bool do_h = (rep == 0) || (DUP_MIX & 1), do_a = (rep == 0) || (DUP_MIX & 2);
          const bf16* QA = slot0; const bf16* KA = slot0 + pg8::SLOT_ELEMS; const bf16* VA = slot0 + 2 * pg8::SLOT_ELEMS;
          int nxt_it = 0, nxt_ts = 0; if (threadIdx.x == 0) { nxt_it = (int)atomicAdd(ctr, 1u); nxt_ts = (nxt_it < 1024) ? (int)ctl[CW_TS + 1024 * l + (nxt_it & 31) + 32 * (31 - (nxt_it >> 5))] : 0; }
          for (;;) {
              FRESH_IDS();
              if (tid == 0) { MISC[16] = nxt_it; MISC[17] = nxt_ts; }
              __syncthreads();
              const int it = MISC[16], its = MISC[17];
              __syncthreads();
              if (it >= 1024) break;
              if (tid == 0) { nxt_it = (int)atomicAdd(ctr, 1u); nxt_ts = (nxt_it < 1024) ? (int)ctl[CW_TS + 1024 * l + (nxt_it & 31) + 32 * (31 - (nxt_it >> 5))] : 0; }
              PH(5) if (do_a) { const int idx = it, qb = 31 - (idx >> 5), bh = idx & 31;
                     attn_body::attn_unit<60>(bh >> 3, bh & 7, qb, (const attn_body::bf16*)QA, (const attn_body::bf16*)KA, (const attn_body::bf16*)VA, (attn_body::bf16*)MIX, c2, P.fox_norm_g + l * 512, (int)__builtin_amdgcn_readfirstlane(its), (char*)lds_raw); }
          }
          PH(4) if (do_h) hg::hgrn_out_phase(bx, G, (const float*)(slot0 + 4 * pg8::SLOT_ELEMS), (const bf16*)(ws + WS_HQS), (const bf16*)(ws + WS_HOI), slot0 + 7 * pg8::SLOT_ELEMS, P.hgrn_norm_g + l * 512, MIX, lds);
          if (DUP_MIX && rep == 0) GSYNC(); }
        GSYNC();
        REP(6) { if (rep_) GSYNC();
        PH(6) { pg8::Gemm g{MIX, (const bf16*)(ws + WS_WO) + (size_t)l * 1024 * 1024, M, D, D}; pg8::StaticOrder S; S.init(M, D, G, bx);
          pg8::EpiBf16<0> E{SUB, D, nullptr, 0, 0, 1.f};
          pg8::gemm_phase<pg8::EpiBf16<0>, pg8::StaticOrder, PG8_ALIGN_, PG8_SP2_>(lds, g, S, E); } }
        GSYNC();
        REP(3) { if (rep_) GSYNC();
        PH(1) { FRESH_IDS(); ln_phase<4, false>(nullptr, XN, SUB, DN_ALPHA, nullptr, (DUPP == 3 && rep_ == 0) ? (bf16*)(ws + 200 * MiB) : XN, P.ln_mix_g + l * D, P.ln_mix_b + l * D, nullptr, 0, nullptr, nullptr, (LAS float*)lds, gw, NGW, lane, tid); } }
        GSYNC();
        REP(2) { if (rep_) GSYNC();
        PH(7) { pg8::Gemm g{XN, (const bf16*)(ws + WS_WUP) + (size_t)l * 2 * DFF * 1024, M, 2 * DFF, D}; pg8::StaticOrder S; S.init(M, 2 * DFF, G, bx);
          pg8::EpiGate E{GB, (float*)(ws + WS_HALO), P.conv_w + (size_t)l * 3 * 2 * DFF, P.conv_b + (size_t)l * 2 * DFF};
          pg8::gemm_phase<pg8::EpiGate, pg8::StaticOrder, PG8_ALIGN_UP, PG8_SP2_>(lds, g, S, E); } }
        GSYNC();
        REP(8) { if (rep_) GSYNC();
        PH(8) { FRESH_IDS(); gate_fixup((const float*)(ws + WS_HALO), P.conv_w + (size_t)l * 3 * 2 * DFF, P.conv_b + (size_t)l * 2 * DFF, GB, gtid, nthr); } }
        GSYNC();
        REP(7) { if (rep_) GSYNC();
        PH(6) { pg8::Gemm g{GB, (const bf16*)(ws + WS_WDN) + (size_t)l * 1024 * DFF, M, D, DFF}; pg8::StaticOrder S; S.init(M, D, G, bx);
          pg8::EpiBf16<0> E{SUB, D, nullptr, 0, 0, 1.f};
          pg8::gemm_phase<pg8::EpiBf16<0>, pg8::StaticOrder, PG8_ALIGN_, PG8_SP2_>(lds, g, S, E); } }
        GSYNC();
        if (l == 0) { PH(1) { FRESH_IDS(); ln_phase<2, true>(nullptr, XN, SUB, DN_ALPHA, nullptr, XN, P.ln_ffn_g, P.ln_ffn_b, wfa + 8 * 1024, 0, P.fox_f_bias + 8, lfa, (LAS float*)lds, gw, NGW, lane, tid); } GSYNC(); }
        else PH(1) { FRESH_IDS(); ln_phase<4, false>(nullptr, XN, SUB, DN_ALPHA, P.out, nullptr, P.ln_ffn_g + D, P.ln_ffn_b + D, nullptr, 0, nullptr, nullptr, (LAS float*)lds, gw, NGW, lane, tid); }
    }
}

extern "C" void kernel_launch(void* const* d_in, const int* in_sizes, int n_in, void* d_out, int out_size, void* d_ws, size_t ws_size, hipStream_t stream) {
    static int grid = 0;
    if (grid == 0) {
        if (n_in != 17 || in_sizes[0] != M * D || out_size != M * D || ws_size < WS_END) { fprintf(stderr, "kernel_launch: unexpected shapes: n_in %d in0 %d out %d ws %zu\n", n_in, n_in > 0 ? in_sizes[0] : -1, out_size, ws_size); grid = -1; return; }
        int dev = 0, cus = 0, per_cu = 0;
        if (hipGetDevice(&dev) != hipSuccess || hipDeviceGetAttribute(&cus, hipDeviceAttributeMultiprocessorCount, dev) != hipSuccess) { fprintf(stderr, "kernel_launch: device query failed\n"); grid = -1; return; }
        if (hipFuncSetAttribute((const void*)fwd_megakernel, hipFuncAttributeMaxDynamicSharedMemorySize, LDS_BYTES) != hipSuccess) { fprintf(stderr, "kernel_launch: hipFuncSetAttribute failed\n"); grid = -1; return; }
        if (hipOccupancyMaxActiveBlocksPerMultiprocessor(&per_cu, (const void*)fwd_megakernel, NWAVES * 64, LDS_BYTES) != hipSuccess || per_cu < 1) { fprintf(stderr, "kernel_launch: occupancy query says %d blocks/CU\n", per_cu); per_cu = 1; }
        (void)hipGetLastError();
        if (cus < 256) { fprintf(stderr, "kernel_launch: this kernel's phase maps need 256 co-resident workgroups (one per CU); the device has %d CUs\n", cus); grid = -1; return; }
        grid = 256;
    }
    if (grid < 0) return;
    (void)hipMemsetAsync((char*)d_ws + WS_CTL, 0, CTL_ZERO_BYTES, stream);
    Args a{};
    const float** pp = (const float**)&a.p;
    for (int i = 0; i < 17; ++i) pp[i] = (const float*)d_in[i];
    a.p.out = (float*)d_out; a.p.ws = (unsigned char*)d_ws;
    void* kargs[] = {&a};
    const hipError_t e = hipLaunchCooperativeKernel((const void*)fwd_megakernel, dim3(grid), dim3(NWAVES * 64), kargs, LDS_BYTES, stream);
    if (e != hipSuccess) fprintf(stderr, "kernel_launch: cooperative launch failed: %s (grid %d)\n", hipGetErrorString(e), grid);
}
```

```cpp
#include <hip/hip_runtime.h>
#include <hip/hip_cooperative_groups.h>
#include <hip/hip_bf16.h>
#include <cstdio>
#include <cstdint>
#include <cmath>
namespace pg8 {
#define PG8_LAS __attribute__((address_space(3)))
typedef unsigned short bf16_t;
typedef short bf16x8 __attribute__((ext_vector_type(8)));
typedef float f32x4 __attribute__((ext_vector_type(4)));
typedef unsigned u32x4 __attribute__((ext_vector_type(4)));
constexpr int BM = 256, BK = 64, HALF = 128, HTB = HALF * BK * 2  , STAGE_BYTES = 8 * HTB, NXCD = 8, WGM = 4;

__host__ __device__ __forceinline__ int lds_byte(int r, int c) { const int st = (r >> 4) * 2 + (c >> 5), rr = r & 15, cc = c & 31, ob = rr * 64 + cc * 2; return st * 1024 + (ob ^ (((ob >> 9) & 1) << 5)); }
__host__ __device__ __forceinline__ void stage_rc(int b, int& R, int& C) { const int st = b / 1024, sb = b % 1024, swz = sb ^ (((sb >> 9) & 1) << 5); R = (st >> 1) * 16 + swz / 64; C = (st & 1) * 32 + (swz % 64) / 2; }
__host__ __device__ __forceinline__ int perm32(int rho) { const int n = rho >> 4, i = rho & 15; return 8 * (i >> 2) + 4 * n + (i & 3); }

struct Unit { int pm, pn; };
struct Gemm { const bf16_t* A; const bf16_t* Bt; int M, N, K; };

struct StaticOrder {
    int nM, nN, nwg, G, c;
    __host__ __device__ void init(int M, int N, int G_, int c_) { nM = M / BM; nN = N / BM; nwg = nM * nN; G = G_; c = c_; }
    __host__ __device__ bool next(int i, Unit& u) const {
        const long L = (long)i * G + c; if (L >= nwg) return false;
        int wgid = (int)L; { const int q = nwg / NXCD, r = nwg % NXCD, xcd = wgid % NXCD, off = wgid / NXCD; wgid = (xcd < r ? xcd * (q + 1) : r * (q + 1) + (xcd - r) * q) + off; }
        const int nig = WGM * nN, gid = wgid / nig, fm = gid * WGM, gsz = (nM - fm) < WGM ? (nM - fm) : WGM;
        u.pm = fm + ((wgid % nig) % gsz); u.pn = (wgid % nig) / gsz; return true;
    }
    __device__ __forceinline__ void a_ready(const Unit&) const {}
    __device__ __forceinline__ void done(const Unit&) const {}
};

typedef float f32x2c __attribute__((ext_vector_type(2))); typedef __bf16 bf16x2c __attribute__((ext_vector_type(2)));
__device__ __forceinline__ unsigned cvt_pk_bf16(float lo, float hi) { f32x2c v = {lo, hi}; bf16x2c b = __builtin_convertvector(v, bf16x2c); return __builtin_bit_cast(unsigned, b); }
typedef float f32x2 __attribute__((ext_vector_type(2)));
__device__ __forceinline__ f32x2 gelu_pk(f32x2 v) {
    const f32x2 av = __builtin_elementwise_abs(v), d = av * 0.2316418882f + 1.0f;
    f32x2 t; t.x = __builtin_amdgcn_rcpf(d.x); t.y = __builtin_amdgcn_rcpf(d.y);
    f32x2 q = t * 0.5307027145f + (-0.7265760135f); q = q * t + 0.7107068705f; q = q * t + (-0.142248368f); q = q * t + 0.127414796f; q = q * t;
    const f32x2 s = (v * v) * (-0.72134752044f);
    f32x2 e; e.x = __builtin_amdgcn_exp2f(s.x); e.y = __builtin_amdgcn_exp2f(s.y);
    f32x2 p; p.x = fmaxf(v.x, 0.f); p.y = fmaxf(v.y, 0.f);
    return p - av * (q * e);
}

template <int ACT  > struct EpiBf16 {
    static constexpr bool PERM = true, AFTER_DRAIN = false; static_assert(ACT == 0 || ACT == 1, "EpiBf16: ACT is 0 (none) or 1 (gelu_pk)");
    bf16_t* O; int ldc; const float* bias; int split_cols; size_t split_stride; float scale0;
    __device__ __forceinline__ void operator()(const f32x4 (&acc)[2][2][4][2], const Unit& u, int wr, int wc, int fr, int fq) const {
        const int row0 = u.pm * BM + wr * 64 + fr; int colt = u.pn * BM; bf16_t* base = O;
        float sc = 1.f; if (split_cols) { const int t = colt / split_cols; base += (size_t)t * split_stride; colt -= t * split_cols; if (t == 0) sc = scale0; }
        const int col0 = colt + wc * 32 + 8 * fq, bcol0 = u.pn * BM + wc * 32 + 8 * fq;
        f32x4 bv[2][2];
#pragma unroll
        for (int bj = 0; bj < 2; ++bj)
#pragma unroll
            for (int n = 0; n < 2; ++n) bv[bj][n] = bias ? *(const f32x4*)(bias + bcol0 + bj * HALF + 4 * n) : (f32x4){0.f, 0.f, 0.f, 0.f};
#pragma unroll
        for (int ai = 0; ai < 2; ++ai)
#pragma unroll
            for (int m = 0; m < 4; ++m) { bf16_t* rowp = base + (size_t)(row0 + ai * HALF + m * 16) * ldc + col0;
#pragma unroll
                for (int bj = 0; bj < 2; ++bj) { f32x4 v0 = acc[ai][bj][m][0] + bv[bj][0], v1 = acc[ai][bj][m][1] + bv[bj][1];
                    if (ACT == 1) { f32x2 a = gelu_pk((f32x2){v0[0], v0[1]}), b = gelu_pk((f32x2){v0[2], v0[3]}), c = gelu_pk((f32x2){v1[0], v1[1]}), d = gelu_pk((f32x2){v1[2], v1[3]});
                        v0 = (f32x4){a.x, a.y, b.x, b.y}; v1 = (f32x4){c.x, c.y, d.x, d.y}; }
                    v0 = v0 * sc; v1 = v1 * sc; u32x4 w; w.x = cvt_pk_bf16(v0[0], v0[1]); w.y = cvt_pk_bf16(v0[2], v0[3]); w.z = cvt_pk_bf16(v1[0], v1[1]); w.w = cvt_pk_bf16(v1[2], v1[3]);
                    *(u32x4*)(rowp + bj * HALF) = w; } }
    }
};
__device__ __forceinline__ float silu_f(float x) { return x * __builtin_amdgcn_rcpf(1.0f + __expf(-x)); }
constexpr size_t SLOT_ELEMS = (size_t)32768 * 512;
struct EpiProj {
    static constexpr bool PERM = true, AFTER_DRAIN = false;
    bf16_t* base0; const float* hlb; int layer; float qscale;
    template <int MODE  > __device__ __forceinline__ void st_bf16(const f32x4 (&acc)[2][2][4][2], bf16_t* base, int row0, int col0, float sc) const {
#pragma unroll
        for (int ai = 0; ai < 2; ++ai)
#pragma unroll
            for (int m = 0; m < 4; ++m) { bf16_t* rowp = base + (size_t)(row0 + ai * HALF + m * 16) * 512 + col0;
#pragma unroll
                for (int bj = 0; bj < 2; ++bj) { f32x4 v0 = acc[ai][bj][m][0], v1 = acc[ai][bj][m][1];
                    if (MODE == 2) { v0 = (f32x4){silu_f(v0[0]), silu_f(v0[1]), silu_f(v0[2]), silu_f(v0[3])}; v1 = (f32x4){silu_f(v1[0]), silu_f(v1[1]), silu_f(v1[2]), silu_f(v1[3])}; }
                    if (MODE == 1) { v0 = v0 * sc; v1 = v1 * sc; }
                    u32x4 w; w.x = cvt_pk_bf16(v0[0], v0[1]); w.y = cvt_pk_bf16(v0[2], v0[3]); w.z = cvt_pk_bf16(v1[0], v1[1]); w.w = cvt_pk_bf16(v1[2], v1[3]);
                    *(u32x4*)(rowp + bj * HALF) = w; } }
    }
    template <bool LB0> static __device__ __forceinline__ float logf_gate(float z, float l) {
        const float e = __expf(-fabsf(z));
        if (LB0) return fminf(z, 0.f) - __logf(1.0f + e);
        const float r = __builtin_amdgcn_rcpf(1.0f + e); const float sg = (z >= 0.f) ? r : e * r;
        return __logf(l + (1.0f - l) * sg);
    }
    template <bool LB0> static __device__ __forceinline__ f32x4 logf_gate4(f32x4 v, f32x4 l) { return (f32x4){logf_gate<LB0>(v[0], l[0]), logf_gate<LB0>(v[1], l[1]), logf_gate<LB0>(v[2], l[2]), logf_gate<LB0>(v[3], l[3])}; }
    __device__ __forceinline__ f32x4 lb4(int c) const {
        const f32x4 h0 = *(const f32x4*)(hlb + c), h1 = *(const f32x4*)(hlb + 512 + c);
        return (f32x4){__builtin_amdgcn_rcpf(1.0f + __expf(h0[0] - h1[0])), __builtin_amdgcn_rcpf(1.0f + __expf(h0[1] - h1[1])), __builtin_amdgcn_rcpf(1.0f + __expf(h0[2] - h1[2])), __builtin_amdgcn_rcpf(1.0f + __expf(h0[3] - h1[3]))};
    }
    template <bool LB0> __device__ __forceinline__ void st_logf(const f32x4 (&acc)[2][2][4][2], float* base, int row0, int col0) const {
        const f32x4 z4 = (f32x4){0.f, 0.f, 0.f, 0.f};
        const f32x4 lA0 = LB0 ? z4 : lb4(col0), lA1 = LB0 ? z4 : lb4(col0 + 4), lB0 = LB0 ? z4 : lb4(col0 + HALF), lB1 = LB0 ? z4 : lb4(col0 + HALF + 4);
#pragma unroll
        for (int ai = 0; ai < 2; ++ai)
#pragma unroll
            for (int m = 0; m < 4; ++m) { float* rowp = base + (size_t)(row0 + ai * HALF + m * 16) * 512 + col0;
                *(f32x4*)(rowp) = logf_gate4<LB0>(acc[ai][0][m][0], lA0); *(f32x4*)(rowp + 4) = logf_gate4<LB0>(acc[ai][0][m][1], lA1);
                *(f32x4*)(rowp + HALF) = logf_gate4<LB0>(acc[ai][1][m][0], lB0); *(f32x4*)(rowp + HALF + 4) = logf_gate4<LB0>(acc[ai][1][m][1], lB1); }
    }
    __device__ __forceinline__ void operator()(const f32x4 (&acc)[2][2][4][2], const Unit& u, int wr, int wc, int fr, int fq) const {
        const int t = u.pn >> 1, colt = (u.pn & 1) * 256, slot = t < 5 ? t : t + 1;
        const int row0 = u.pm * BM + wr * 64 + fr, col0 = colt + wc * 32 + 8 * fq;
        bf16_t* base = base0 + (size_t)slot * SLOT_ELEMS;
        if (t == 4) { if (layer == 0) st_logf<true>(acc, (float*)base, row0, col0); else st_logf<false>(acc, (float*)base, row0, col0); }
        else if (t == 0) st_bf16<1>(acc, base, row0, col0, qscale);
        else if (t == 3 || t == 6) st_bf16<2>(acc, base, row0, col0, 1.f);
        else st_bf16<0>(acc, base, row0, col0, 1.f);
    }
};
struct EpiRes {
    static constexpr bool PERM = false, AFTER_DRAIN = false;
    const float* ysrc; float* ydst; const float* stats; const float* g; const float* b; float alpha;
    __device__ __forceinline__ void operator()(const f32x4 (&acc)[2][2][4][2], const Unit& u, int wr, int wc, int fr, int fq) const {
        const int col0 = u.pn * BM + wc * 32 + 4 * fq, rowb = u.pm * BM + wr * 64 + fr;
        float mu[2][4], rs[2][4];
#pragma unroll
        for (int ai = 0; ai < 2; ++ai)
#pragma unroll
            for (int m = 0; m < 4; ++m) { const f32x2 st = *(const f32x2*)(stats + 2 * (rowb + ai * HALF + m * 16)); mu[ai][m] = st.x; rs[ai][m] = st.y; }
#pragma unroll
        for (int bj = 0; bj < 2; ++bj)
#pragma unroll
            for (int n = 0; n < 2; ++n) { const int c = col0 + bj * HALF + n * 16;
                f32x4 y[2][4];
#pragma unroll
                for (int ai = 0; ai < 2; ++ai)
#pragma unroll
                    for (int m = 0; m < 4; ++m) y[ai][m] = *(const f32x4*)(ysrc + (size_t)(rowb + ai * HALF + m * 16) * 1024 + c);
                const f32x4 gv = *(const f32x4*)(g + c), bv = *(const f32x4*)(b + c);
#pragma unroll
                for (int ai = 0; ai < 2; ++ai)
#pragma unroll
                    for (int m = 0; m < 4; ++m) { const f32x4 o = (((y[ai][m] - mu[ai][m]) * rs[ai][m]) * gv + bv) * alpha + acc[ai][bj][m][n];
                        *(f32x4*)(ydst + (size_t)(rowb + ai * HALF + m * 16) * 1024 + c) = o; }
                asm volatile("" ::: "memory"); }
    }
};
struct EpiGate {
    static constexpr bool PERM = true, AFTER_DRAIN = false;
    bf16_t* G; float* halo; const float* cw; const float* cb;
    static __device__ __forceinline__ float ror1(float v) { return __builtin_bit_cast(float, __builtin_amdgcn_mov_dpp(__builtin_bit_cast(int, v), 0x121, 0xf, 0xf, false)); }
    static __device__ __forceinline__ float ror2(float v) { return __builtin_bit_cast(float, __builtin_amdgcn_mov_dpp(__builtin_bit_cast(int, v), 0x122, 0xf, 0xf, false)); }
    static __device__ __forceinline__ f32x4 ror1v(f32x4 v) { return (f32x4){ror1(v[0]), ror1(v[1]), ror1(v[2]), ror1(v[3])}; }
    static __device__ __forceinline__ f32x4 ror2v(f32x4 v) { return (f32x4){ror2(v[0]), ror2(v[1]), ror2(v[2]), ror2(v[3])}; }
    __device__ __forceinline__ void operator()(const f32x4 (&acc)[2][2][4][2], const Unit& u, int wr, int wc, int fr, int fq) const {
        const int rowb = u.pm * BM + wr * 64 + fr;
#pragma unroll
        for (int n = 0; n < 2; ++n) {
            const int ch = u.pn * 128 + wc * 32 + 8 * fq + 4 * n;
            const f32x4 wa0 = *(const f32x4*)(cw + ch), wa1 = *(const f32x4*)(cw + 5632 + ch), wa2 = *(const f32x4*)(cw + 2 * 5632 + ch), ba = *(const f32x4*)(cb + ch);
            const f32x4 wu0 = *(const f32x4*)(cw + 2816 + ch), wu1 = *(const f32x4*)(cw + 5632 + 2816 + ch), wu2 = *(const f32x4*)(cw + 2 * 5632 + 2816 + ch), bu = *(const f32x4*)(cb + 2816 + ch);
#pragma unroll
            for (int ai = 0; ai < 2; ++ai) {
                f32x4 pa1 = (f32x4){0.f, 0.f, 0.f, 0.f}, pa2 = pa1, pu1 = pa1, pu2 = pa1;
#pragma unroll
                for (int m = 0; m < 4; ++m) {
                    const f32x4 a = acc[ai][0][m][n], uu = acc[ai][1][m][n];
                    const f32x4 ra1 = ror1v(a), ra2 = ror2v(a), ru1 = ror1v(uu), ru2 = ror2v(uu);
                    const f32x4 a1 = (fr >= 1) ? ra1 : pa1, a2 = (fr >= 2) ? ra2 : pa2, u1 = (fr >= 1) ? ru1 : pu1, u2 = (fr >= 2) ? ru2 : pu2;
                    const f32x4 ya = wa0 * a2 + wa1 * a1 + wa2 * a + ba, yu = wu0 * u2 + wu1 * u1 + wu2 * uu + bu;
                    const f32x2 g0 = gelu_pk((f32x2){ya[0], ya[1]}), g1 = gelu_pk((f32x2){ya[2], ya[3]});
                    const int row = rowb + ai * HALF + m * 16;
                    if (m > 0 || fr >= 2) { typedef unsigned u32x2 __attribute__((ext_vector_type(2)));
                        u32x2 w; w.x = cvt_pk_bf16(g0.x * yu[0], g0.y * yu[1]); w.y = cvt_pk_bf16(g1.x * yu[2], g1.y * yu[3]); *(u32x2*)(G + (size_t)row * 2816 + ch) = w; }
                    if (m == 0 && fr < 2) { float* hp = halo + ((size_t)(row >> 6) * 4 + fr) * 5632 + ch; *(f32x4*)hp = a; *(f32x4*)(hp + 2816) = uu; }
                    if (m == 3 && fr >= 14) { float* hp = halo + ((size_t)(row >> 6) * 4 + (fr - 12)) * 5632 + ch; *(f32x4*)hp = a; *(f32x4*)(hp + 2816) = uu; }
                    pa1 = ra1; pa2 = ra2; pu1 = ru1; pu2 = ru2;
                }
            }
        }
    }
};
template <class Epi, class Sched, bool ALIGN_EPI = false, bool SP2 = false>
__device__ __forceinline__ void gemm_phase(PG8_LAS unsigned char* lds, const Gemm g, const Sched& S, const Epi& E) {
    int tid_ = threadIdx.x; asm volatile("" : "+v"(tid_)); const int tid = tid_, wid = __builtin_amdgcn_readfirstlane(tid >> 6), lane = tid & 63, wr = wid >> 2, wc = wid & 3, fr = lane & 15, fq = lane >> 4;
    const int K = g.K, nt = K / BK;
    unsigned voffA[2], voffB[2];
#pragma unroll
    for (int i = 0; i < 2; ++i) { int R, C; stage_rc(tid * 16 + i * 8192, R, C); const int Rb = Epi::PERM ? ((R & ~31) + perm32(R & 31)) : R;
        voffA[i] = (unsigned)(R * K + C) * 2u; voffB[i] = (unsigned)(Rb * K + C) * 2u; }
    const size_t kstep = (size_t)(BK * 2);
    const size_t hstep = (size_t)HALF * K * 2;
    const size_t tstep = 2 * hstep;
    const unsigned ldsw = (unsigned)wid * 1024u;
    const int aoff = lds_byte(wr * 64 + fr, fq * 8), boff = lds_byte(wc * 32 + fr, fq * 8);
#define PG8_SA(b, h) (((b) * 2 + (h)) * HTB)
#define PG8_SB(b, h) ((4 + (b) * 2 + (h)) * HTB)
#define PG8_STAGE(bufoff, gbase, voff) do { _Pragma("unroll") for (int _i = 0; _i < 2; ++_i) \
        __builtin_amdgcn_global_load_lds((const unsigned*)((const char*)(gbase) + (voff)[_i]), (PG8_LAS unsigned*)(lds + (bufoff) + ldsw + _i * 8192), 16, 0, 0); } while (0)
#define PG8_LDA(dst, b, h) do { _Pragma("unroll") for (int m = 0; m < 4; ++m) _Pragma("unroll") for (int k = 0; k < 2; ++k) dst[m][k] = *(const PG8_LAS bf16x8*)(lds + PG8_SA(b, h) + aoff + m * 2048 + k * 1024); } while (0)
#define PG8_LDB(dst, b, h) do { _Pragma("unroll") for (int n = 0; n < 2; ++n) _Pragma("unroll") for (int k = 0; k < 2; ++k) dst[n][k] = *(const PG8_LAS bf16x8*)(lds + PG8_SB(b, h) + boff + n * 2048 + k * 1024); } while (0)
#define PG8_MMA(ai, bj, At, Bt) do { __builtin_amdgcn_s_setprio(1); _Pragma("unroll") for (int m = 0; m < 4; ++m) _Pragma("unroll") for (int n = 0; n < 2; ++n) _Pragma("unroll") for (int k = 0; k < 2; ++k) \
        acc[ai][bj][m][n] = __builtin_amdgcn_mfma_f32_16x16x32_bf16(Bt[n][k], At[m][k], acc[ai][bj][m][n], 0, 0, 0); __builtin_amdgcn_s_setprio(0); } while (0)
#define PG8_WAIT_V(n) asm volatile("s_waitcnt vmcnt(" #n ")" ::: "memory")
#define PG8_WAIT_L(n) asm volatile("s_waitcnt lgkmcnt(" #n ")" ::: "memory")
#define PG8_BAR __builtin_amdgcn_s_barrier()
#define PG8_SCHED __builtin_amdgcn_sched_barrier(0)
    Unit cur, nxt; int ui = 0;
    if (!S.next(0, cur)) return;
    f32x4 acc[2][2][4][2];
#pragma unroll
    for (int a = 0; a < 2; ++a)
#pragma unroll
        for (int b = 0; b < 2; ++b)
#pragma unroll
            for (int m = 0; m < 4; ++m)
#pragma unroll
                for (int n = 0; n < 2; ++n) acc[a][b][m][n] = (f32x4){0.f, 0.f, 0.f, 0.f};
    bf16x8 At[4][2], B0[2][2], B1[2][2];
    const char* cA = (const char*)g.A + (size_t)cur.pm * tstep; const char* cB = (const char*)g.Bt + (size_t)cur.pn * tstep;
    S.a_ready(cur);
    if constexpr (SP2) {
        PG8_STAGE(PG8_SB(0, 0), cB, voffB); PG8_STAGE(PG8_SB(0, 1), cB + hstep, voffB); PG8_STAGE(PG8_SA(0, 0), cA, voffA); PG8_STAGE(PG8_SA(0, 1), cA + hstep, voffA);
        if (wr == 1) PG8_BAR;
        PG8_WAIT_V(2); PG8_BAR;
        PG8_STAGE(PG8_SB(1, 0), cB + kstep, voffB); PG8_STAGE(PG8_SA(1, 0), cA + kstep, voffA); PG8_STAGE(PG8_SB(1, 1), cB + hstep + kstep, voffB);
        PG8_WAIT_V(6); PG8_BAR;
    } else {
        PG8_STAGE(PG8_SB(0, 0), cB, voffB); PG8_STAGE(PG8_SA(0, 0), cA, voffA); PG8_STAGE(PG8_SB(0, 1), cB + hstep, voffB); PG8_STAGE(PG8_SA(0, 1), cA + hstep, voffA);
        if (wr == 1) PG8_BAR;
        PG8_WAIT_V(4); PG8_BAR;
        PG8_STAGE(PG8_SB(1, 0), cB + kstep, voffB); PG8_STAGE(PG8_SA(1, 0), cA + kstep, voffA); PG8_STAGE(PG8_SB(1, 1), cB + hstep + kstep, voffB);
        PG8_WAIT_V(6); PG8_BAR;
    }
    for (;;) {
        const bool has_next = S.next(ui + 1, nxt);
        const char* nA = has_next ? (const char*)g.A + (size_t)nxt.pm * tstep : cA; const char* nB = has_next ? (const char*)g.Bt + (size_t)nxt.pn * tstep : cB;
        for (int t = 0; t < nt; t += 2) {
            const bool last = (t == nt - 2);
            const char* a1 = cA + (size_t)(t + 1) * kstep;
            const char* a2 = last ? nA : cA + (size_t)(t + 2) * kstep; const char* b2 = last ? nB : cB + (size_t)(t + 2) * kstep;
            const char* a3 = a2 + kstep; const char* b3 = b2 + kstep;
            if (last && has_next) S.a_ready(nxt);
            if constexpr (SP2) {
            PG8_LDB(B0, 0, 0); PG8_LDB(B1, 0, 1); PG8_SCHED; PG8_LDA(At, 0, 0); PG8_STAGE(PG8_SA(1, 1), a1 + hstep, voffA);
            PG8_WAIT_V(8); PG8_WAIT_L(0); PG8_BAR; PG8_MMA(0, 0, At, B0); PG8_MMA(0, 1, At, B1); PG8_BAR; PG8_SCHED;
            PG8_LDA(At, 0, 1); PG8_STAGE(PG8_SB(0, 0), b2, voffB); PG8_STAGE(PG8_SB(0, 1), b2 + hstep, voffB); PG8_STAGE(PG8_SA(0, 0), a2, voffA);
            PG8_WAIT_V(8); PG8_WAIT_L(0); PG8_BAR; PG8_MMA(1, 0, At, B0); PG8_MMA(1, 1, At, B1); PG8_BAR; PG8_SCHED;
            PG8_LDB(B0, 1, 0); PG8_LDB(B1, 1, 1); PG8_SCHED; PG8_LDA(At, 1, 0); PG8_STAGE(PG8_SA(0, 1), a2 + hstep, voffA);
            PG8_WAIT_V(8); PG8_WAIT_L(0); PG8_BAR; PG8_MMA(0, 0, At, B0); PG8_MMA(0, 1, At, B1); PG8_BAR; PG8_SCHED;
            PG8_LDA(At, 1, 1); PG8_STAGE(PG8_SB(1, 0), b3, voffB); PG8_STAGE(PG8_SB(1, 1), b3 + hstep, voffB); PG8_STAGE(PG8_SA(1, 0), a3, voffA);
            PG8_WAIT_V(8); PG8_WAIT_L(0); PG8_BAR; PG8_MMA(1, 0, At, B0); PG8_MMA(1, 1, At, B1); PG8_BAR; PG8_SCHED;
            } else {
            PG8_LDB(B0, 0, 0); PG8_SCHED; PG8_LDA(At, 0, 0); PG8_STAGE(PG8_SA(1, 1), a1 + hstep, voffA);
            PG8_WAIT_L(8); PG8_BAR; PG8_WAIT_L(0); PG8_MMA(0, 0, At, B0); PG8_BAR; PG8_SCHED;
            PG8_LDB(B1, 0, 1); PG8_STAGE(PG8_SB(0, 0), b2, voffB);
            PG8_BAR; PG8_WAIT_L(0); PG8_MMA(0, 1, At, B1); PG8_BAR;
            PG8_LDA(At, 0, 1); PG8_STAGE(PG8_SA(0, 0), a2, voffA);
            PG8_BAR; PG8_WAIT_L(0); PG8_MMA(1, 0, At, B0); PG8_BAR; PG8_SCHED;
            PG8_STAGE(PG8_SB(0, 1), b2 + hstep, voffB);
            PG8_WAIT_V(6); PG8_BAR; PG8_MMA(1, 1, At, B1); PG8_BAR;
            PG8_LDB(B0, 1, 0); PG8_SCHED; PG8_LDA(At, 1, 0); PG8_STAGE(PG8_SA(0, 1), a2 + hstep, voffA);
            PG8_WAIT_L(8); PG8_BAR; PG8_WAIT_L(0); PG8_MMA(0, 0, At, B0); PG8_BAR; PG8_SCHED;
            PG8_LDB(B1, 1, 1); PG8_STAGE(PG8_SB(1, 0), b3, voffB);
            PG8_BAR; PG8_WAIT_L(0); PG8_MMA(0, 1, At, B1); PG8_BAR;
            PG8_LDA(At, 1, 1); PG8_STAGE(PG8_SA(1, 0), a3, voffA);
            PG8_BAR; PG8_WAIT_L(0); PG8_MMA(1, 0, At, B0); PG8_BAR; PG8_SCHED;
            PG8_STAGE(PG8_SB(1, 1), b3 + hstep, voffB);
            PG8_WAIT_V(6); PG8_BAR; PG8_MMA(1, 1, At, B1); PG8_BAR;
            }
        }
        if constexpr (ALIGN_EPI) { if (wr == 0) PG8_BAR; }
        if constexpr (!Epi::AFTER_DRAIN) { E(acc, cur, wr, wc, fr, fq); S.done(cur); }
        if (!has_next) break;
#pragma unroll
        for (int a = 0; a < 2; ++a)
#pragma unroll
            for (int b = 0; b < 2; ++b)
#pragma unroll
                for (int m = 0; m < 4; ++m)
#pragma unroll
                    for (int n = 0; n < 2; ++n) acc[a][b][m][n] = (f32x4){0.f, 0.f, 0.f, 0.f};
        cur = nxt; cA = nA; cB = nB; ++ui;
        if constexpr (ALIGN_EPI) { if (wr == 1) PG8_BAR; }
    }
    PG8_WAIT_V(0);
    if constexpr (!ALIGN_EPI) { if (wr == 0) PG8_BAR; }
    PG8_BAR;
    if constexpr (Epi::AFTER_DRAIN) { E.fused(acc, cur, wr, wc, fr, fq, lds, wid, lane); S.done(cur); }
#undef PG8_SA
#undef PG8_SB
#undef PG8_STAGE
#undef PG8_LDA
#undef PG8_LDB
#undef PG8_MMA
#undef PG8_WAIT_V
#undef PG8_WAIT_L
#undef PG8_BAR
#undef PG8_SCHED
}
}
namespace attn_body {
using bf16=__hip_bfloat16;
using bf16x8=__attribute__((ext_vector_type(8)))short;
using s16x4=__attribute__((ext_vector_type(4)))short;
using f32x16=__attribute__((ext_vector_type(16)))float;
using u32x4=__attribute__((ext_vector_type(4)))unsigned;
constexpr int BATCH=4,NHEAD=8,SEQ=8192,D=64,DM=NHEAD*D,OPITCH=1024;
constexpr int NW=8,QBLK=32,QB=QBLK*NW,KVBLK=64,NQB=SEQ/QB;
constexpr int ATTN_PITCH=DM, ATTN_UNIT_ROWS=QB;
__device__ __forceinline__ int crow(int r,int hi){return (r&3)+8*(r>>2)+4*hi;}
#define SBAR() __builtin_amdgcn_sched_barrier(0)
__device__ __forceinline__ void cmask(f32x16&p0,f32x16&p1,int jb,int qrel,int hi){
  const float NEG=-INFINITY; int kb=64*jb+4*hi;
  #pragma unroll
  for(int r=0;r<16;++r){int kv=kb+(r&3)+8*(r>>2); if(kv>qrel)p0[r]=NEG; if(kv+32>qrel)p1[r]=NEG;}
}

constexpr int NSLOT=3, SLOTB=8192;
constexpr int LDS_K=0, LDS_V=NSLOT*SLOTB, LDS_WS=2*NSLOT*SLOTB, LDS_OST=LDS_WS+NW*64*4, LDS_CK=LDS_OST+NW*4096, LDS_BYTES=LDS_CK+SEQ*4;
constexpr float C2=0.125f*1.4426950408889634f;
__device__ __forceinline__ void glds16(const void*gsrc,unsigned lds_dst){unsigned keep;
  asm volatile("s_mov_b32 %0, m0\n\ts_mov_b32 m0, %2\n\ts_nop 0\n\tglobal_load_lds_dwordx4 %1, off\n\ts_mov_b32 m0, %0":"=&s"(keep):"v"(gsrc),"s"(lds_dst):"memory");}
__device__ __forceinline__ float max3f(float a,float b,float c){float r;asm("v_max3_f32 %0, %1, %2, %3":"=v"(r):"v"(a),"v"(b),"v"(c));return r;}
__device__ __forceinline__ float max2f(float a,float b){float r;asm("v_max_f32_e32 %0, %1, %2":"=v"(r):"v"(a),"v"(b));return r;}
__device__ __forceinline__ float fadd_s(float a,float b){float r;asm("v_add_f32_e32 %0, %1, %2":"=v"(r):"v"(a),"v"(b));return r;}
__device__ __forceinline__ float fsub_s(float a,float b){float r;asm("v_sub_f32_e32 %0, %1, %2":"=v"(r):"v"(a),"v"(b));return r;}
typedef float f32x2_t __attribute__((ext_vector_type(2))); typedef __bf16 bf16x2_t __attribute__((ext_vector_type(2)));
__device__ __forceinline__ unsigned cvtpk_s(float lo,float hi){f32x2_t v={lo,hi};bf16x2_t b=__builtin_convertvector(v,bf16x2_t);return __builtin_bit_cast(unsigned,b);}
#define WAIT_BAR(N) asm volatile("s_waitcnt vmcnt(" #N ") lgkmcnt(0)\n\ts_barrier":::"memory")

__device__ __forceinline__ void qkt(f32x16&p0,f32x16&p1,const char*Kslot,const bf16x8*qr,const f32x16&negm,int r32,int hi){
  const char*kb=Kslot+hi*1024+r32*16;
  #pragma unroll
  for(int d0=0;d0<4;++d0){
    const bf16x8 b0=*reinterpret_cast<const bf16x8*>(kb+d0*2048);
    const bf16x8 b1=*reinterpret_cast<const bf16x8*>(kb+d0*2048+512);
    if(d0==0){p0=__builtin_amdgcn_mfma_f32_32x32x16_bf16(b0,qr[0],negm,0,0,0);p1=__builtin_amdgcn_mfma_f32_32x32x16_bf16(b1,qr[0],negm,0,0,0);}
    else{p0=__builtin_amdgcn_mfma_f32_32x32x16_bf16(b0,qr[d0],p0,0,0,0);p1=__builtin_amdgcn_mfma_f32_32x32x16_bf16(b1,qr[d0],p1,0,0,0);}}
}
typedef __attribute__((address_space(3))) const char* lds_cptr;
typedef short v4i16_t __attribute__((ext_vector_type(4)));
__device__ __forceinline__ void kload8(bf16x8*kf,lds_cptr kp){
  kf[0]=*(const __attribute__((address_space(3))) bf16x8*)(kp);      kf[1]=*(const __attribute__((address_space(3))) bf16x8*)(kp+512);
  kf[2]=*(const __attribute__((address_space(3))) bf16x8*)(kp+2048); kf[3]=*(const __attribute__((address_space(3))) bf16x8*)(kp+2560);
  kf[4]=*(const __attribute__((address_space(3))) bf16x8*)(kp+4096); kf[5]=*(const __attribute__((address_space(3))) bf16x8*)(kp+4608);
  kf[6]=*(const __attribute__((address_space(3))) bf16x8*)(kp+6144); kf[7]=*(const __attribute__((address_space(3))) bf16x8*)(kp+6656);
}
__device__ __forceinline__ void kload2(bf16x8*kf,lds_cptr kp,int j){ kf[2*j]=*(const __attribute__((address_space(3))) bf16x8*)(kp+j*2048); kf[2*j+1]=*(const __attribute__((address_space(3))) bf16x8*)(kp+j*2048+512); }
__device__ __forceinline__ s16x4 vtr(lds_cptr p){ return __builtin_bit_cast(s16x4,__builtin_amdgcn_ds_read_tr16_b64_v4i16((__attribute__((address_space(3))) v4i16_t*)p)); }
__device__ __forceinline__ float rowmax(const f32x16&p0,const f32x16&p1){
  float a=max3f(p0[0],p0[1],p1[0]),b=max3f(p0[2],p0[3],p1[1]);a=max3f(a,p1[2],p1[3]);
  #pragma unroll
  for(int r=4;r<16;r+=4){a=max3f(a,p0[r],p0[r+1]);b=max3f(b,p0[r+2],p0[r+3]);a=max3f(a,p1[r],p1[r+1]);b=max3f(b,p1[r+2],p1[r+3]);}
  const float m=max2f(a,b);
  auto rr=__builtin_amdgcn_permlane32_swap(__float_as_uint(m),__float_as_uint(m),false,false);
  return max2f(__uint_as_float(rr[0]),__uint_as_float(rr[1]));
}
__device__ __forceinline__ void pv(f32x16*o,int vb,bf16x8 pa0,bf16x8 pa1,bf16x8 pa2,bf16x8 pa3){
  #pragma unroll
  for(int d0=0;d0<2;++d0){s16x4 lo[4],hi[4];
    #pragma unroll
    for(int ks=0;ks<4;++ks){
      asm volatile("ds_read_b64_tr_b16 %0,%1 offset:%c2":"=&v"(lo[ks]):"v"(vb),"i"(d0*4096+ks*1024):"memory");
      asm volatile("ds_read_b64_tr_b16 %0,%1 offset:%c2":"=&v"(hi[ks]):"v"(vb),"i"(d0*4096+ks*1024+512):"memory");}
    asm volatile("s_waitcnt lgkmcnt(0)":::"memory");SBAR();
    #define PK(k) (bf16x8){lo[k][0],lo[k][1],lo[k][2],lo[k][3],hi[k][0],hi[k][1],hi[k][2],hi[k][3]}
    o[d0]=__builtin_amdgcn_mfma_f32_32x32x16_bf16(pa0,PK(0),o[d0],0,0,0);
    o[d0]=__builtin_amdgcn_mfma_f32_32x32x16_bf16(pa1,PK(1),o[d0],0,0,0);
    o[d0]=__builtin_amdgcn_mfma_f32_32x32x16_bf16(pa2,PK(2),o[d0],0,0,0);
    o[d0]=__builtin_amdgcn_mfma_f32_32x32x16_bf16(pa3,PK(3),o[d0],0,0,0);
    #undef PK
  }
}

#ifndef ATTN_STORE16
#define ATTN_STORE16(p,v) (*(u32x4*)(p)=(v))
#endif
template<int THRL> __device__ __forceinline__ void attn_unit(int b,int h,int qb,const bf16*Q,const bf16*__restrict__ K,const bf16*__restrict__ V,bf16*O,const float*__restrict__ c2,const float*__restrict__ gnorm,int ts,char*shm){
  int tid_=threadIdx.x; asm volatile("":"+v"(tid_)); const int tid=tid_,lane=tid&63,r32=lane&31,hi=lane>>5; const int wid=__builtin_amdgcn_readfirstlane(tid>>6);
  const long rowbase=(long)b*SEQ; const int q0=qb*QB;
  const bf16*Qw=Q+(rowbase+q0+wid*QBLK)*DM+h*D;
  const bf16*Kh=K+(rowbase+(long)ts*KVBLK)*DM+h*D,*Vh=V+(rowbase+(long)ts*KVBLK)*DM+h*D;
  const unsigned lds0=(unsigned)(uintptr_t)shm;
  float*wsf=(float*)(shm+LDS_WS)+wid*64;
  const bf16*ksrc=Kh+(long)lane*DM+wid*8;
  const bf16*vsrc=Vh+(long)(16*(wid&3)+(lane>>2))*DM+(wid>>2)*32+(lane&3)*8;
  const unsigned kdst=lds0+LDS_K+wid*1024, vdst=lds0+LDS_V+wid*1024;
  #define DMA_K(t,slot) glds16(ksrc+(long)(t)*KVBLK*DM,(unsigned)__builtin_amdgcn_readfirstlane(kdst+(slot)))
  #define DMA_V(t,slot) glds16(vsrc+(long)(t)*KVBLK*DM,(unsigned)__builtin_amdgcn_readfirstlane(vdst+(slot)))
  const int vb0=(int)(lds0+LDS_V)+((lane>>4)&1)*32+(lane&3)*8+(4*hi+((lane&15)>>2))*64;
  const char*Kbase=shm+LDS_K; bf16x8 kf[8];
  const lds_cptr shm3=(lds_cptr)shm; const lds_cptr kp0=shm3+LDS_K+hi*1024+r32*16; const lds_cptr vp0=shm3+LDS_V+((lane>>4)&1)*32+(lane&3)*8+(4*hi+((lane&15)>>2))*64;
  const int NT=(q0+QB)/KVBLK-ts;
  DMA_K(0,0);DMA_V(0,0);DMA_K(1,SLOTB);
  bf16x8 qr[4];
  #pragma unroll
  for(int d0=0;d0<4;++d0)qr[d0]=*reinterpret_cast<const bf16x8*>(&Qw[(long)r32*DM+d0*16+hi*8]);
  float mhat=0.f,l_reg=0.f;f32x16 o[2];o[0]=f32x16{};o[1]=f32x16{};f32x16 negm=f32x16{};asm volatile("":"+v"(negm));
  const int qrel=wid*QBLK+r32;
  #define CMASK(P0,P1,t) do{int jb_=(t)-(NT-4); if(jb_>=0)cmask(P0,P1,jb_,qrel,hi);}while(0)
  bool resc=false;
  #define START(P0,P1) do{ const float rm=*(const __attribute__((address_space(3))) float*)(shm3+LDS_CK+4*(q0-ts*KVBLK+wid*QBLK+r32)); resc=false; \
    { const float dl=rm; mhat=fadd_s(mhat,dl); \
      _Pragma("unroll") for(int r=0;r<16;++r){P0[r]=fsub_s(P0[r],dl);P1[r]=fsub_s(P1[r],dl);} \
      _Pragma("unroll") for(int r=0;r<16;++r)negm[r]=-mhat; asm volatile("":"+v"(negm)); } \
    _Pragma("unroll") for(int r=0;r<16;++r)P0[r]=__builtin_amdgcn_exp2f(P0[r]); }while(0)
  #define RESC() do{ if(resc){ asm volatile("s_waitcnt lgkmcnt(0)":::"memory"); \
      _Pragma("unroll") for(int d_=0;d_<2;++d_) _Pragma("unroll") for(int r=0;r<16;++r)o[d_][r]*=wsf[crow(r,hi)]; } }while(0)
  f32x16 pA0,pA1,pB0,pB1;
  int sl_prev=0,sl_cur=0,sl_next=SLOTB;
  #define ROT() do{sl_prev=sl_cur;sl_cur=sl_next;sl_next=(sl_next==(NSLOT-1)*SLOTB)?0:sl_next+SLOTB;}while(0)
  { typedef float f32x4v __attribute__((ext_vector_type(4)));
    const float*cb=c2+((long)(b*NHEAD+h))*SEQ; const float cref=cb[q0+QB-1];
    for(int i=tid;i<(q0+QB)/4-ts*16;i+=NW*64){ const f32x4v v=*(const f32x4v*)(cb+ts*64+4*i); *(__attribute__((address_space(3))) f32x4v*)((lds_cptr)shm+LDS_CK+16*i)=(f32x4v){cref-v[0],cref-v[1],cref-v[2],cref-v[3]}; } }
  DMA_K(2,2*SLOTB);
  WAIT_BAR(3);
  typedef float f32x4w __attribute__((ext_vector_type(4)));
  #define CKADD(P0,P1,t) do{ const __attribute__((address_space(3))) f32x4w*cp_=(const __attribute__((address_space(3))) f32x4w*)(shm3+LDS_CK)+(t)*16+hi; \
    { SBAR(); const f32x4w a0_=cp_[0],a1_=cp_[2],a2_=cp_[4],a3_=cp_[6]; \
      P0[0]+=a0_[0];P0[1]+=a0_[1];P0[2]+=a0_[2];P0[3]+=a0_[3]; P0[4]+=a1_[0];P0[5]+=a1_[1];P0[6]+=a1_[2];P0[7]+=a1_[3]; \
      P0[8]+=a2_[0];P0[9]+=a2_[1];P0[10]+=a2_[2];P0[11]+=a2_[3]; P0[12]+=a3_[0];P0[13]+=a3_[1];P0[14]+=a3_[2];P0[15]+=a3_[3]; } \
    { SBAR(); const f32x4w b0_=cp_[8],b1_=cp_[10],b2_=cp_[12],b3_=cp_[14]; \
      P1[0]+=b0_[0];P1[1]+=b0_[1];P1[2]+=b0_[2];P1[3]+=b0_[3]; P1[4]+=b1_[0];P1[5]+=b1_[1];P1[6]+=b1_[2];P1[7]+=b1_[3]; \
      P1[8]+=b2_[0];P1[9]+=b2_[1];P1[10]+=b2_[2];P1[11]+=b2_[3]; P1[12]+=b3_[0];P1[13]+=b3_[1];P1[14]+=b3_[2];P1[15]+=b3_[3]; } }while(0)
  qkt(pA0,pA1,Kbase,qr,negm,r32,hi);asm volatile("s_nop 15\n\ts_nop 7":"+v"(pA0),"+v"(pA1));CKADD(pA0,pA1,0);CMASK(pA0,pA1,0);
  START(pA0,pA1);
  _Pragma("unroll") for(int r=0;r<16;++r)pA1[r]=__builtin_amdgcn_exp2f(pA1[r]);
  WAIT_BAR(0);
  DMA_K(3,0);DMA_V(1,SLOTB);
  ROT();
  kload8(kf,kp0+sl_cur);
  WAIT_BAR(2);
  s16x4 vlo[8],vhi[8]; u32x4 pw0,pw1,pw2,pw3;
  #define PKW(P,B) cvtpk_s(P[B],P[B+1])
  #define PAF(k) __builtin_bit_cast(bf16x8,pw##k)
  #define VFR(i) (bf16x8){vlo[i][0],vlo[i][1],vlo[i][2],vlo[i][3],vhi[i][0],vhi[i][1],vhi[i][2],vhi[i][3]}
  #define PIN(x) asm volatile("":"+v"(x))
  #define MX3(a,b,c) __builtin_fmaxf(__builtin_fmaxf((a),(b)),(c))
  #define GAPA(MF,A0,A1,A2,A3,W0,W1,PW) do{ MF; sacc+=A0; sacc+=A1; sacc+=A2; sacc+=A3; PIN(sacc); W0; W1; PIN(PW); SBAR(); }while(0)
  #define EX(v) __builtin_amdgcn_exp2f(v)
  #define GAPB(MF,X,B) do{ MF; X[B]=EX(X[B]); X[B+1]=EX(X[B+1]); X[B+2]=EX(X[B+2]); X[B+3]=EX(X[B+3]); PIN(X); SBAR(); }while(0)
  #define VRD(i) do{ vlo[i]=vtr(vp_+(((i)>>2)*4096+((i)&3)*1024)); vhi[i]=vtr(vp_+(((i)>>2)*4096+((i)&3)*1024+512)); }while(0)
  #define KRD(G,j) do{ if(G){ kload2(kf,kp0+sl_next,j); SBAR(); } }while(0)
  #define STEP(C0,C1,P0,P1,t,GK,GV,GL) do{ SBAR(); \
    const lds_cptr vp_=vp0+sl_prev; \
    VRD(0); SBAR(); float sacc=(P0[0]+P0[1]); \
    GAPA(C0=__builtin_amdgcn_mfma_f32_32x32x16_bf16(kf[0],qr[0],negm,0,0,0), P0[2],P0[3],P0[4],P0[5],     pw0[0]=PKW(P0,0), pw0[1]=PKW(P0,2), pw0); \
    VRD(4); SBAR(); GAPA(C1=__builtin_amdgcn_mfma_f32_32x32x16_bf16(kf[1],qr[0],negm,0,0,0), P0[6],P0[7],P0[8],P0[9],     pw0[2]=PKW(P0,4), pw0[3]=PKW(P0,6), pw0); \
    VRD(1); SBAR(); GAPA(C0=__builtin_amdgcn_mfma_f32_32x32x16_bf16(kf[2],qr[1],C0,0,0,0),   P0[10],P0[11],P0[12],P0[13], pw1[0]=PKW(P0,8), pw1[1]=PKW(P0,10), pw1); \
    VRD(5); SBAR(); GAPA(C1=__builtin_amdgcn_mfma_f32_32x32x16_bf16(kf[3],qr[1],C1,0,0,0),   P0[14],P0[15],P1[0],P1[1],   pw1[2]=PKW(P0,12),pw1[3]=PKW(P0,14), pw1); \
    VRD(2); SBAR(); GAPA(C0=__builtin_amdgcn_mfma_f32_32x32x16_bf16(kf[4],qr[2],C0,0,0,0),   P1[2],P1[3],P1[4],P1[5],     pw2[0]=PKW(P1,0), pw2[1]=PKW(P1,2), pw2); \
    VRD(6); SBAR(); GAPA(C1=__builtin_amdgcn_mfma_f32_32x32x16_bf16(kf[5],qr[2],C1,0,0,0),   P1[6],P1[7],P1[8],P1[9],     pw2[2]=PKW(P1,4), pw2[3]=PKW(P1,6), pw2); \
    VRD(3); SBAR(); GAPA(C0=__builtin_amdgcn_mfma_f32_32x32x16_bf16(kf[6],qr[3],C0,0,0,0),   P1[10],P1[11],P1[12],P1[13], pw3[0]=PKW(P1,8), pw3[1]=PKW(P1,10), pw3); \
    VRD(7); SBAR(); GAPA(C1=__builtin_amdgcn_mfma_f32_32x32x16_bf16(kf[7],qr[3],C1,0,0,0),   P1[14],P1[15],0.f,0.f,       pw3[2]=PKW(P1,12),pw3[3]=PKW(P1,14), pw3); \
    l_reg+=sacc; \
    if(GK){DMA_K((t)+3,sl_cur);} if(GV){DMA_V((t)+1,sl_next);} \
    CKADD(C0,C1,t); CMASK(C0,C1,t); \
    { float a=MX3(C0[0],C0[1],C1[0]),b=MX3(C0[2],C0[3],C1[1]); a=MX3(a,C1[2],C1[3]); \
      _Pragma("unroll") for(int r=4;r<16;r+=4){a=MX3(a,C0[r],C0[r+1]);b=MX3(b,C0[r+2],C0[r+3]);a=MX3(a,C1[r],C1[r+1]);b=MX3(b,C1[r+2],C1[r+3]);} \
      float rm=__builtin_fmaxf(a,b); { auto rr=__builtin_amdgcn_permlane32_swap(__float_as_uint(rm),__float_as_uint(rm),false,false); rm=__builtin_fmaxf(__uint_as_float(rr[0]),__uint_as_float(rr[1])); } \
      resc=false; \
      if(__builtin_expect(__any(rm>(float)THRL),0)){ const float dl=__builtin_fmaxf(rm,0.f); mhat+=dl; \
        _Pragma("unroll") for(int r=0;r<16;++r){C0[r]-=dl;C1[r]-=dl;} \
        _Pragma("unroll") for(int r=0;r<16;++r)negm[r]=-mhat; asm volatile("":"+v"(negm)); \
        const float f=__builtin_amdgcn_exp2f(-dl); l_reg*=f; if(hi==0)wsf[r32]=f; resc=true; } } \
    SBAR(); \
    GAPB(o[0]=__builtin_amdgcn_mfma_f32_32x32x16_bf16(PAF(0),VFR(0),o[0],0,0,0), C0,0); \
    GAPB(o[1]=__builtin_amdgcn_mfma_f32_32x32x16_bf16(PAF(0),VFR(4),o[1],0,0,0), C0,4); \
    KRD(GL,0); GAPB(o[0]=__builtin_amdgcn_mfma_f32_32x32x16_bf16(PAF(1),VFR(1),o[0],0,0,0), C0,8); \
    KRD(GL,1); GAPB(o[1]=__builtin_amdgcn_mfma_f32_32x32x16_bf16(PAF(1),VFR(5),o[1],0,0,0), C0,12); \
    KRD(GL,2); GAPB(o[0]=__builtin_amdgcn_mfma_f32_32x32x16_bf16(PAF(2),VFR(2),o[0],0,0,0), C1,0); \
    KRD(GL,3); GAPB(o[1]=__builtin_amdgcn_mfma_f32_32x32x16_bf16(PAF(2),VFR(6),o[1],0,0,0), C1,4); \
    GAPB(o[0]=__builtin_amdgcn_mfma_f32_32x32x16_bf16(PAF(3),VFR(3),o[0],0,0,0), C1,8); \
    GAPB(o[1]=__builtin_amdgcn_mfma_f32_32x32x16_bf16(PAF(3),VFR(7),o[1],0,0,0), C1,12); \
    }while(0)
  int t=1;
  #undef CMASK
  #define CMASK(P0,P1,t) do{}while(0)
  for(;t+5<NT;t+=2){
    STEP(pB0,pB1,pA0,pA1,t,true,true,true);     WAIT_BAR(2); RESC(); ROT();
    STEP(pA0,pA1,pB0,pB1,t+1,true,true,true);   WAIT_BAR(2); RESC(); ROT();
  }
  #undef CMASK
  #define CMASK(P0,P1,t) do{int jb_=(t)-(NT-4); if(jb_>=0)cmask(P0,P1,jb_,qrel,hi);}while(0)
  #define ENDW(tt) do{ if((tt)+3<NT){WAIT_BAR(2);} else if((tt)+2<NT){WAIT_BAR(1);} else {WAIT_BAR(0);} }while(0)
  for(;t+1<NT;t+=2){
    STEP(pB0,pB1,pA0,pA1,t,(t+3<NT),(t+1<NT),(t+1<NT));       ENDW(t);   RESC(); ROT();
    STEP(pA0,pA1,pB0,pB1,t+1,(t+4<NT),(t+2<NT),(t+2<NT));     ENDW(t+1); RESC(); ROT();
  }
  STEP(pB0,pB1,pA0,pA1,NT-1,false,false,false); RESC();
  { float sacc=pB0[0]+pB0[1]; _Pragma("unroll") for(int r=2;r<16;++r)sacc+=pB0[r]; _Pragma("unroll") for(int r=0;r<16;++r)sacc+=pB1[r]; l_reg+=sacc;
    pw0=(u32x4){PKW(pB0,0),PKW(pB0,2),PKW(pB0,4),PKW(pB0,6)};pw1=(u32x4){PKW(pB0,8),PKW(pB0,10),PKW(pB0,12),PKW(pB0,14)};pw2=(u32x4){PKW(pB1,0),PKW(pB1,2),PKW(pB1,4),PKW(pB1,6)};pw3=(u32x4){PKW(pB1,8),PKW(pB1,10),PKW(pB1,12),PKW(pB1,14)};
    SBAR(); pv(o,vb0+sl_cur,PAF(0),PAF(1),PAF(2),PAF(3)); }
  #undef PKW
  #undef PAF
  #undef VFR
  #undef PIN
  #undef MX3
  #undef GAPA
  #undef GAPB
  #undef EX
  #undef VRD
  #undef KRD
  #undef STEP
  #undef ENDW
  {auto rr=__builtin_amdgcn_permlane32_swap(__float_as_uint(l_reg),__float_as_uint(l_reg),false,false);l_reg=__uint_as_float(rr[0])+__uint_as_float(rr[1]);}
  if(hi==0)wsf[32+r32]=l_reg;asm volatile("s_waitcnt lgkmcnt(0)":::"memory");
  float rli[16];
  #pragma unroll
  for(int r=0;r<16;++r)rli[r]=__builtin_amdgcn_rcpf(wsf[32+crow(r,hi)]);
  { const float g0=gnorm[h*D+r32],g1=gnorm[h*D+32+r32];
    #pragma unroll
    for(int r=0;r<16;++r){ const float x0=o[0][r]*rli[r],x1=o[1][r]*rli[r]; float s=x0*x0+x1*x1;
      s+=__shfl_xor(s,1);s+=__shfl_xor(s,2);s+=__shfl_xor(s,4);s+=__shfl_xor(s,8);s+=__shfl_xor(s,16);
      const float sc=1.0f/sqrtf(s*(1.0f/64.0f)+1e-6f); o[0][r]=x0*sc*g0; o[1][r]=x1*sc*g1; rli[r]=1.0f; } }
  bf16*Ow=O+(rowbase+q0+wid*QBLK)*OPITCH+h*D;
  { bf16*stg=(bf16*)(shm+LDS_OST)+wid*2048;
    #pragma unroll
    for(int r=0;r<16;++r){const int orow=crow(r,hi);
      #pragma unroll
      for(int d0=0;d0<2;++d0)stg[orow*64+d0*32+r32]=__float2bfloat16(o[d0][r]*rli[r]);}
    asm volatile("s_waitcnt lgkmcnt(0)":::"memory");
    #pragma unroll
    for(int i=0;i<4;++i){const int row=i*8+(lane>>3),ch=lane&7; const u32x4 v=*(const u32x4*)(stg+row*64+ch*8); ATTN_STORE16(Ow+(long)row*OPITCH+ch*8,v);} }
  asm volatile("s_waitcnt lgkmcnt(0)\n\ts_barrier":::"memory");
  #undef DMA_K
  #undef DMA_V
  #undef CMASK
  #undef CKADD
  #undef START
  #undef RESC
  #undef ROT
}
constexpr int ATTN_LDS_BYTES=LDS_BYTES;
#undef SBAR
#undef WAIT_BAR
}
constexpr int NWAVES = 8;
constexpr int BATCH = 4, SEQ = 8192, M = BATCH * SEQ, D = 1024, DFF = 2816, INC = 3592, NPROJ = 3584;
constexpr int NP1 = 1536, NP2 = 1280;
constexpr float LN_EPS = 1e-5f, RMS_EPS = 1e-6f;
constexpr float DN_ALPHA = 1.4142135623730951f;
constexpr float LOG2E = 1.4426950408889634f;
constexpr size_t MiB = 1u << 20;
constexpr size_t WS_CTL = 0, CTL_ZERO_BYTES = 49152;
constexpr int CW_BAR = 8192;
constexpr int CW_KMAX = 1024, CW_QMAX = 2048, CW_TS = 4096;
constexpr size_t WS_WFA = 1 * MiB;
constexpr size_t WS_STATS = 2 * MiB;
constexpr size_t WS_C2 = 4 * MiB;
constexpr size_t WS_LFA = 5 * MiB;
constexpr size_t WS_WIN = 8 * MiB, WS_WO = 22 * MiB, WS_WUP = 26 * MiB, WS_WDN = 48 * MiB;
constexpr size_t WS_XN = 60 * MiB;
constexpr size_t WS_SLOT0 = 124 * MiB;
constexpr size_t WS_MIX = 380 * MiB;
constexpr size_t WS_HALO = 124 * MiB;
constexpr size_t WS_SUB = 124 * MiB;
constexpr size_t WS_G = 316 * MiB;
constexpr size_t WS_HQS = 444 * MiB, WS_HOI = 476 * MiB, WS_HDL = 508 * MiB;
constexpr size_t WS_END = 512 * MiB;
static_assert(WS_G + (size_t)M * DFF * 2 <= WS_END && WS_HALO + (size_t)(M / 64) * 4 * 5632 * 4 <= WS_G && WS_MIX + (size_t)M * 1024 * 2 <= WS_END, "ws map");
constexpr int RING_BYTES = 131072, MISC_OFF = RING_BYTES + 320, LDS_BYTES = 147456;

#define GAS __attribute__((address_space(1)))
#define LAS __attribute__((address_space(3)))
typedef unsigned short bf16;
typedef unsigned v4u __attribute__((ext_vector_type(4)));
typedef float f32x4 __attribute__((ext_vector_type(4)));
typedef short bf16x8 __attribute__((ext_vector_type(8)));
typedef short bf16x4 __attribute__((ext_vector_type(4)));
#define LDS_WAIT() asm volatile("s_waitcnt lgkmcnt(0)" ::: "memory")
__device__ __forceinline__ unsigned f2bf(float f) { unsigned u = __builtin_bit_cast(unsigned, f); return (u + 0x7fffu + ((u >> 16) & 1u)) >> 16; }
__device__ __forceinline__ unsigned pk2(float lo, float hi) { return f2bf(lo) | (f2bf(hi) << 16); }
__device__ __forceinline__ float bf2f(unsigned short v) { return __uint_as_float((unsigned)v << 16); }
__device__ __forceinline__ float wave_sum(float v) {
#pragma unroll
    for (int o = 1; o < 64; o <<= 1) v += __shfl_xor(v, o);
    return v;
}
__device__ __forceinline__ void p0_transpose_item(const float* W, int ldw, int K, int N, bf16* WT, int row_off, LAS float* scr, int item, int lane) {
    const int nblk = N / 32, kb = item / nblk, nb = item % nblk, k0 = 64 * kb, n0 = 32 * nb;
#pragma unroll
    for (int i = 0; i < 8; ++i) { const int kk = 8 * i + (lane >> 3), c4 = (lane & 7) * 4; const f32x4 v = *(const f32x4*)(W + (size_t)(k0 + kk) * ldw + n0 + c4);
        scr[kk * 33 + c4] = v.x; scr[kk * 33 + c4 + 1] = v.y; scr[kk * 33 + c4 + 2] = v.z; scr[kk * 33 + c4 + 3] = v.w; }
    LDS_WAIT(); asm volatile("" ::: "memory");
    const int c = lane & 7;
#pragma unroll
    for (int j = 0; j < 4; ++j) { const int n = (lane >> 3) + 8 * j; const LAS float* s = scr + (8 * c) * 33 + n;
        v4u o; o.x = pk2(s[0 * 33], s[1 * 33]); o.y = pk2(s[2 * 33], s[3 * 33]); o.z = pk2(s[4 * 33], s[5 * 33]); o.w = pk2(s[6 * 33], s[7 * 33]);
        *(GAS v4u*)(WT + (size_t)(row_off + n0 + n) * K + k0 + 8 * c) = o; }
    LDS_WAIT(); asm volatile("" ::: "memory");
}

typedef GAS unsigned gu32;
#define RLX_AGENT __ATOMIC_RELAXED, __HIP_MEMORY_SCOPE_AGENT
#define XB_TMO      128
#define XB_XCNT(j)  (256  + 64 * (j))
#define XB_XSUB(j)  (1280 + 64 * (j))
#define XB_XGEN(j)  (2304 + 64 * (j))
#define XB_TOP      3328
#define XB_TOPGEN   3392
#define XCD_BAR_WORDS 3456
#define XB_SPIN_CAP (1u << 18)

__device__ __forceinline__ unsigned xb_ld(unsigned* p)              { return __hip_atomic_load(p, __ATOMIC_RELAXED, __HIP_MEMORY_SCOPE_AGENT); }
__device__ __forceinline__ unsigned xb_add(unsigned* p, unsigned v) { return __hip_atomic_fetch_add(p, v, __ATOMIC_RELAXED, __HIP_MEMORY_SCOPE_AGENT); }
__device__ __forceinline__ unsigned xb_xcc_id() { return (unsigned)__builtin_amdgcn_s_getreg((3 << 11) | 20) & 0xFu; }
#define XB_SPIN(cond, bar) do { unsigned _sp = 0; while (cond) { __builtin_amdgcn_s_sleep(1); \
    if ((++_sp & 255u) == 0u) { if (xb_ld(&(bar)[XB_TMO])) break; if (_sp > XB_SPIN_CAP) { atomicAdd(&(bar)[XB_TMO], 1u); break; } } } } while (0)

struct XcdBarrier {
    unsigned* bar; unsigned x;
    volatile LAS unsigned* st;
};

__device__ __forceinline__ XcdBarrier xcd_barrier_post(unsigned* bar, volatile LAS unsigned* st) {
    XcdBarrier b; b.bar = bar; b.x = xb_xcc_id(); b.st = st;
    if (threadIdx.x == 0) (void)xb_add(&bar[XB_XCNT(b.x)], 1u);
    return b;
}
__device__ __forceinline__ void xcd_barrier_complete(unsigned* bar, unsigned x, unsigned& nloc, unsigned& nx) {
    const unsigned G = gridDim.x * gridDim.y * gridDim.z;
    unsigned sum, cnt, mine, sp = 0u;
    for (;;) {
        sum = 0u; cnt = 0u; mine = 0u;
#pragma unroll
        for (unsigned j = 0; j < 16; ++j) { const unsigned c = xb_ld(&bar[XB_XCNT(j)]); sum += c; cnt += (c > 0u) ? 1u : 0u; mine = (j == x) ? c : mine; }
        if (sum == G) break;
        __builtin_amdgcn_s_sleep(1);
        if ((++sp & 255u) == 0u) { if (xb_ld(&bar[XB_TMO])) break; if (sp > XB_SPIN_CAP) { atomicAdd(&bar[XB_TMO], 1u); break; } }
    }
    nloc = mine > 0u ? mine : 1u; nx = cnt > 0u ? cnt : 1u;
}

__device__ __forceinline__ void xcd_barrier(const XcdBarrier& b) {
    asm volatile("s_waitcnt vmcnt(0)" ::: "memory");
    __syncthreads();
    if (threadIdx.x == 0) {
        unsigned* bar = b.bar; unsigned xq = b.x; asm volatile("" : "+s"(bar), "+s"(xq));
        __builtin_amdgcn_s_waitcnt(0);
        unsigned nloc = b.st[0], nx = b.st[1];
        if (nloc == 0u) { xcd_barrier_complete(bar, xq, nloc, nx); b.st[0] = nloc; b.st[1] = nx; }
        const unsigned old = xb_add(&bar[XB_XSUB(xq)], 1u);
        const unsigned gen = old / nloc;
        if (old + 1u == (gen + 1u) * nloc) {
            __builtin_amdgcn_fence(__ATOMIC_RELEASE, "agent");
            asm volatile("s_waitcnt vmcnt(0)" ::: "memory");
            const unsigned og = xb_add(&bar[XB_TOP], 1u);
            const unsigned tg = og / nx;
            if (og + 1u == (tg + 1u) * nx) xb_add(&bar[XB_TOPGEN], 1u);
            else XB_SPIN(xb_ld(&bar[XB_TOPGEN]) == tg, bar);
            __builtin_amdgcn_fence(__ATOMIC_ACQUIRE, "agent");
            xb_add(&bar[XB_XGEN(xq)], 1u);
            asm volatile("s_waitcnt vmcnt(0)" ::: "memory");
        } else {
            XB_SPIN(xb_ld(&bar[XB_XGEN(xq)]) == gen, bar);
            __builtin_amdgcn_fence(__ATOMIC_ACQUIRE, "agent");
            asm volatile("s_waitcnt vmcnt(0)" ::: "memory");
        }
    }
    __syncthreads();
}

struct Ptrs {
    const float *x, *ln_emb_g, *ln_emb_b, *w_in, *fox_f_bias, *fox_norm_g, *hlb, *hgrn_norm_g, *w_o, *ln_mix_g, *ln_mix_b, *w_up, *conv_w, *conv_b, *w_down, *ln_ffn_g, *ln_ffn_b;
    float* out; unsigned char* ws;
};

__device__ __forceinline__ void prologue_weights(const Ptrs& P, LAS unsigned char* lds, int gw, int NGW, int wave, int lane, int gtid, int nthr) {
    LAS float* scr = (LAS float*)(lds + wave * 16384);
    bf16* win = (bf16*)(P.ws + WS_WIN); bf16* wo = (bf16*)(P.ws + WS_WO); bf16* wup = (bf16*)(P.ws + WS_WUP); bf16* wdn = (bf16*)(P.ws + WS_WDN);
    constexpr int IT0 = 16 * 48, IT1 = 16 * 64, IT2 = 16 * 32, IT3 = 44 * 16 * 4, IT7 = 44 * 32;
    constexpr int PER_LAYER = IT0 + IT1 + IT2 + IT3 + IT7;
    for (int it = gw; it < 2 * PER_LAYER; it += NGW) {
        const int l = it / PER_LAYER; int r = it % PER_LAYER;
        const float* wi = P.w_in + (size_t)l * 1024 * INC; const float* wu = P.w_up + (size_t)l * 1024 * 2 * DFF;
        bf16* winl = win + (size_t)l * NPROJ * 1024; bf16* wupl = wup + (size_t)l * 2 * DFF * 1024;
        if (r < IT0) { p0_transpose_item(wi, INC, 1024, 1536, winl, 0, scr, r, lane); continue; } r -= IT0;
        if (r < IT1) { p0_transpose_item(wi + 1544, INC, 1024, 2048, winl, 1536, scr, r, lane); continue; } r -= IT1;
        if (r < IT2) { p0_transpose_item(P.w_o + (size_t)l * 1024 * 1024, 1024, 1024, 1024, wo + (size_t)l * 1024 * 1024, 0, scr, r, lane); continue; } r -= IT2;
        if (r < IT3) { const int sgm = r >> 6, ri = r & 63; p0_transpose_item(wu + ((sgm & 1) ? DFF : 0) + (sgm >> 1) * 128, 2 * DFF, 1024, 128, wupl, sgm * 128, scr, ri, lane); continue; } r -= IT3;
        p0_transpose_item(P.w_down + (size_t)l * DFF * 1024, 1024, DFF, 1024, wdn + (size_t)l * 1024 * DFF, 0, scr, r, lane);
    }
    float* wfa = (float*)(P.ws + WS_WFA);
    for (int i = gtid; i < 2 * 8 * 1024; i += nthr) { const int l = i >> 13, j = (i >> 10) & 7, k = i & 1023; wfa[i] = P.w_in[(size_t)l * 1024 * INC + (size_t)k * INC + 1536 + j]; }
}


template <int LN_NR, bool FA> __device__ __forceinline__ void ln_phase(const float* xsrc, const bf16* xsrcb, const bf16* add, float alpha, float* xdst, bf16* XN, const float* g, const float* bta, const float* wfa, int wfa_ld, const float* fbias, float* lfa,
                                         LAS float* wl, int gw, int NGW, int lane, int tid) {
    if (FA && wfa_ld == 0) { for (int i = tid; i < 8 * 1024 / 4; i += NWAVES * 64) ((LAS f32x4*)wl)[i] = ((const f32x4*)wfa)[i]; __syncthreads(); }
    else if (FA) {
        for (int k = tid; k < 1024; k += NWAVES * 64) { const f32x4 a = *(const f32x4*)(wfa + (size_t)k * wfa_ld), b = *(const f32x4*)(wfa + (size_t)k * wfa_ld + 4);
            wl[k] = a.x; wl[1024 + k] = a.y; wl[2048 + k] = a.z; wl[3072 + k] = a.w; wl[4096 + k] = b.x; wl[5120 + k] = b.y; wl[6144 + k] = b.z; wl[7168 + k] = b.w; }
        __syncthreads(); }
    f32x4 gv[4], bv[4];
#pragma unroll
    for (int j = 0; j < 4; ++j) { gv[j] = ((const f32x4*)g)[lane + 64 * j]; bv[j] = ((const f32x4*)bta)[lane + 64 * j]; }
    const float fb = (FA && lane < 8) ? fbias[lane] : 0.f;
#pragma nounroll
    for (int m0 = gw; m0 < M; m0 += LN_NR * NGW) {
        f32x4 v[LN_NR][4]; unsigned long long av[LN_NR][4];
#pragma unroll
        for (int r = 0; r < LN_NR; ++r) { const int m = m0 + r * NGW;
            if (xsrc) { const GAS f32x4* xr = (const GAS f32x4*)(xsrc + (size_t)m * D) + lane;
#pragma unroll
                for (int j = 0; j < 4; ++j) v[r][j] = xr[64 * j]; }
            else { const GAS unsigned long long* xr = (const GAS unsigned long long*)(xsrcb + (size_t)m * D) + lane;
#pragma unroll
                for (int j = 0; j < 4; ++j) { const unsigned long long a = xr[64 * j]; const unsigned lo = (unsigned)a, hi = (unsigned)(a >> 32);
                    v[r][j] = (f32x4){__uint_as_float(lo << 16), __uint_as_float(lo & 0xffff0000u), __uint_as_float(hi << 16), __uint_as_float(hi & 0xffff0000u)}; } }
            if (add) { const GAS unsigned long long* ar = (const GAS unsigned long long*)(add + (size_t)m * D) + lane;
#pragma unroll
                for (int j = 0; j < 4; ++j) av[r][j] = ar[64 * j]; } }
#pragma unroll
        for (int r = 0; r < LN_NR; ++r) { const int m = m0 + r * NGW; float s = 0.f;
            if (add) {
#pragma unroll
                for (int j = 0; j < 4; ++j) { const unsigned lo = (unsigned)av[r][j], hi = (unsigned)(av[r][j] >> 32);
                    v[r][j] = v[r][j] * alpha + (f32x4){__uint_as_float(lo << 16), __uint_as_float(lo & 0xffff0000u), __uint_as_float(hi << 16), __uint_as_float(hi & 0xffff0000u)}; } }
#pragma unroll
            for (int j = 0; j < 4; ++j) s += (v[r][j].x + v[r][j].y) + (v[r][j].z + v[r][j].w);
            const float mean = wave_sum(s) * (1.f / D); float s2 = 0.f;
#pragma unroll
            for (int j = 0; j < 4; ++j) { v[r][j] = v[r][j] - mean; s2 += (v[r][j].x * v[r][j].x + v[r][j].y * v[r][j].y) + (v[r][j].z * v[r][j].z + v[r][j].w * v[r][j].w); }
            const float rstd = 1.f / sqrtf(wave_sum(s2) * (1.f / D) + LN_EPS);
#pragma unroll
            for (int j = 0; j < 4; ++j) v[r][j] = (v[r][j] * rstd) * gv[j] + bv[j];
            if (XN) { GAS unsigned long long* o8 = (GAS unsigned long long*)(XN + (size_t)m * D) + lane;
#pragma unroll
                for (int j = 0; j < 4; ++j) o8[64 * j] = (unsigned long long)pk2(v[r][j].x, v[r][j].y) | ((unsigned long long)pk2(v[r][j].z, v[r][j].w) << 32); }
            if (xdst) { GAS f32x4* o = (GAS f32x4*)(xdst + (size_t)m * D) + lane;
#pragma unroll
                for (int j = 0; j < 4; ++j) o[64 * j] = v[r][j]; }
            if (FA) { float mine = 0.f;
#pragma unroll
                for (int h = 0; h < 8; ++h) { float d = 0.f;
#pragma unroll
                    for (int j = 0; j < 4; ++j) { const f32x4 w = ((const LAS f32x4*)wl)[h * 256 + lane + 64 * j]; d += (v[r][j].x * w.x + v[r][j].y * w.y) + (v[r][j].z * w.z + v[r][j].w * w.w); }
                    d = wave_sum(d); if (lane == h) mine = d; }
                if (lane < 8) { const float z = mine + fb; lfa[(size_t)m * 8 + lane] = fminf(z, 0.f) - __logf(1.0f + __expf(-fabsf(z))); } } }
    }
}

__device__ __forceinline__ void cumsum_phase(const float* lfa, float* c2, int b, LAS float* scr, int tid, int wave, int lane) {
    const f32x4* src = (const f32x4*)(lfa + ((size_t)b * SEQ + 16 * tid) * 8);
    float a[16][8];
#pragma unroll
    for (int i = 0; i < 16; ++i) { const f32x4 p = src[2 * i], q = src[2 * i + 1]; a[i][0] = p.x; a[i][1] = p.y; a[i][2] = p.z; a[i][3] = p.w; a[i][4] = q.x; a[i][5] = q.y; a[i][6] = q.z; a[i][7] = q.w; }
#pragma unroll
    for (int i = 1; i < 16; ++i)
#pragma unroll
        for (int h = 0; h < 8; ++h) a[i][h] += a[i - 1][h];
    float off[8];
#pragma unroll
    for (int h = 0; h < 8; ++h) { float t = a[15][h], inc = t;
#pragma unroll
        for (int o = 1; o < 64; o <<= 1) { const float u = __shfl_up(inc, o); if (lane >= o) inc += u; }
        off[h] = inc - t; if (lane == 63) scr[wave * 8 + h] = inc; }
    __syncthreads();
#pragma unroll
    for (int h = 0; h < 8; ++h) { float p = 0.f; for (int w = 0; w < wave; ++w) p += scr[w * 8 + h]; off[h] += p; }
#pragma unroll
    for (int h = 0; h < 8; ++h) { f32x4* dst = (f32x4*)(c2 + ((size_t)(b * 8 + h)) * SEQ + 16 * tid);
#pragma unroll
        for (int i4 = 0; i4 < 4; ++i4) dst[i4] = (f32x4){(a[4 * i4][h] + off[h]) * LOG2E, (a[4 * i4 + 1][h] + off[h]) * LOG2E, (a[4 * i4 + 2][h] + off[h]) * LOG2E, (a[4 * i4 + 3][h] + off[h]) * LOG2E}; }
    __syncthreads();
}

#ifndef THR_EXTRA
#define THR_EXTRA 0.0f
#endif
__device__ __forceinline__ void fox_norms(const bf16* QA, const bf16* KA, unsigned* kmax, unsigned* qmax, int gw, int lane) {
    if (gw >= M / 16) return;
    float kq = 0.f, qq = 0.f;
#pragma unroll 4
    for (int i = 0; i < 16; ++i) { const size_t off = ((size_t)(16 * gw + i)) * 512 + lane * 8;
        const v4u kv = *(const v4u*)(KA + off), qv = *(const v4u*)(QA + off); float sk = 0.f, sq = 0.f;
#pragma unroll
        for (int j = 0; j < 4; ++j) { const float k0 = __uint_as_float(kv[j] << 16), k1 = __uint_as_float(kv[j] & 0xffff0000u), q0 = __uint_as_float(qv[j] << 16), q1 = __uint_as_float(qv[j] & 0xffff0000u); sk += k0 * k0 + k1 * k1; sq += q0 * q0 + q1 * q1; }
        sk += __shfl_xor(sk, 1); sk += __shfl_xor(sk, 2); sk += __shfl_xor(sk, 4); sq += __shfl_xor(sq, 1); sq += __shfl_xor(sq, 2); sq += __shfl_xor(sq, 4);
        kq = fmaxf(kq, sk); qq = fmaxf(qq, sq); }
    if ((lane & 7) == 0) { const int row0 = 16 * gw, b = row0 / SEQ, qb = (row0 % SEQ) / 256, h = lane >> 3;
        atomicMax(kmax + b * 8 + h, __float_as_uint(kq)); atomicMax(qmax + (b * 8 + h) * 32 + qb, __float_as_uint(qq)); }
}
__device__ __forceinline__ void fox_tstart(const float* c2, const unsigned* kmax, const unsigned* qmax, unsigned* tsout, int u) {
    if (u >= 1024) return;
    const int bh = u & 31, qb = u >> 5, q0 = qb * 256;
    const float kn = sqrtf(__uint_as_float(kmax[bh])) * 1.01f, qn = sqrtf(__uint_as_float(qmax[bh * 32 + qb])) * 1.01f;
    const float* cb = c2 + (size_t)bh * SEQ; const float thr = -152.0f - qn * kn - THR_EXTRA;
    const float cq0 = cb[q0];
    int T = q0 / 64 - 1;
    while (T >= 0 && !(cq0 - cb[64 * T + 63] < thr)) --T;
    int ts = (T + 1) & ~1; const int NTabs = q0 / 64 + 4; if (ts > NTabs - 4) ts = NTabs - 4;
    tsout[u] = (unsigned)ts;
}

__device__ __forceinline__ void gate_fixup(const float* halo, const float* cw, const float* cb, bf16* G, int gtid, int nthr) {
    const int ngrp = DFF / 4, nitems = (M / 64) * ngrp;
    for (int item = gtid; item < nitems; item += nthr) {
        const int blk = item / ngrp, ch = (item % ngrp) * 4;
        const float* h0 = halo + (size_t)blk * 4 * 5632 + ch;
        const f32x4 a0 = *(const f32x4*)(h0), u0 = *(const f32x4*)(h0 + 2816), a1 = *(const f32x4*)(h0 + 5632), u1 = *(const f32x4*)(h0 + 5632 + 2816);
        f32x4 pa62 = (f32x4){0.f, 0.f, 0.f, 0.f}, pa63 = pa62, pu62 = pa62, pu63 = pa62;
        if ((blk & 127) != 0) { const float* hp = h0 - 2 * 5632; pa62 = *(const f32x4*)(hp); pu62 = *(const f32x4*)(hp + 2816); pa63 = *(const f32x4*)(hp + 5632); pu63 = *(const f32x4*)(hp + 5632 + 2816); }
        const f32x4 wa0 = *(const f32x4*)(cw + ch), wa1 = *(const f32x4*)(cw + 5632 + ch), wa2 = *(const f32x4*)(cw + 2 * 5632 + ch), ba = *(const f32x4*)(cb + ch);
        const f32x4 wu0 = *(const f32x4*)(cw + 2816 + ch), wu1 = *(const f32x4*)(cw + 5632 + 2816 + ch), wu2 = *(const f32x4*)(cw + 2 * 5632 + 2816 + ch), bu = *(const f32x4*)(cb + 2816 + ch);
        const f32x4 ya0 = wa0 * pa62 + wa1 * pa63 + wa2 * a0 + ba, yu0 = wu0 * pu62 + wu1 * pu63 + wu2 * u0 + bu;
        const f32x4 ya1 = wa0 * pa63 + wa1 * a0 + wa2 * a1 + ba, yu1 = wu0 * pu63 + wu1 * u0 + wu2 * u1 + bu;
        const pg8::f32x2 g00 = pg8::gelu_pk((pg8::f32x2){ya0[0], ya0[1]}), g01 = pg8::gelu_pk((pg8::f32x2){ya0[2], ya0[3]}), g10 = pg8::gelu_pk((pg8::f32x2){ya1[0], ya1[1]}), g11 = pg8::gelu_pk((pg8::f32x2){ya1[2], ya1[3]});
        typedef unsigned u32x2f __attribute__((ext_vector_type(2)));
        *(u32x2f*)(G + (size_t)(blk * 64) * DFF + ch) = (u32x2f){pk2(g00.x * yu0[0], g00.y * yu0[1]), pk2(g01.x * yu0[2], g01.y * yu0[3])};
        *(u32x2f*)(G + (size_t)(blk * 64 + 1) * DFF + ch) = (u32x2f){pk2(g10.x * yu1[0], g10.y * yu1[1]), pk2(g11.x * yu1[2], g11.y * yu1[3])};
    }
}

namespace hg {
constexpr int QT_P = 272, KH_P = 144;
constexpr int O_QT = 0, O_KT = O_QT + 64 * QT_P, O_KH = O_KT + 64 * QT_P, O_VT = O_KH + 128 * KH_P, O_PB = O_VT + 128 * KH_P, O_BT = O_PB + 64 * KH_P, O_RS = O_BT + 2048, O_END = O_RS + 4096;
static_assert(O_END <= RING_BYTES, "hgrn lds");
constexpr int NITEMS = 16 * 128;
#define MFMA16(a, b, c) __builtin_amdgcn_mfma_f32_16x16x32_bf16((a), (b), (c), 0, 0, 0)
typedef float f32x2_t __attribute__((ext_vector_type(2))); typedef __bf16 bf16x2_t __attribute__((ext_vector_type(2)));
__device__ __forceinline__ unsigned cvtpk(float lo, float hi) { f32x2_t v = {lo, hi}; bf16x2_t b = __builtin_convertvector(v, bf16x2_t); return __builtin_bit_cast(unsigned, b); }
__device__ __forceinline__ void hgrn_prep(int first, int stride, bf16* QR, float* LF, const bf16* IR, const bf16* GR, bf16* U, bf16* QS, bf16* OI, float* DLg, LAS unsigned char* lds) {
    int tid_ = threadIdx.x; asm volatile("" : "+v"(tid_)); const int tid = tid_, lane = tid & 63, w = __builtin_amdgcn_readfirstlane(tid >> 6), n16 = lane & 15, g = lane >> 4;
    const int col = tid & 127, tq = tid >> 7;
    LAS unsigned char* QT = lds + O_QT; LAS unsigned char* KT = lds + O_KT; LAS unsigned char* KH = lds + O_KH; LAS unsigned char* VT = lds + O_VT; LAS unsigned char* PB = lds + O_PB;
    LAS float* BT = (LAS float*)(lds + O_BT);
    const int r32 = col & 31, qpos = (col & ~31) + ((r32 < 16) ? (8 * (r32 >> 2) + (r32 & 3)) : (8 * ((r32 - 16) >> 2) + 4 + (r32 & 3)));
    if (first >= NITEMS) return;
    float lf[16]; unsigned short qv[16], vv[16];
    { const int bh = first >> 7, c = first & 127; const size_t base = ((size_t)(bh >> 2) * SEQ + 64 * c + 16 * tq) * 512 + (bh & 3) * 128 + col;
#pragma unroll
      for (int i = 0; i < 16; ++i) { lf[i] = LF[base + (size_t)i * 512]; qv[i] = QR[base + (size_t)i * 512]; vv[i] = IR[base + (size_t)i * 512]; } }
    for (int it = first; it < NITEMS; it += stride) {
        float bl[16]; bl[0] = lf[0];
#pragma unroll
        for (int i = 1; i < 16; ++i) bl[i] = bl[i - 1] + lf[i];
        BT[tq * 128 + col] = bl[15];
        __syncthreads();
        const float t0 = BT[col], t1 = BT[128 + col], t2 = BT[256 + col], t3 = BT[384 + col];
        const float off = (tq == 0) ? 0.f : (tq == 1) ? t0 : (tq == 2) ? (t0 + t1) : (t0 + t1 + t2);
        const float bref = t0 + t1, blast = (t0 + t1) + (t2 + t3);
        unsigned khp[8], vtp[8];
        bf16* qsrow = QS + (size_t)it * 8192 + (size_t)(16 * tq) * 128 + qpos;
#pragma unroll
        for (int i = 0; i < 16; i += 2) {
            const float bb0 = bl[i] + off, bb1 = bl[i + 1] + off, k0 = 1.0f - __expf(lf[i]), k1 = 1.0f - __expf(lf[i + 1]), q0 = bf2f(qv[i]), q1 = bf2f(qv[i + 1]);
            const unsigned qs = cvtpk(q0 * __expf(fminf(bb0 - bref, 80.f)), q1 * __expf(fminf(bb1 - bref, 80.f)));
            const unsigned ks = cvtpk(k0 * __expf(fminf(bref - bb0, 80.f)), k1 * __expf(fminf(bref - bb1, 80.f)));
            const unsigned qa = cvtpk(q0 * __expf(bb0), q1 * __expf(bb1));
            khp[i >> 1] = cvtpk(k0 * __expf(blast - bb0), k1 * __expf(blast - bb1));
            vtp[i >> 1] = (unsigned)vv[i] | ((unsigned)vv[i + 1] << 16);
            *(LAS unsigned short*)(QT + (16 * tq + i) * QT_P + col * 2) = (unsigned short)qs; *(LAS unsigned short*)(QT + (16 * tq + i + 1) * QT_P + col * 2) = (unsigned short)(qs >> 16);
            *(LAS unsigned short*)(KT + (16 * tq + i) * QT_P + col * 2) = (unsigned short)ks; *(LAS unsigned short*)(KT + (16 * tq + i + 1) * QT_P + col * 2) = (unsigned short)(ks >> 16);
            qsrow[(size_t)i * 128] = (unsigned short)qa; qsrow[(size_t)(i + 1) * 128] = (unsigned short)(qa >> 16);
        }
        *(LAS v4u*)(KH + col * KH_P + 32 * tq) = (v4u){khp[0], khp[1], khp[2], khp[3]}; *(LAS v4u*)(KH + col * KH_P + 32 * tq + 16) = (v4u){khp[4], khp[5], khp[6], khp[7]};
        *(LAS v4u*)(VT + col * KH_P + 32 * tq) = (v4u){vtp[0], vtp[1], vtp[2], vtp[3]}; *(LAS v4u*)(VT + col * KH_P + 32 * tq + 16) = (v4u){vtp[4], vtp[5], vtp[6], vtp[7]};
        if (tq == 0) DLg[(size_t)it * 128 + col] = __expf(blast);
        if (it + stride < NITEMS) { const int nx = it + stride, bh = nx >> 7, c = nx & 127; const size_t base = ((size_t)(bh >> 2) * SEQ + 64 * c + 16 * tq) * 512 + (bh & 3) * 128 + col;
#pragma unroll
            for (int i = 0; i < 16; ++i) { lf[i] = LF[base + (size_t)i * 512]; qv[i] = QR[base + (size_t)i * 512]; vv[i] = IR[base + (size_t)i * 512]; } }
        __syncthreads();
        { const int tb = w >> 1;
#pragma unroll
          for (int jj = 0; jj < 2; ++jj) { const int sb = 2 * (w & 1) + jj; f32x4 p = (f32x4){0.f, 0.f, 0.f, 0.f};
              if (sb <= tb) {
#pragma unroll
                  for (int kk = 0; kk < 4; ++kk) { const bf16x8 A = *(const LAS bf16x8*)(QT + (16 * tb + n16) * QT_P + (32 * kk + 8 * g) * 2), B = *(const LAS bf16x8*)(KT + (16 * sb + n16) * QT_P + (32 * kk + 8 * g) * 2); p = MFMA16(A, B, p); }
                  if (sb == tb) {
#pragma unroll
                      for (int i = 0; i < 4; ++i) if (n16 > 4 * g + i) p[i] = 0.f; } }
#pragma unroll
              for (int i = 0; i < 4; ++i) *(LAS unsigned short*)(PB + (16 * tb + 4 * g + i) * KH_P + (16 * sb + n16) * 2) = (unsigned short)f2bf(p[i]); } }
        __syncthreads();
        bf16x8 vB[2];
#pragma unroll
        for (int kk = 0; kk < 2; ++kk) vB[kk] = *(const LAS bf16x8*)(VT + (16 * w + n16) * KH_P + (32 * kk + 8 * g) * 2);
#pragma unroll
        for (int mt = 0; mt < 4; ++mt) { f32x4 acc = (f32x4){0.f, 0.f, 0.f, 0.f};
#pragma unroll
            for (int kk = 0; kk < 2; ++kk) { const bf16x8 A = *(const LAS bf16x8*)(PB + (16 * mt + n16) * KH_P + (32 * kk + 8 * g) * 2); acc = MFMA16(A, vB[kk], acc); }
            *(unsigned long long*)(OI + (((size_t)it * 8 + w) * 4 + mt) * 256 + lane * 4) = (unsigned long long)cvtpk(acc[0], acc[1]) | ((unsigned long long)cvtpk(acc[2], acc[3]) << 32); }
#pragma unroll
        for (int j = 0; j < 8; ++j) { f32x4 acc = (f32x4){0.f, 0.f, 0.f, 0.f};
#pragma unroll
            for (int kk = 0; kk < 2; ++kk) { const bf16x8 A = *(const LAS bf16x8*)(KH + (16 * j + n16) * KH_P + (32 * kk + 8 * g) * 2); acc = MFMA16(A, vB[kk], acc); }
            { const int bh_ = it >> 7; const size_t T0_ = (size_t)(bh_ >> 2) * SEQ + 64 * (it & 127);
              *(unsigned long long*)((bf16*)(LF + (T0_ + 8 * w + j) * 512 + (bh_ & 3) * 128) + lane * 4) = (unsigned long long)cvtpk(acc[0], acc[1]) | ((unsigned long long)cvtpk(acc[2], acc[3]) << 32); } }
    }
    __syncthreads();
}
typedef unsigned u32x2 __attribute__((ext_vector_type(2)));
__device__ __forceinline__ f32x4 up4(u32x2 v) { return (f32x4){__uint_as_float(v.x << 16), __uint_as_float(v.x & 0xffff0000u), __uint_as_float(v.y << 16), __uint_as_float(v.y & 0xffff0000u)}; }
__device__ __forceinline__ void hgrn_scan(int task, float* LF, const float* DLg, int lane) {
    if (task >= 16 * 64) return;
    const int bh = task >> 6, wj = task & 63, g = lane >> 4;
    bf16* up = (bf16*)(LF + ((size_t)(bh >> 2) * SEQ + wj) * 512 + (bh & 3) * 128) + lane * 4;
    const float* dlp = DLg + (size_t)bh * 128 * 128 + 16 * (wj & 7) + 4 * g;
    f32x4 S = (f32x4){0.f, 0.f, 0.f, 0.f};
    u32x2 ub[8]; f32x4 db[8];
#pragma unroll
    for (int k = 0; k < 8; ++k) { ub[k] = *(const u32x2*)(up + (size_t)k * 65536); db[k] = *(const f32x4*)(dlp + (size_t)k * 128); }
#pragma nounroll
    for (int c0 = 0; c0 < SEQ / 64; c0 += 8) {
        u32x2 un[8]; f32x4 dn[8];
        if (c0 + 8 < SEQ / 64) {
#pragma unroll
            for (int k = 0; k < 8; ++k) { un[k] = *(const u32x2*)(up + (size_t)(c0 + 8 + k) * 65536); dn[k] = *(const f32x4*)(dlp + (size_t)(c0 + 8 + k) * 128); } }
        else {
#pragma unroll
            for (int k = 0; k < 8; ++k) { un[k] = (u32x2){0u, 0u}; dn[k] = (f32x4){0.f, 0.f, 0.f, 0.f}; } }
#pragma unroll
        for (int k = 0; k < 8; ++k) { *(u32x2*)(up + (size_t)(c0 + k) * 65536) = (u32x2){cvtpk(S[0], S[1]), cvtpk(S[2], S[3])}; S = S * db[k] + up4(ub[k]); }
#pragma unroll
        for (int k = 0; k < 8; ++k) { ub[k] = un[k]; db[k] = dn[k]; }
    }
}
__device__ __forceinline__ void hgrn_out_phase(int first, int stride, const float* LF, const bf16* QS, const bf16* OI, const bf16* GQ, const float* gnorm, bf16* MIX, LAS unsigned char* lds) {
    int tid_ = threadIdx.x; asm volatile("" : "+v"(tid_)); const int tid = tid_, lane = tid & 63, w = __builtin_amdgcn_readfirstlane(tid >> 6), n16 = lane & 15, g = lane >> 4;
    if (first >= NITEMS) return;
    LAS float* RS = (LAS float*)(lds + O_RS);
    bf16x8 qf[4][4]; u32x2 oif[4], sp[8]; unsigned short gq[16];
#define HO_LOAD(IT) do { const int bh_ = (IT) >> 7, hc_ = (bh_ & 3) * 128; const size_t T0_ = (size_t)(bh_ >> 2) * SEQ + 64 * ((IT) & 127); \
      _Pragma("unroll") for (int mt = 0; mt < 4; ++mt) { _Pragma("unroll") for (int kk = 0; kk < 4; ++kk) qf[mt][kk] = *(const bf16x8*)(QS + (size_t)(IT) * 8192 + (16 * mt + n16) * 128 + 32 * kk + 8 * g); \
          oif[mt] = *(const u32x2*)(OI + (((size_t)(IT) * 8 + w) * 4 + mt) * 256 + lane * 4); \
          _Pragma("unroll") for (int i = 0; i < 4; ++i) gq[4 * mt + i] = GQ[(T0_ + 16 * mt + 4 * g + i) * 512 + hc_ + 16 * w + n16]; } \
      _Pragma("unroll") for (int j = 0; j < 8; ++j) sp[j] = *(const u32x2*)((const bf16*)(LF + (T0_ + 8 * w + j) * 512 + hc_) + lane * 4); } while (0)
    HO_LOAD(first);
    int par = 0;
    for (int it = first; it < NITEMS; it += stride, par ^= 1) {
        const int bh = it >> 7, hc = (bh & 3) * 128; const size_t T0 = (size_t)(bh >> 2) * SEQ + 64 * (it & 127);
        const float gn = gnorm[hc + 16 * w + n16];
        f32x4 o[4], gf[4];
#pragma unroll
        for (int mt = 0; mt < 4; ++mt) { f32x4 acc = up4(oif[mt]); gf[mt] = (f32x4){bf2f(gq[4 * mt]), bf2f(gq[4 * mt + 1]), bf2f(gq[4 * mt + 2]), bf2f(gq[4 * mt + 3])};
#pragma unroll
            for (int kk = 0; kk < 4; ++kk) acc = MFMA16(qf[mt][kk], __builtin_bit_cast(bf16x8, (v4u){sp[2 * kk].x, sp[2 * kk].y, sp[2 * kk + 1].x, sp[2 * kk + 1].y}), acc);
            o[mt] = acc; }
        asm volatile("" ::: "memory");
        if (it + stride < NITEMS) HO_LOAD(it + stride);
        LAS float* RSc = RS + par * 512;
#pragma unroll
        for (int mt = 0; mt < 4; ++mt) { f32x4 q = o[mt] * o[mt];
#pragma unroll
            for (int sh = 1; sh < 16; sh <<= 1) { q[0] += __shfl_xor(q[0], sh); q[1] += __shfl_xor(q[1], sh); q[2] += __shfl_xor(q[2], sh); q[3] += __shfl_xor(q[3], sh); }
            if (n16 == 0) *(LAS f32x4*)(RSc + w * 64 + 16 * mt + 4 * g) = q; }
        asm volatile("s_waitcnt lgkmcnt(0)\n\ts_barrier" ::: "memory");
#pragma unroll
        for (int mt = 0; mt < 4; ++mt) { f32x4 tot = (f32x4){0.f, 0.f, 0.f, 0.f};
#pragma unroll
            for (int ww = 0; ww < 8; ++ww) tot += *(const LAS f32x4*)(RSc + ww * 64 + 16 * mt + 4 * g);
#pragma unroll
            for (int i = 0; i < 4; ++i) { const float r = __builtin_amdgcn_rsqf(tot[i] * (1.f / 128.f) + RMS_EPS); const float val = o[mt][i] * r * gn * gf[mt][i];
                MIX[(T0 + 16 * mt + 4 * g + i) * 1024 + 512 + hc + 16 * w + n16] = (unsigned short)f2bf(val); } }
    }
    __syncthreads();
#undef HO_LOAD
}
}
namespace cg = cooperative_groups;
#ifndef PHM
#define PHM 0xffff
#endif
#define PH(b) if constexpr ((PHM >> (b)) & 1)
#ifndef DUPP
#define DUPP 0
#endif
#define GSYNC() do { xcd_barrier(xbar); if (DUPP == 9) xcd_barrier(xbar); } while (0)
#ifndef PG8_SP2_
#define PG8_SP2_ true
#endif
#ifndef PG8_ALIGN_UP
#define PG8_ALIGN_UP true
#endif
#ifndef PG8_ALIGN_
#define PG8_ALIGN_ true
#endif
#define REP(k) for (int rep_ = 0; rep_ < ((DUPP == (k)) ? 2 : 1); ++rep_)
struct Args { Ptrs p; };
#define FRESH_IDS() int tid = threadIdx.x; asm volatile("" : "+v"(tid)); const int lane = tid & 63, wave = __builtin_amdgcn_readfirstlane(tid >> 6); const int gw = bx * NWAVES + wave, gtid = bx * (NWAVES * 64) + tid; (void)lane; (void)gw; (void)gtid;
__global__ void __launch_bounds__(NWAVES * 64, 2) fwd_megakernel(Args args) {
    extern __shared__ __attribute__((aligned(16))) unsigned char lds_raw[];
    cg::grid_group grid = cg::this_grid();
    const Ptrs& P = args.p;
    LAS unsigned char* lds = (LAS unsigned char*)lds_raw;
    volatile LAS int* MISC = (volatile LAS int*)(lds + MISC_OFF);
    const int G = gridDim.x, bx = blockIdx.x;
    const int NGW = G * NWAVES, nthr = G * NWAVES * 64;
    unsigned char* ws = P.ws;
    unsigned* ctl = (unsigned*)(ws + WS_CTL);
    if (threadIdx.x < 32) ((LAS unsigned*)(lds + MISC_OFF))[threadIdx.x] = 0u;
    __syncthreads();
    const XcdBarrier xbar = xcd_barrier_post(ctl + CW_BAR, (volatile LAS unsigned*)(lds + MISC_OFF) + 8);
    float* c2 = (float*)(ws + WS_C2); float* lfa = (float*)(ws + WS_LFA); const float* wfa = (const float*)(ws + WS_WFA);
    bf16* XN = (bf16*)(ws + WS_XN); bf16* slot0 = (bf16*)(ws + WS_SLOT0); bf16* MIX = (bf16*)(ws + WS_MIX); bf16* GB = (bf16*)(ws + WS_G); bf16* SUB = (bf16*)(ws + WS_SUB);

    REP(5) PH(0) { FRESH_IDS(); prologue_weights(P, lds, gw, NGW, wave, lane, gtid, nthr); }
    __syncthreads();
    PH(1) { FRESH_IDS(); ln_phase<2, true>(P.x, nullptr, nullptr, 1.f, nullptr, XN, P.ln_emb_g, P.ln_emb_b, P.w_in + 1536, INC, P.fox_f_bias, lfa, (LAS float*)lds, gw, NGW, lane, tid); }
    grid.sync();

#pragma nounroll
    for (int l = 0; l < 2; ++l) {
        PH(2) if (bx < BATCH) { FRESH_IDS(); cumsum_phase(lfa, c2, bx, (LAS float*)lds, tid, wave, lane); }
        REP(1) { if (rep_) GSYNC();
        PH(3) { pg8::Gemm g{XN, (const bf16*)(ws + WS_WIN) + (size_t)l * NPROJ * 1024, M, NPROJ, D}; pg8::StaticOrder S; S.init(M, NPROJ, G, bx);
          pg8::EpiProj E{slot0, P.hlb, l, attn_body::C2};
          pg8::gemm_phase<pg8::EpiProj, pg8::StaticOrder, PG8_ALIGN_, PG8_SP2_>(lds, g, S, E); } }
        GSYNC();
        PH(5) { FRESH_IDS(); fox_norms(slot0, slot0 + pg8::SLOT_ELEMS, ctl + CW_KMAX + 32 * l, ctl + CW_QMAX + 1024 * l, gw, lane); }
        REP(4) { if (rep_) GSYNC();
        PH(4) hg::hgrn_prep(bx, G, slot0 + 3 * pg8::SLOT_ELEMS, (float*)(slot0 + 4 * pg8::SLOT_ELEMS), slot0 + 6 * pg8::SLOT_ELEMS, slot0 + 7 * pg8::SLOT_ELEMS, nullptr, (bf16*)(ws + WS_HQS), (bf16*)(ws + WS_HOI), (float*)(ws + WS_HDL), lds); }
        GSYNC();
        PH(4) { FRESH_IDS(); hg::hgrn_scan(gw, (float*)(slot0 + 4 * pg8::SLOT_ELEMS), (const float*)(ws + WS_HDL), lane);
                if (gw >= 1024) fox_tstart(c2, ctl + CW_KMAX + 32 * l, ctl + CW_QMAX + 1024 * l, ctl + CW_TS + 1024 * l, gtid - 1024 * 64); }
        GSYNC();
#ifndef DUP_MIX
#define DUP_MIX 0
#endif
        for (int rep = 0; rep < (DUP_MIX ? 2 : 1); ++rep) { unsigned* ctr = ctl + 64 * (l + 2 * rep); const bool do_h = (rep == 0) || (DUP_MIX & 1), do_a = (rep == 0) || (DUP_MIX & 2);
          const bf16* QA = slot0; const bf16* KA = slot0 + pg8::SLOT_ELEMS; const bf16* VA = slot0 + 2 * pg8::SLOT_ELEMS;
          int nxt_it = 0, nxt_ts = 0; if (threadIdx.x == 0) { nxt_it = (int)atomicAdd(ctr, 1u); nxt_ts = (nxt_it < 1024) ? (int)ctl[CW_TS + 1024 * l + (nxt_it & 31) + 32 * (31 - (nxt_it >> 5))] : 0; }
          for (;;) {
              FRESH_IDS();
              if (tid == 0) { MISC[16] = nxt_it; MISC[17] = nxt_ts; }
              __syncthreads();
              const int it = MISC[16], its = MISC[17];
              __syncthreads();
              if (it >= 1024) break;
              if (tid == 0) { nxt_it = (int)atomicAdd(ctr, 1u); nxt_ts = (nxt_it < 1024) ? (int)ctl[CW_TS + 1024 * l + (nxt_it & 31) + 32 * (31 - (nxt_it >> 5))] : 0; }
              PH(5) if (do_a) { const int idx = it, qb = 31 - (idx >> 5), bh = idx & 31;
                     attn_body::attn_unit<60>(bh >> 3, bh & 7, qb, (const attn_body::bf16*)QA, (const attn_body::bf16*)KA, (const attn_body::bf16*)VA, (attn_body::bf16*)MIX, c2, P.fox_norm_g + l * 512, (int)__builtin_amdgcn_readfirstlane(its), (char*)lds_raw); }
          }
          PH(4) if (do_h) hg::hgrn_out_phase(bx, G, (const float*)(slot0 + 4 * pg8::SLOT_ELEMS), (const bf16*)(ws + WS_HQS), (const bf16*)(ws + WS_HOI), slot0 + 7 * pg8::SLOT_ELEMS, P.hgrn_norm_g + l * 512, MIX, lds);
          if (DUP_MIX && rep == 0) GSYNC(); }
        GSYNC();
        REP(6) { if (rep_) GSYNC();
        PH(6) { pg8::Gemm g{MIX, (const bf16*)(ws + WS_WO) + (size_t)l * 1024 * 1024, M, D, D}; pg8::StaticOrder S; S.init(M, D, G, bx);
          pg8::EpiBf16<0> E{SUB, D, nullptr, 0, 0, 1.f};
          pg8::gemm_phase<pg8::EpiBf16<0>, pg8::StaticOrder, PG8_ALIGN_, PG8_SP2_>(lds, g, S, E); } }
        GSYNC();
        REP(3) { if (rep_) GSYNC();
        PH(1) { FRESH_IDS(); ln_phase<4, false>(nullptr, XN, SUB, DN_ALPHA, nullptr, (DUPP == 3 && rep_ == 0) ? (bf16*)(ws + 200 * MiB) : XN, P.ln_mix_g + l * D, P.ln_mix_b + l * D, nullptr, 0, nullptr, nullptr, (LAS float*)lds, gw, NGW, lane, tid); } }
        GSYNC();
        REP(2) { if (rep_) GSYNC();
        PH(7) { pg8::Gemm g{XN, (const bf16*)(ws + WS_WUP) + (size_t)l * 2 * DFF * 1024, M, 2 * DFF, D}; pg8::StaticOrder S; S.init(M, 2 * DFF, G, bx);
          pg8::EpiGate E{GB, (float*)(ws + WS_HALO), P.conv_w + (size_t)l * 3 * 2 * DFF, P.conv_b + (size_t)l * 2 * DFF};
          pg8::gemm_phase<pg8::EpiGate, pg8::StaticOrder, PG8_ALIGN_UP, PG8_SP2_>(lds, g, S, E); } }
        GSYNC();
        REP(8) { if (rep_) GSYNC();
        PH(8) { FRESH_IDS(); gate_fixup((const float*)(ws + WS_HALO), P.conv_w + (size_t)l * 3 * 2 * DFF, P.conv_b + (size_t)l * 2 * DFF, GB, gtid, nthr); } }
        GSYNC();
        REP(7) { if (rep_) GSYNC();
        PH(6) { pg8::Gemm g{GB, (const bf16*)(ws + WS_WDN) + (size_t)l * 1024 * DFF, M, D, DFF}; pg8::StaticOrder S; S.init(M, D, G, bx);
          pg8::EpiBf16<0> E{SUB, D, nullptr, 0, 0, 1.f};
          pg8::gemm_phase<pg8::EpiBf16<0>, pg8::StaticOrder, PG8_ALIGN_, PG8_SP2_>(lds, g, S, E); } }
        GSYNC();
        if (l == 0) { PH(1) { FRESH_IDS(); ln_phase<2, true>(nullptr, XN, SUB, DN_ALPHA, nullptr, XN, P.ln_ffn_g, P.ln_ffn_b, wfa + 8 * 1024, 0, P.fox_f_bias + 8, lfa, (LAS float*)lds, gw, NGW, lane, tid); } GSYNC(); }
        else PH(1) { FRESH_IDS(); ln_phase<4, false>(nullptr, XN, SUB, DN_ALPHA, P.out, nullptr, P.ln_ffn_g + D, P.ln_ffn_b + D, nullptr, 0, nullptr, nullptr, (LAS float*)lds, gw, NGW, lane, tid); }
    }
}

extern "C" void kernel_launch(void* const* d_in, const int* in_sizes, int n_in, void* d_out, int out_size, void* d_ws, size_t ws_size, hipStream_t stream) {
    static int grid = 0;
    if (grid == 0) {
        if (n_in != 17 || in_sizes[0] != M * D || out_size != M * D || ws_size < WS_END) { fprintf(stderr, "kernel_launch: unexpected shapes: n_in %d in0 %d out %d ws %zu\n", n_in, n_in > 0 ? in_sizes[0] : -1, out_size, ws_size); grid = -1; return; }
        int dev = 0, cus = 0, per_cu = 0;
        if (hipGetDevice(&dev) != hipSuccess || hipDeviceGetAttribute(&cus, hipDeviceAttributeMultiprocessorCount, dev) != hipSuccess) { fprintf(stderr, "kernel_launch: device query failed\n"); grid = -1; return; }
        if (hipFuncSetAttribute((const void*)fwd_megakernel, hipFuncAttributeMaxDynamicSharedMemorySize, LDS_BYTES) != hipSuccess) { fprintf(stderr, "kernel_launch: hipFuncSetAttribute failed\n"); grid = -1; return; }
        if (hipOccupancyMaxActiveBlocksPerMultiprocessor(&per_cu, (const void*)fwd_megakernel, NWAVES * 64, LDS_BYTES) != hipSuccess || per_cu < 1) { fprintf(stderr, "kernel_launch: occupancy query says %d blocks/CU\n", per_cu); per_cu = 1; }
        (void)hipGetLastError();
        if (cus < 256) { fprintf(stderr, "kernel_launch: this kernel's phase maps need 256 co-resident workgroups (one per CU); the device has %d CUs\n", cus); grid = -1; return; }
        grid = 256;
    }
    if (grid < 0) return;
    (void)hipMemsetAsync((char*)d_ws + WS_CTL, 0, CTL_ZERO_BYTES, stream);
    Args a{};
    const float** pp = (const float**)&a.p;
    for (int i = 0; i < 17; ++i) pp[i] = (const float*)d_in[i];
    a.p.out = (float*)d_out; a.p.ws = (unsigned char*)d_ws;
    void* kargs[] = {&a};
    const hipError_t e = hipLaunchCooperativeKernel((const void*)fwd_megakernel, dim3(grid), dim3(NWAVES * 64), kargs, LDS_BYTES, stream);
    if (e != hipSuccess) fprintf(stderr, "kernel_launch: cooperative launch failed: %s (grid %d)\n", hipGetErrorString(e), grid);
}
```

```cpp
#include <hip/hip_runtime.h>
#include <hip/hip_cooperative_groups.h>
#include <hip/hip_bf16.h>
#include <cstdio>
#include <cstdint>
#include <cmath>
namespace pg8 {
#define PG8_LAS __attribute__((address_space(3)))
typedef unsigned short bf16_t;
typedef short bf16x8 __attribute__((ext_vector_type(8)));
typedef float f32x4 __attribute__((ext_vector_type(4)));
typedef unsigned u32x4 __attribute__((ext_vector_type(4)));
constexpr int BM = 256, BK = 64, HALF = 128, HTB = HALF * BK * 2  , STAGE_BYTES = 8 * HTB, NXCD = 8, WGM = 4;

__host__ __device__ __forceinline__ int lds_byte(int r, int c) { const int st = (r >> 4) * 2 + (c >> 5), rr = r & 15, cc = c & 31, ob = rr * 64 + cc * 2; return st * 1024 + (ob ^ (((ob >> 9) & 1) << 5)); }
__host__ __device__ __forceinline__ void stage_rc(int b, int& R, int& C) { const int st = b / 1024, sb = b % 1024, swz = sb ^ (((sb >> 9) & 1) << 5); R = (st >> 1) * 16 + swz / 64; C = (st & 1) * 32 + (swz % 64) / 2; }
__host__ __device__ __forceinline__ int perm32(int rho) { const int n = rho >> 4, i = rho & 15; return 8 * (i >> 2) + 4 * n + (i & 3); }

struct Unit { int pm, pn; };
struct Gemm { const bf16_t* A; const bf16_t* Bt; int M, N, K; };

struct StaticOrder {
    int nM, nN, nwg, G, c;
    __host__ __device__ void init(int M, int N, int G_, int c_) { nM = M / BM; nN = N / BM; nwg = nM * nN; G = G_; c = c_; }
    __host__ __device__ bool next(int i, Unit& u) const {
        const long L = (long)i * G + c; if (L >= nwg) return false;
        int wgid = (int)L; { const int q = nwg / NXCD, r = nwg % NXCD, xcd = wgid % NXCD, off = wgid / NXCD; wgid = (xcd < r ? xcd * (q + 1) : r * (q + 1) + (xcd - r) * q) + off; }
        const int nig = WGM * nN, gid = wgid / nig, fm = gid * WGM, gsz = (nM - fm) < WGM ? (nM - fm) : WGM;
        u.pm = fm + ((wgid % nig) % gsz); u.pn = (wgid % nig) / gsz; return true;
    }
    __device__ __forceinline__ void a_ready(const Unit&) const {}
    __device__ __forceinline__ void done(const Unit&) const {}
};

typedef float f32x2c __attribute__((ext_vector_type(2))); typedef __bf16 bf16x2c __attribute__((ext_vector_type(2)));
__device__ __forceinline__ unsigned cvt_pk_bf16(float lo, float hi) { f32x2c v = {lo, hi}; bf16x2c b = __builtin_convertvector(v, bf16x2c); return __builtin_bit_cast(unsigned, b); }
typedef float f32x2 __attribute__((ext_vector_type(2)));
__device__ __forceinline__ f32x2 gelu_pk(f32x2 v) {
    const f32x2 av = __builtin_elementwise_abs(v), d = av * 0.2316418882f + 1.0f;
    f32x2 t; t.x = __builtin_amdgcn_rcpf(d.x); t.y = __builtin_amdgcn_rcpf(d.y);
    f32x2 q = t * 0.5307027145f + (-0.7265760135f); q = q * t + 0.7107068705f; q = q * t + (-0.142248368f); q = q * t + 0.127414796f; q = q * t;
    const f32x2 s = (v * v) * (-0.72134752044f);
    f32x2 e; e.x = __builtin_amdgcn_exp2f(s.x); e.y = __builtin_amdgcn_exp2f(s.y);
    f32x2 p; p.x = fmaxf(v.x, 0.f); p.y = fmaxf(v.y, 0.f);
    return p - av * (q * e);
}

template <int ACT  > struct EpiBf16 {
    static constexpr bool PERM = true, AFTER_DRAIN = false; static_assert(ACT == 0 || ACT == 1, "EpiBf16: ACT is 0 (none) or 1 (gelu_pk)");
    bf16_t* O; int ldc; const float* bias; int split_cols; size_t split_stride; float scale0;
    __device__ __forceinline__ void operator()(const f32x4 (&acc)[2][2][4][2], const Unit& u, int wr, int wc, int fr, int fq) const {
        const int row0 = u.pm * BM + wr * 64 + fr; int colt = u.pn * BM; bf16_t* base = O;
        float sc = 1.f; if (split_cols) { const int t = colt / split_cols; base += (size_t)t * split_stride; colt -= t * split_cols; if (t == 0) sc = scale0; }
        const int col0 = colt + wc * 32 + 8 * fq, bcol0 = u.pn * BM + wc * 32 + 8 * fq;
        f32x4 bv[2][2];
#pragma unroll
        for (int bj = 0; bj < 2; ++bj)
#pragma unroll
            for (int n = 0; n < 2; ++n) bv[bj][n] = bias ? *(const f32x4*)(bias + bcol0 + bj * HALF + 4 * n) : (f32x4){0.f, 0.f, 0.f, 0.f};
#pragma unroll
        for (int ai = 0; ai < 2; ++ai)
#pragma unroll
            for (int m = 0; m < 4; ++m) { bf16_t* rowp = base + (size_t)(row0 + ai * HALF + m * 16) * ldc + col0;
#pragma unroll
                for (int bj = 0; bj < 2; ++bj) { f32x4 v0 = acc[ai][bj][m][0] + bv[bj][0], v1 = acc[ai][bj][m][1] + bv[bj][1];
                    if (ACT == 1) { f32x2 a = gelu_pk((f32x2){v0[0], v0[1]}), b = gelu_pk((f32x2){v0[2], v0[3]}), c = gelu_pk((f32x2){v1[0], v1[1]}), d = gelu_pk((f32x2){v1[2], v1[3]});
                        v0 = (f32x4){a.x, a.y, b.x, b.y}; v1 = (f32x4){c.x, c.y, d.x, d.y}; }
                    v0 = v0 * sc; v1 = v1 * sc; u32x4 w; w.x = cvt_pk_bf16(v0[0], v0[1]); w.y = cvt_pk_bf16(v0[2], v0[3]); w.z = cvt_pk_bf16(v1[0], v1[1]); w.w = cvt_pk_bf16(v1[2], v1[3]);
                    *(u32x4*)(rowp + bj * HALF) = w; } }
    }
};
__device__ __forceinline__ float silu_f(float x) { return x * __builtin_amdgcn_rcpf(1.0f + __expf(-x)); }
constexpr size_t SLOT_ELEMS = (size_t)32768 * 512;
struct EpiProj {
    static constexpr bool PERM = true, AFTER_DRAIN = false;
    bf16_t* base0; const float* hlb; int layer; float qscale;
    template <int MODE  > __device__ __forceinline__ void st_bf16(const f32x4 (&acc)[2][2][4][2], bf16_t* base, int row0, int col0, float sc) const {
#pragma unroll
        for (int ai = 0; ai < 2; ++ai)
#pragma unroll
            for (int m = 0; m < 4; ++m) { bf16_t* rowp = base + (size_t)(row0 + ai * HALF + m * 16) * 512 + col0;
#pragma unroll
                for (int bj = 0; bj < 2; ++bj) { f32x4 v0 = acc[ai][bj][m][0], v1 = acc[ai][bj][m][1];
                    if (MODE == 2) { v0 = (f32x4){silu_f(v0[0]), silu_f(v0[1]), silu_f(v0[2]), silu_f(v0[3])}; v1 = (f32x4){silu_f(v1[0]), silu_f(v1[1]), silu_f(v1[2]), silu_f(v1[3])}; }
                    if (MODE == 1) { v0 = v0 * sc; v1 = v1 * sc; }
                    u32x4 w; w.x = cvt_pk_bf16(v0[0], v0[1]); w.y = cvt_pk_bf16(v0[2], v0[3]); w.z = cvt_pk_bf16(v1[0], v1[1]); w.w = cvt_pk_bf16(v1[2], v1[3]);
                    *(u32x4*)(rowp + bj * HALF) = w; } }
    }
    template <bool LB0> static __device__ __forceinline__ float logf_gate(float z, float l) {
        const float e = __expf(-fabsf(z));
        if (LB0) return fminf(z, 0.f) - __logf(1.0f + e);
        const float r = __builtin_amdgcn_rcpf(1.0f + e); const float sg = (z >= 0.f) ? r : e * r;
        return __logf(l + (1.0f - l) * sg);
    }
    template <bool LB0> static __device__ __forceinline__ f32x4 logf_gate4(f32x4 v, f32x4 l) { return (f32x4){logf_gate<LB0>(v[0], l[0]), logf_gate<LB0>(v[1], l[1]), logf_gate<LB0>(v[2], l[2]), logf_gate<LB0>(v[3], l[3])}; }
    __device__ __forceinline__ f32x4 lb4(int c) const {
        const f32x4 h0 = *(const f32x4*)(hlb + c), h1 = *(const f32x4*)(hlb + 512 + c);
        return (f32x4){__builtin_amdgcn_rcpf(1.0f + __expf(h0[0] - h1[0])), __builtin_amdgcn_rcpf(1.0f + __expf(h0[1] - h1[1])), __builtin_amdgcn_rcpf(1.0f + __expf(h0[2] - h1[2])), __builtin_amdgcn_rcpf(1.0f + __expf(h0[3] - h1[3]))};
    }
    template <bool LB0> __device__ __forceinline__ void st_logf(const f32x4 (&acc)[2][2][4][2], float* base, int row0, int col0) const {
        const f32x4 z4 = (f32x4){0.f, 0.f, 0.f, 0.f};
        const f32x4 lA0 = LB0 ? z4 : lb4(col0), lA1 = LB0 ? z4 : lb4(col0 + 4), lB0 = LB0 ? z4 : lb4(col0 + HALF), lB1 = LB0 ? z4 : lb4(col0 + HALF + 4);
#pragma unroll
        for (int ai = 0; ai < 2; ++ai)
#pragma unroll
            for (int m = 0; m < 4; ++m) { float* rowp = base + (size_t)(row0 + ai * HALF + m * 16) * 512 + col0;
                *(f32x4*)(rowp) = logf_gate4<LB0>(acc[ai][0][m][0], lA0); *(f32x4*)(rowp + 4) = logf_gate4<LB0>(acc[ai][0][m][1], lA1);
                *(f32x4*)(rowp + HALF) = logf_gate4<LB0>(acc[ai][1][m][0], lB0); *(f32x4*)(rowp + HALF + 4) = logf_gate4<LB0>(acc[ai][1][m][1], lB1); }
    }
    __device__ __forceinline__ void operator()(const f32x4 (&acc)[2][2][4][2], const Unit& u, int wr, int wc, int fr, int fq) const {
        const int t = u.pn >> 1, colt = (u.pn & 1) * 256, slot = t < 5 ? t : t + 1;
        const int row0 = u.pm * BM + wr * 64 + fr, col0 = colt + wc * 32 + 8 * fq;
        bf16_t* base = base0 + (size_t)slot * SLOT_ELEMS;
        if (t == 4) { if (layer == 0) st_logf<true>(acc, (float*)base, row0, col0); else st_logf<false>(acc, (float*)base, row0, col0); }
        else if (t == 0) st_bf16<1>(acc, base, row0, col0, qscale);
        else if (t == 3 || t == 6) st_bf16<2>(acc, base, row0, col0, 1.f);
        else st_bf16<0>(acc, base, row0, col0, 1.f);
    }
};
struct EpiRes {
    static constexpr bool PERM = false, AFTER_DRAIN = false;
    const float* ysrc; float* ydst; const float* stats; const float* g; const float* b; float alpha;
    __device__ __forceinline__ void operator()(const f32x4 (&acc)[2][2][4][2], const Unit& u, int wr, int wc, int fr, int fq) const {
        const int col0 = u.pn * BM + wc * 32 + 4 * fq, rowb = u.pm * BM + wr * 64 + fr;
        float mu[2][4], rs[2][4];
#pragma unroll
        for (int ai = 0; ai < 2; ++ai)
#pragma unroll
            for (int m = 0; m < 4; ++m) { const f32x2 st = *(const f32x2*)(stats + 2 * (rowb + ai * HALF + m * 16)); mu[ai][m] = st.x; rs[ai][m] = st.y; }
#pragma unroll
        for (int bj = 0; bj < 2; ++bj)
#pragma unroll
            for (int n = 0; n < 2; ++n) { const int c = col0 + bj * HALF + n * 16;
                f32x4 y[2][4];
#pragma unroll
                for (int ai = 0; ai < 2; ++ai)
#pragma unroll
                    for (int m = 0; m < 4; ++m) y[ai][m] = *(const f32x4*)(ysrc + (size_t)(rowb + ai * HALF + m * 16) * 1024 + c);
                const f32x4 gv = *(const f32x4*)(g + c), bv = *(const f32x4*)(b + c);
#pragma unroll
                for (int ai = 0; ai < 2; ++ai)
#pragma unroll
                    for (int m = 0; m < 4; ++m) { const f32x4 o = (((y[ai][m] - mu[ai][m]) * rs[ai][m]) * gv + bv) * alpha + acc[ai][bj][m][n];
                        *(f32x4*)(ydst + (size_t)(rowb + ai * HALF + m * 16) * 1024 + c) = o; }
                asm volatile("" ::: "memory"); }
    }
};
struct EpiGate {
    static constexpr bool PERM = true, AFTER_DRAIN = false;
    bf16_t* G; float* halo; const float* cw; const float* cb;
    static __device__ __forceinline__ float ror1(float v) { return __builtin_bit_cast(float, __builtin_amdgcn_mov_dpp(__builtin_bit_cast(int, v), 0x121, 0xf, 0xf, false)); }
    static __device__ __forceinline__ float ror2(float v) { return __builtin_bit_cast(float, __builtin_amdgcn_mov_dpp(__builtin_bit_cast(int, v), 0x122, 0xf, 0xf, false)); }
    static __device__ __forceinline__ f32x4 ror1v(f32x4 v) { return (f32x4){ror1(v[0]), ror1(v[1]), ror1(v[2]), ror1(v[3])}; }
    static __device__ __forceinline__ f32x4 ror2v(f32x4 v) { return (f32x4){ror2(v[0]), ror2(v[1]), ror2(v[2]), ror2(v[3])}; }
    __device__ __forceinline__ void operator()(const f32x4 (&acc)[2][2][4][2], const Unit& u, int wr, int wc, int fr, int fq) const {
        const int rowb = u.pm * BM + wr * 64 + fr;
#pragma unroll
        for (int n = 0; n < 2; ++n) {
            const int ch = u.pn * 128 + wc * 32 + 8 * fq + 4 * n;
            const f32x4 wa0 = *(const f32x4*)(cw + ch), wa1 = *(const f32x4*)(cw + 5632 + ch), wa2 = *(const f32x4*)(cw + 2 * 5632 + ch), ba = *(const f32x4*)(cb + ch);
            const f32x4 wu0 = *(const f32x4*)(cw + 2816 + ch), wu1 = *(const f32x4*)(cw + 5632 + 2816 + ch), wu2 = *(const f32x4*)(cw + 2 * 5632 + 2816 + ch), bu = *(const f32x4*)(cb + 2816 + ch);
#pragma unroll
            for (int ai = 0; ai < 2; ++ai) {
                f32x4 pa1 = (f32x4){0.f, 0.f, 0.f, 0.f}, pa2 = pa1, pu1 = pa1, pu2 = pa1;
#pragma unroll
                for (int m = 0; m < 4; ++m) {
                    const f32x4 a = acc[ai][0][m][n], uu = acc[ai][1][m][n];
                    const f32x4 ra1 = ror1v(a), ra2 = ror2v(a), ru1 = ror1v(uu), ru2 = ror2v(uu);
                    const f32x4 a1 = (fr >= 1) ? ra1 : pa1, a2 = (fr >= 2) ? ra2 : pa2, u1 = (fr >= 1) ? ru1 : pu1, u2 = (fr >= 2) ? ru2 : pu2;
                    const f32x4 ya = wa0 * a2 + wa1 * a1 + wa2 * a + ba, yu = wu0 * u2 + wu1 * u1 + wu2 * uu + bu;
                    const f32x2 g0 = gelu_pk((f32x2){ya[0], ya[1]}), g1 = gelu_pk((f32x2){ya[2], ya[3]});
                    const int row = rowb + ai * HALF + m * 16;
                    if (m > 0 || fr >= 2) { typedef unsigned u32x2 __attribute__((ext_vector_type(2)));
                        u32x2 w; w.x = cvt_pk_bf16(g0.x * yu[0], g0.y * yu[1]); w.y = cvt_pk_bf16(g1.x * yu[2], g1.y * yu[3]); *(u32x2*)(G + (size_t)row * 2816 + ch) = w; }
                    if (m == 0 && fr < 2) { float* hp = halo + ((size_t)(row >> 6) * 4 + fr) * 5632 + ch; *(f32x4*)hp = a; *(f32x4*)(hp + 2816) = uu; }
                    if (m == 3 && fr >= 14) { float* hp = halo + ((size_t)(row >> 6) * 4 + (fr - 12)) * 5632 + ch; *(f32x4*)hp = a; *(f32x4*)(hp + 2816) = uu; }
                    pa1 = ra1; pa2 = ra2; pu1 = ru1; pu2 = ru2;
                }
            }
        }
    }
};
template <class Epi, class Sched, bool ALIGN_EPI = false, bool SP2 = false>
__device__ __forceinline__ void gemm_phase(PG8_LAS unsigned char* lds, const Gemm g, const Sched& S, const Epi& E) {
    int tid_ = threadIdx.x; asm volatile("" : "+v"(tid_)); const int tid = tid_, wid = __builtin_amdgcn_readfirstlane(tid >> 6), lane = tid & 63, wr = wid >> 2, wc = wid & 3, fr = lane & 15, fq = lane >> 4;
    const int K = g.K, nt = K / BK;
    unsigned voffA[2], voffB[2];
#pragma unroll
    for (int i = 0; i < 2; ++i) { int R, C; stage_rc(tid * 16 + i * 8192, R, C); const int Rb = Epi::PERM ? ((R & ~31) + perm32(R & 31)) : R;
        voffA[i] = (unsigned)(R * K + C) * 2u; voffB[i] = (unsigned)(Rb * K + C) * 2u; }
    const size_t kstep = (size_t)(BK * 2);
    const size_t hstep = (size_t)HALF * K * 2;
    const size_t tstep = 2 * hstep;
    const unsigned ldsw = (unsigned)wid * 1024u;
    const int aoff = lds_byte(wr * 64 + fr, fq * 8), boff = lds_byte(wc * 32 + fr, fq * 8);
#define PG8_SA(b, h) (((b) * 2 + (h)) * HTB)
#define PG8_SB(b, h) ((4 + (b) * 2 + (h)) * HTB)
#define PG8_STAGE(bufoff, gbase, voff) do { _Pragma("unroll") for (int _i = 0; _i < 2; ++_i) \
        __builtin_amdgcn_global_load_lds((const unsigned*)((const char*)(gbase) + (voff)[_i]), (PG8_LAS unsigned*)(lds + (bufoff) + ldsw + _i * 8192), 16, 0, 0); } while (0)
#define PG8_LDA(dst, b, h) do { _Pragma("unroll") for (int m = 0; m < 4; ++m) _Pragma("unroll") for (int k = 0; k < 2; ++k) dst[m][k] = *(const PG8_LAS bf16x8*)(lds + PG8_SA(b, h) + aoff + m * 2048 + k * 1024); } while (0)
#define PG8_LDB(dst, b, h) do { _Pragma("unroll") for (int n = 0; n < 2; ++n) _Pragma("unroll") for (int k = 0; k < 2; ++k) dst[n][k] = *(const PG8_LAS bf16x8*)(lds + PG8_SB(b, h) + boff + n * 2048 + k * 1024); } while (0)
#define PG8_MMA(ai, bj, At, Bt) do { __builtin_amdgcn_s_setprio(1); _Pragma("unroll") for (int m = 0; m < 4; ++m) _Pragma("unroll") for (int n = 0; n < 2; ++n) _Pragma("unroll") for (int k = 0; k < 2; ++k) \
        acc[ai][bj][m][n] = __builtin_amdgcn_mfma_f32_16x16x32_bf16(Bt[n][k], At[m][k], acc[ai][bj][m][n], 0, 0, 0); __builtin_amdgcn_s_setprio(0); } while (0)
#define PG8_WAIT_V(n) asm volatile("s_waitcnt vmcnt(" #n ")" ::: "memory")
#define PG8_WAIT_L(n) asm volatile("s_waitcnt lgkmcnt(" #n ")" ::: "memory")
#define PG8_BAR __builtin_amdgcn_s_barrier()
#define PG8_SCHED __builtin_amdgcn_sched_barrier(0)
    Unit cur, nxt; int ui = 0;
    if (!S.next(0, cur)) return;
    f32x4 acc[2][2][4][2];
#pragma unroll
    for (int a = 0; a < 2; ++a)
#pragma unroll
        for (int b = 0; b < 2; ++b)
#pragma unroll
            for (int m = 0; m < 4; ++m)
#pragma unroll
                for (int n = 0; n < 2; ++n) acc[a][b][m][n] = (f32x4){0.f, 0.f, 0.f, 0.f};
    bf16x8 At[4][2], B0[2][2], B1[2][2];
    const char* cA = (const char*)g.A + (size_t)cur.pm * tstep; const char* cB = (const char*)g.Bt + (size_t)cur.pn * tstep;
    S.a_ready(cur);
    if constexpr (SP2) {
        PG8_STAGE(PG8_SB(0, 0), cB, voffB); PG8_STAGE(PG8_SB(0, 1), cB + hstep, voffB); PG8_STAGE(PG8_SA(0, 0), cA, voffA); PG8_STAGE(PG8_SA(0, 1), cA + hstep, voffA);
        if (wr == 1) PG8_BAR;
        PG8_WAIT_V(2); PG8_BAR;
        PG8_STAGE(PG8_SB(1, 0), cB + kstep, voffB); PG8_STAGE(PG8_SA(1, 0), cA + kstep, voffA); PG8_STAGE(PG8_SB(1, 1), cB + hstep + kstep, voffB);
        PG8_WAIT_V(6); PG8_BAR;
    } else {
        PG8_STAGE(PG8_SB(0, 0), cB, voffB); PG8_STAGE(PG8_SA(0, 0), cA, voffA); PG8_STAGE(PG8_SB(0, 1), cB + hstep, voffB); PG8_STAGE(PG8_SA(0, 1), cA + hstep, voffA);
        if (wr == 1) PG8_BAR;
        PG8_WAIT_V(4); PG8_BAR;
        PG8_STAGE(PG8_SB(1, 0), cB + kstep, voffB); PG8_STAGE(PG8_SA(1, 0), cA + kstep, voffA); PG8_STAGE(PG8_SB(1, 1), cB + hstep + kstep, voffB);
        PG8_WAIT_V(6); PG8_BAR;
    }
    for (;;) {
        const bool has_next = S.next(ui + 1, nxt);
        const char* nA = has_next ? (const char*)g.A + (size_t)nxt.pm * tstep : cA; const char* nB = has_next ? (const char*)g.Bt + (size_t)nxt.pn * tstep : cB;
        for (int t = 0; t < nt; t += 2) {
            const bool last = (t == nt - 2);
            const char* a1 = cA + (size_t)(t + 1) * kstep;
            const char* a2 = last ? nA : cA + (size_t)(t + 2) * kstep; const char* b2 = last ? nB : cB + (size_t)(t + 2) * kstep;
            const char* a3 = a2 + kstep; const char* b3 = b2 + kstep;
            if (last && has_next) S.a_ready(nxt);
            if constexpr (SP2) {
            PG8_LDB(B0, 0, 0); PG8_LDB(B1, 0, 1); PG8_SCHED; PG8_LDA(At, 0, 0); PG8_STAGE(PG8_SA(1, 1), a1 + hstep, voffA);
            PG8_WAIT_V(8); PG8_WAIT_L(0); PG8_BAR; PG8_MMA(0, 0, At, B0); PG8_MMA(0, 1, At, B1); PG8_BAR; PG8_SCHED;
            PG8_LDA(At, 0, 1); PG8_STAGE(PG8_SB(0, 0), b2, voffB); PG8_STAGE(PG8_SB(0, 1), b2 + hstep, voffB); PG8_STAGE(PG8_SA(0, 0), a2, voffA);
            PG8_WAIT_V(8); PG8_WAIT_L(0); PG8_BAR; PG8_MMA(1, 0, At, B0); PG8_MMA(1, 1, At, B1); PG8_BAR; PG8_SCHED;
            PG8_LDB(B0, 1, 0); PG8_LDB(B1, 1, 1); PG8_SCHED; PG8_LDA(At, 1, 0); PG8_STAGE(PG8_SA(0, 1), a2 + hstep, voffA);
            PG8_WAIT_V(8); PG8_WAIT_L(0); PG8_BAR; PG8_MMA(0, 0, At, B0); PG8_MMA(0, 1, At, B1); PG8_BAR; PG8_SCHED;
            PG8_LDA(At, 1, 1); PG8_STAGE(PG8_SB(1, 0), b3, voffB); PG8_STAGE(PG8_SB(1, 1), b3 + hstep, voffB); PG8_STAGE(PG8_SA(1, 0), a3, voffA);
            PG8_WAIT_V(8); PG8_WAIT_L(0); PG8_BAR; PG8_MMA(1, 0, At, B0); PG8_MMA(1, 1, At, B1); PG8_BAR; PG8_SCHED;
            } else {
            PG8_LDB(B0, 0, 0); PG8_SCHED; PG8_LDA(At, 0, 0); PG8_STAGE(PG8_SA(1, 1), a1 + hstep, voffA);
            PG8_WAIT_L(8); PG8_BAR; PG8_WAIT_L(0); PG8_MMA(0, 0, At, B0); PG8_BAR; PG8_SCHED;
            PG8_LDB(B1, 0, 1); PG8_STAGE(PG8_SB(0, 0), b2, voffB);
            PG8_BAR; PG8_WAIT_L(0); PG8_MMA(0, 1, At, B1); PG8_BAR;
            PG8_LDA(At, 0, 1); PG8_STAGE(PG8_SA(0, 0), a2, voffA);
            PG8_BAR; PG8_WAIT_L(0); PG8_MMA(1, 0, At, B0); PG8_BAR; PG8_SCHED;
            PG8_STAGE(PG8_SB(0, 1), b2 + hstep, voffB);
            PG8_WAIT_V(6); PG8_BAR; PG8_MMA(1, 1, At, B1); PG8_BAR;
            PG8_LDB(B0, 1, 0); PG8_SCHED; PG8_LDA(At, 1, 0); PG8_STAGE(PG8_SA(0, 1), a2 + hstep, voffA);
            PG8_WAIT_L(8); PG8_BAR; PG8_WAIT_L(0); PG8_MMA(0, 0, At, B0); PG8_BAR; PG8_SCHED;
            PG8_LDB(B1, 1, 1); PG8_STAGE(PG8_SB(1, 0), b3, voffB);
            PG8_BAR; PG8_WAIT_L(0); PG8_MMA(0, 1, At, B1); PG8_BAR;
            PG8_LDA(At, 1, 1); PG8_STAGE(PG8_SA(1, 0), a3, voffA);
            PG8_BAR; PG8_WAIT_L(0); PG8_MMA(1, 0, At, B0); PG8_BAR; PG8_SCHED;
            PG8_STAGE(PG8_SB(1, 1), b3 + hstep, voffB);
            PG8_WAIT_V(6); PG8_BAR; PG8_MMA(1, 1, At, B1); PG8_BAR;
            }
        }
        if constexpr (ALIGN_EPI) { if (wr == 0) PG8_BAR; }
        if constexpr (!Epi::AFTER_DRAIN) { E(acc, cur, wr, wc, fr, fq); S.done(cur); }
        if (!has_next) break;
#pragma unroll
        for (int a = 0; a < 2; ++a)
#pragma unroll
            for (int b = 0; b < 2; ++b)
#pragma unroll
                for (int m = 0; m < 4; ++m)
#pragma unroll
                    for (int n = 0; n < 2; ++n) acc[a][b][m][n] = (f32x4){0.f, 0.f, 0.f, 0.f};
        cur = nxt; cA = nA; cB = nB; ++ui;
        if constexpr (ALIGN_EPI) { if (wr == 1) PG8_BAR; }
    }
    PG8_WAIT_V(0);
    if constexpr (!ALIGN_EPI) { if (wr == 0) PG8_BAR; }
    PG8_BAR;
    if constexpr (Epi::AFTER_DRAIN) { E.fused(acc, cur, wr, wc, fr, fq, lds, wid, lane); S.done(cur); }
#undef PG8_SA
#undef PG8_SB
#undef PG8_STAGE
#undef PG8_LDA
#undef PG8_LDB
#undef PG8_MMA
#undef PG8_WAIT_V
#undef PG8_WAIT_L
#undef PG8_BAR
#undef PG8_SCHED
}
}
namespace attn_body {
using bf16=__hip_bfloat16;
using bf16x8=__attribute__((ext_vector_type(8)))short;
using s16x4=__attribute__((ext_vector_type(4)))short;
using f32x16=__attribute__((ext_vector_type(16)))float;
using u32x4=__attribute__((ext_vector_type(4)))unsigned;
constexpr int BATCH=4,NHEAD=8,SEQ=8192,D=64,DM=NHEAD*D,OPITCH=1024;
constexpr int NW=8,QBLK=32,QB=QBLK*NW,KVBLK=64,NQB=SEQ/QB;
constexpr int ATTN_PITCH=DM, ATTN_UNIT_ROWS=QB;
__device__ __forceinline__ int crow(int r,int hi){return (r&3)+8*(r>>2)+4*hi;}
#define SBAR() __builtin_amdgcn_sched_barrier(0)
__device__ __forceinline__ void cmask(f32x16&p0,f32x16&p1,int jb,int qrel,int hi){
  const float NEG=-INFINITY; int kb=64*jb+4*hi;
  #pragma unroll
  for(int r=0;r<16;++r){int kv=kb+(r&3)+8*(r>>2); if(kv>qrel)p0[r]=NEG; if(kv+32>qrel)p1[r]=NEG;}
}

constexpr int NSLOT=3, SLOTB=8192;
constexpr int LDS_K=0, LDS_V=NSLOT*SLOTB, LDS_WS=2*NSLOT*SLOTB, LDS_OST=LDS_WS+NW*64*4, LDS_CK=LDS_OST+NW*4096, LDS_BYTES=LDS_CK+SEQ*4;
constexpr float C2=0.125f*1.4426950408889634f;
__device__ __forceinline__ void glds16(const void*gsrc,unsigned lds_dst){unsigned keep;
  asm volatile("s_mov_b32 %0, m0\n\ts_mov_b32 m0, %2\n\ts_nop 0\n\tglobal_load_lds_dwordx4 %1, off\n\ts_mov_b32 m0, %0":"=&s"(keep):"v"(gsrc),"s"(lds_dst):"memory");}
__device__ __forceinline__ float max3f(float a,float b,float c){float r;asm("v_max3_f32 %0, %1, %2, %3":"=v"(r):"v"(a),"v"(b),"v"(c));return r;}
__device__ __forceinline__ float max2f(float a,float b){float r;asm("v_max_f32_e32 %0, %1, %2":"=v"(r):"v"(a),"v"(b));return r;}
__device__ __forceinline__ float fadd_s(float a,float b){float r;asm("v_add_f32_e32 %0, %1, %2":"=v"(r):"v"(a),"v"(b));return r;}
__device__ __forceinline__ float fsub_s(float a,float b){float r;asm("v_sub_f32_e32 %0, %1, %2":"=v"(r):"v"(a),"v"(b));return r;}
typedef float f32x2_t __attribute__((ext_vector_type(2))); typedef __bf16 bf16x2_t __attribute__((ext_vector_type(2)));
__device__ __forceinline__ unsigned cvtpk_s(float lo,float hi){f32x2_t v={lo,hi};bf16x2_t b=__builtin_convertvector(v,bf16x2_t);return __builtin_bit_cast(unsigned,b);}
#define WAIT_BAR(N) asm volatile("s_waitcnt vmcnt(" #N ") lgkmcnt(0)\n\ts_barrier":::"memory")

__device__ __forceinline__ void qkt(f32x16&p0,f32x16&p1,const char*Kslot,const bf16x8*qr,const f32x16&negm,int r32,int hi){
  const char*kb=Kslot+hi*1024+r32*16;
  #pragma unroll
  for(int d0=0;d0<4;++d0){
    const bf16x8 b0=*reinterpret_cast<const bf16x8*>(kb+d0*2048);
    const bf16x8 b1=*reinterpret_cast<const bf16x8*>(kb+d0*2048+512);
    if(d0==0){p0=__builtin_amdgcn_mfma_f32_32x32x16_bf16(b0,qr[0],negm,0,0,0);p1=__builtin_amdgcn_mfma_f32_32x32x16_bf16(b1,qr[0],negm,0,0,0);}
    else{p0=__builtin_amdgcn_mfma_f32_32x32x16_bf16(b0,qr[d0],p0,0,0,0);p1=__builtin_amdgcn_mfma_f32_32x32x16_bf16(b1,qr[d0],p1,0,0,0);}}
}
typedef __attribute__((address_space(3))) const char* lds_cptr;
typedef short v4i16_t __attribute__((ext_vector_type(4)));
__device__ __forceinline__ void kload8(bf16x8*kf,lds_cptr kp){
  kf[0]=*(const __attribute__((address_space(3))) bf16x8*)(kp);      kf[1]=*(const __attribute__((address_space(3))) bf16x8*)(kp+512);
  kf[2]=*(const __attribute__((address_space(3))) bf16x8*)(kp+2048); kf[3]=*(const __attribute__((address_space(3))) bf16x8*)(kp+2560);
  kf[4]=*(const __attribute__((address_space(3))) bf16x8*)(kp+4096); kf[5]=*(const __attribute__((address_space(3))) bf16x8*)(kp+4608);
  kf[6]=*(const __attribute__((address_space(3))) bf16x8*)(kp+6144); kf[7]=*(const __attribute__((address_space(3))) bf16x8*)(kp+6656);
}
__device__ __forceinline__ void kload2(bf16x8*kf,lds_cptr kp,int j){ kf[2*j]=*(const __attribute__((address_space(3))) bf16x8*)(kp+j*2048); kf[2*j+1]=*(const __attribute__((address_space(3))) bf16x8*)(kp+j*2048+512); }
__device__ __forceinline__ s16x4 vtr(lds_cptr p){ return __builtin_bit_cast(s16x4,__builtin_amdgcn_ds_read_tr16_b64_v4i16((__attribute__((address_space(3))) v4i16_t*)p)); }
__device__ __forceinline__ float rowmax(const f32x16&p0,const f32x16&p1){
  float a=max3f(p0[0],p0[1],p1[0]),b=max3f(p0[2],p0[3],p1[1]);a=max3f(a,p1[2],p1[3]);
  #pragma unroll
  for(int r=4;r<16;r+=4){a=max3f(a,p0[r],p0[r+1]);b=max3f(b,p0[r+2],p0[r+3]);a=max3f(a,p1[r],p1[r+1]);b=max3f(b,p1[r+2],p1[r+3]);}
  const float m=max2f(a,b);
  auto rr=__builtin_amdgcn_permlane32_swap(__float_as_uint(m),__float_as_uint(m),false,false);
  return max2f(__uint_as_float(rr[0]),__uint_as_float(rr[1]));
}
__device__ __forceinline__ void pv(f32x16*o,int vb,bf16x8 pa0,bf16x8 pa1,bf16x8 pa2,bf16x8 pa3){
  #pragma unroll
  for(int d0=0;d0<2;++d0){s16x4 lo[4],hi[4];
    #pragma unroll
    for(int ks=0;ks<4;++ks){
      asm volatile("ds_read_b64_tr_b16 %0,%1 offset:%c2":"=&v"(lo[ks]):"v"(vb),"i"(d0*4096+ks*1024):"memory");
      asm volatile("ds_read_b64_tr_b16 %0,%1 offset:%c2":"=&v"(hi[ks]):"v"(vb),"i"(d0*4096+ks*1024+512):"memory");}
    asm volatile("s_waitcnt lgkmcnt(0)":::"memory");SBAR();
    #define PK(k) (bf16x8){lo[k][0],lo[k][1],lo[k][2],lo[k][3],hi[k][0],hi[k][1],hi[k][2],hi[k][3]}
    o[d0]=__builtin_amdgcn_mfma_f32_32x32x16_bf16(pa0,PK(0),o[d0],0,0,0);
    o[d0]=__builtin_amdgcn_mfma_f32_32x32x16_bf16(pa1,PK(1),o[d0],0,0,0);
    o[d0]=__builtin_amdgcn_mfma_f32_32x32x16_bf16(pa2,PK(2),o[d0],0,0,0);
    o[d0]=__builtin_amdgcn_mfma_f32_32x32x16_bf16(pa3,PK(3),o[d0],0,0,0);
    #undef PK
  }
}

#ifndef ATTN_STORE16
#define ATTN_STORE16(p,v) (*(u32x4*)(p)=(v))
#endif
template<int THRL> __device__ __forceinline__ void attn_unit(int b,int h,int qb,const bf16*Q,const bf16*__restrict__ K,const bf16*__restrict__ V,bf16*O,const float*__restrict__ c2,const float*__restrict__ gnorm,int ts,char*shm){
  int tid_=threadIdx.x; asm volatile("":"+v"(tid_)); const int tid=tid_,lane=tid&63,r32=lane&31,hi=lane>>5; const int wid=__builtin_amdgcn_readfirstlane(tid>>6);
  const long rowbase=(long)b*SEQ; const int q0=qb*QB;
  const bf16*Qw=Q+(rowbase+q0+wid*QBLK)*DM+h*D;
  const bf16*Kh=K+(rowbase+(long)ts*KVBLK)*DM+h*D,*Vh=V+(rowbase+(long)ts*KVBLK)*DM+h*D;
  const unsigned lds0=(unsigned)(uintptr_t)shm;
  float*wsf=(float*)(shm+LDS_WS)+wid*64;
  const bf16*ksrc=Kh+(long)lane*DM+wid*8;
  const bf16*vsrc=Vh+(long)(16*(wid&3)+(lane>>2))*DM+(wid>>2)*32+(lane&3)*8;
  const unsigned kdst=lds0+LDS_K+wid*1024, vdst=lds0+LDS_V+wid*1024;
  #define DMA_K(t,slot) glds16(ksrc+(long)(t)*KVBLK*DM,(unsigned)__builtin_amdgcn_readfirstlane(kdst+(slot)))
  #define DMA_V(t,slot) glds16(vsrc+(long)(t)*KVBLK*DM,(unsigned)__builtin_amdgcn_readfirstlane(vdst+(slot)))
  const int vb0=(int)(lds0+LDS_V)+((lane>>4)&1)*32+(lane&3)*8+(4*hi+((lane&15)>>2))*64;
  const char*Kbase=shm+LDS_K; bf16x8 kf[8];
  const lds_cptr shm3=(lds_cptr)shm; const lds_cptr kp0=shm3+LDS_K+hi*1024+r32*16; const lds_cptr vp0=shm3+LDS_V+((lane>>4)&1)*32+(lane&3)*8+(4*hi+((lane&15)>>2))*64;
  const int NT=(q0+QB)/KVBLK-ts;
  DMA_K(0,0);DMA_V(0,0);DMA_K(1,SLOTB);
  bf16x8 qr[4];
  #pragma unroll
  for(int d0=0;d0<4;++d0)qr[d0]=*reinterpret_cast<const bf16x8*>(&Qw[(long)r32*DM+d0*16+hi*8]);
  float mhat=0.f,l_reg=0.f;f32x16 o[2];o[0]=f32x16{};o[1]=f32x16{};f32x16 negm=f32x16{};asm volatile("":"+v"(negm));
  const int qrel=wid*QBLK+r32;
  #define CMASK(P0,P1,t) do{int jb_=(t)-(NT-4); if(jb_>=0)cmask(P0,P1,jb_,qrel,hi);}while(0)
  bool resc=false;
  #define START(P0,P1) do{ const float rm=*(const __attribute__((address_space(3))) float*)(shm3+LDS_CK+4*(q0-ts*KVBLK+wid*QBLK+r32)); resc=false; \
    { const float dl=rm; mhat=fadd_s(mhat,dl); \
      _Pragma("unroll") for(int r=0;r<16;++r){P0[r]=fsub_s(P0[r],dl);P1[r]=fsub_s(P1[r],dl);} \
      _Pragma("unroll") for(int r=0;r<16;++r)negm[r]=-mhat; asm volatile("":"+v"(negm)); } \
    _Pragma("unroll") for(int r=0;r<16;++r)P0[r]=__builtin_amdgcn_exp2f(P0[r]); }while(0)
  #define RESC() do{ if(resc){ asm volatile("s_waitcnt lgkmcnt(0)":::"memory"); \
      _Pragma("unroll") for(int d_=0;d_<2;++d_) _Pragma("unroll") for(int r=0;r<16;++r)o[d_][r]*=wsf[crow(r,hi)]; } }while(0)
  f32x16 pA0,pA1,pB0,pB1;
  int sl_prev=0,sl_cur=0,sl_next=SLOTB;
  #define ROT() do{sl_prev=sl_cur;sl_cur=sl_next;sl_next=(sl_next==(NSLOT-1)*SLOTB)?0:sl_next+SLOTB;}while(0)
  { typedef float f32x4v __attribute__((ext_vector_type(4)));
    const float*cb=c2+((long)(b*NHEAD+h))*SEQ; const float cref=cb[q0+QB-1];
    for(int i=tid;i<(q0+QB)/4-ts*16;i+=NW*64){ const f32x4v v=*(const f32x4v*)(cb+ts*64+4*i); *(__attribute__((address_space(3))) f32x4v*)((lds_cptr)shm+LDS_CK+16*i)=(f32x4v){cref-v[0],cref-v[1],cref-v[2],cref-v[3]}; } }
  DMA_K(2,2*SLOTB);
  WAIT_BAR(3);
  typedef float f32x4w __attribute__((ext_vector_type(4)));
  #define CKADD(P0,P1,t) do{ const __attribute__((address_space(3))) f32x4w*cp_=(const __attribute__((address_space(3))) f32x4w*)(shm3+LDS_CK)+(t)*16+hi; \
    { SBAR(); const f32x4w a0_=cp_[0],a1_=cp_[2],a2_=cp_[4],a3_=cp_[6]; \
      P0[0]+=a0_[0];P0[1]+=a0_[1];P0[2]+=a0_[2];P0[3]+=a0_[3]; P0[4]+=a1_[0];P0[5]+=a1_[1];P0[6]+=a1_[2];P0[7]+=a1_[3]; \
      P0[8]+=a2_[0];P0[9]+=a2_[1];P0[10]+=a2_[2];P0[11]+=a2_[3]; P0[12]+=a3_[0];P0[13]+=a3_[1];P0[14]+=a3_[2];P0[15]+=a3_[3]; } \
    { SBAR(); const f32x4w b0_=cp_[8],b1_=cp_[10],b2_=cp_[12],b3_=cp_[14]; \
      P1[0]+=b0_[0];P1[1]+=b0_[1];P1[2]+=b0_[2];P1[3]+=b0_[3]; P1[4]+=b1_[0];P1[5]+=b1_[1];P1[6]+=b1_[2];P1[7]+=b1_[3]; \
      P1[8]+=b2_[0];P1[9]+=b2_[1];P1[10]+=b2_[2];P1[11]+=b2_[3]; P1[12]+=b3_[0];P1[13]+=b3_[1];P1[14]+=b3_[2];P1[15]+=b3_[3]; } }while(0)
  qkt(pA0,pA1,Kbase,qr,negm,r32,hi);asm volatile("s_nop 15\n\ts_nop 7":"+v"(pA0),"+v"(pA1));CKADD(pA0,pA1,0);CMASK(pA0,pA1,0);
  START(pA0,pA1);
  _Pragma("unroll") for(int r=0;r<16;++r)pA1[r]=__builtin_amdgcn_exp2f(pA1[r]);
  WAIT_BAR(0);
  DMA_K(3,0);DMA_V(1,SLOTB);
  ROT();
  kload8(kf,kp0+sl_cur);
  WAIT_BAR(2);
  s16x4 vlo[8],vhi[8]; u32x4 pw0,pw1,pw2,pw3;
  #define PKW(P,B) cvtpk_s(P[B],P[B+1])
  #define PAF(k) __builtin_bit_cast(bf16x8,pw##k)
  #define VFR(i) (bf16x8){vlo[i][0],vlo[i][1],vlo[i][2],vlo[i][3],vhi[i][0],vhi[i][1],vhi[i][2],vhi[i][3]}
  #define PIN(x) asm volatile("":"+v"(x))
  #define MX3(a,b,c) __builtin_fmaxf(__builtin_fmaxf((a),(b)),(c))
  #define GAPA(MF,A0,A1,A2,A3,W0,W1,PW) do{ MF; sacc+=A0; sacc+=A1; sacc+=A2; sacc+=A3; PIN(sacc); W0; W1; PIN(PW); SBAR(); }while(0)
  #define EX(v) __builtin_amdgcn_exp2f(v)
  #define GAPB(MF,X,B) do{ MF; X[B]=EX(X[B]); X[B+1]=EX(X[B+1]); X[B+2]=EX(X[B+2]); X[B+3]=EX(X[B+3]); PIN(X); SBAR(); }while(0)
  #define VRD(i) do{ vlo[i]=vtr(vp_+(((i)>>2)*4096+((i)&3)*1024)); vhi[i]=vtr(vp_+(((i)>>2)*4096+((i)&3)*1024+512)); }while(0)
  #define KRD(G,j) do{ if(G){ kload2(kf,kp0+sl_next,j); SBAR(); } }while(0)
  #define STEP(C0,C1,P0,P1,t,GK,GV,GL) do{ SBAR(); \
    const lds_cptr vp_=vp0+sl_prev; \
    VRD(0); SBAR(); float sacc=(P0[0]+P0[1]); \
    GAPA(C0=__builtin_amdgcn_mfma_f32_32x32x16_bf16(kf[0],qr[0],negm,0,0,0), P0[2],P0[3],P0[4],P0[5],     pw0[0]=PKW(P0,0), pw0[1]=PKW(P0,2), pw0); \
    VRD(4); SBAR(); GAPA(C1=__builtin_amdgcn_mfma_f32_32x32x16_bf16(kf[1],qr[0],negm,0,0,0), P0[6],P0[7],P0[8],P0[9],     pw0[2]=PKW(P0,4), pw0[3]=PKW(P0,6), pw0); \
    VRD(1); SBAR(); GAPA(C0=__builtin_amdgcn_mfma_f32_32x32x16_bf16(kf[2],qr[1],C0,0,0,0),   P0[10],P0[11],P0[12],P0[13], pw1[0]=PKW(P0,8), pw1[1]=PKW(P0,10), pw1); \
    VRD(5); SBAR(); GAPA(C1=__builtin_amdgcn_mfma_f32_32x32x16_bf16(kf[3],qr[1],C1,0,0,0),   P0[14],P0[15],P1[0],P1[1],   pw1[2]=PKW(P0,12),pw1[3]=PKW(P0,14), pw1); \
    VRD(2); SBAR(); GAPA(C0=__builtin_amdgcn_mfma_f32_32x32x16_bf16(kf[4],qr[2],C0,0,0,0),   P1[2],P1[3],P1[4],P1[5],     pw2[0]=PKW(P1,0), pw2[1]=PKW(P1,2), pw2); \
    VRD(6); SBAR(); GAPA(C1=__builtin_amdgcn_mfma_f32_32x32x16_bf16(kf[5],qr[2],C1,0,0,0),   P1[6],P1[7],P1[8],P1[9],     pw2[2]=PKW(P1,4), pw2[3]=PKW(P1,6), pw2); \
    VRD(3); SBAR(); GAPA(C0=__builtin_amdgcn_mfma_f32_32x32x16_bf16(kf[6],qr[3],C0,0,0,0),   P1[10],P1[11],P1[12],P1[13], pw3[0]=PKW(P1,8), pw3[1]=PKW(P1,10), pw3); \
    VRD(7); SBAR(); GAPA(C1=__builtin_amdgcn_mfma_f32_32x32x16_bf16(kf[7],qr[3],C1,0,0,0),   P1[14],P1[15],0.f,0.f,       pw3[2]=PKW(P1,12),pw3[3]=PKW(P1,14), pw3); \
    l_reg+=sacc; \
    if(GK){DMA_K((t)+3,sl_cur);} if(GV){DMA_V((t)+1,sl_next);} \
    CKADD(C0,C1,t); CMASK(C0,C1,t); \
    { float a=MX3(C0[0],C0[1],C1[0]),b=MX3(C0[2],C0[3],C1[1]); a=MX3(a,C1[2],C1[3]); \
      _Pragma("unroll") for(int r=4;r<16;r+=4){a=MX3(a,C0[r],C0[r+1]);b=MX3(b,C0[r+2],C0[r+3]);a=MX3(a,C1[r],C1[r+1]);b=MX3(b,C1[r+2],C1[r+3]);} \
      float rm=__builtin_fmaxf(a,b); { auto rr=__builtin_amdgcn_permlane32_swap(__float_as_uint(rm),__float_as_uint(rm),false,false); rm=__builtin_fmaxf(__uint_as_float(rr[0]),__uint_as_float(rr[1])); } \
      resc=false; \
      if(__builtin_expect(__any(rm>(float)THRL),0)){ const float dl=__builtin_fmaxf(rm,0.f); mhat+=dl; \
        _Pragma("unroll") for(int r=0;r<16;++r){C0[r]-=dl;C1[r]-=dl;} \
        _Pragma("unroll") for(int r=0;r<16;++r)negm[r]=-mhat; asm volatile("":"+v"(negm)); \
        const float f=__builtin_amdgcn_exp2f(-dl); l_reg*=f; if(hi==0)wsf[r32]=f; resc=true; } } \
    SBAR(); \
    GAPB(o[0]=__builtin_amdgcn_mfma_f32_32x32x16_bf16(PAF(0),VFR(0),o[0],0,0,0), C0,0); \
    GAPB(o[1]=__builtin_amdgcn_mfma_f32_32x32x16_bf16(PAF(0),VFR(4),o[1],0,0,0), C0,4); \
    KRD(GL,0); GAPB(o[0]=__builtin_amdgcn_mfma_f32_32x32x16_bf16(PAF(1),VFR(1),o[0],0,0,0), C0,8); \
    KRD(GL,1); GAPB(o[1]=__builtin_amdgcn_mfma_f32_32x32x16_bf16(PAF(1),VFR(5),o[1],0,0,0), C0,12); \
    KRD(GL,2); GAPB(o[0]=__builtin_amdgcn_mfma_f32_32x32x16_bf16(PAF(2),VFR(2),o[0],0,0,0), C1,0); \
    KRD(GL,3); GAPB(o[1]=__builtin_amdgcn_mfma_f32_32x32x16_bf16(PAF(2),VFR(6),o[1],0,0,0), C1,4); \
    GAPB(o[0]=__builtin_amdgcn_mfma_f32_32x32x16_bf16(PAF(3),VFR(3),o[0],0,0,0), C1,8); \
    GAPB(o[1]=__builtin_amdgcn_mfma_f32_32x32x16_bf16(PAF(3),VFR(7),o[1],0,0,0), C1,12); \
    }while(0)
  int t=1;
  #undef CMASK
  #define CMASK(P0,P1,t) do{}while(0)
  for(;t+5<NT;t+=2){
    STEP(pB0,pB1,pA0,pA1,t,true,true,true);     WAIT_BAR(2); RESC(); ROT();
    STEP(pA0,pA1,pB0,pB1,t+1,true,true,true);   WAIT_BAR(2); RESC(); ROT();
  }
  #undef CMASK
  #define CMASK(P0,P1,t) do{int jb_=(t)-(NT-4); if(jb_>=0)cmask(P0,P1,jb_,qrel,hi);}while(0)
  #define ENDW(tt) do{ if((tt)+3<NT){WAIT_BAR(2);} else if((tt)+2<NT){WAIT_BAR(1);} else {WAIT_BAR(0);} }while(0)
  for(;t+1<NT;t+=2){
    STEP(pB0,pB1,pA0,pA1,t,(t+3<NT),(t+1<NT),(t+1<NT));       ENDW(t);   RESC(); ROT();
    STEP(pA0,pA1,pB0,pB1,t+1,(t+4<NT),(t+2<NT),(t+2<NT));     ENDW(t+1); RESC(); ROT();
  }
  STEP(pB0,pB1,pA0,pA1,NT-1,false,false,false); RESC();
  { float sacc=pB0[0]+pB0[1]; _Pragma("unroll") for(int r=2;r<16;++r)sacc+=pB0[r]; _Pragma("unroll") for(int r=0;r<16;++r)sacc+=pB1[r]; l_reg+=sacc;
    pw0=(u32x4){PKW(pB0,0),PKW(pB0,2),PKW(pB0,4),PKW(pB0,6)};pw1=(u32x4){PKW(pB0,8),PKW(pB0,10),PKW(pB0,12),PKW(pB0,14)};pw2=(u32x4){PKW(pB1,0),PKW(pB1,2),PKW(pB1,4),PKW(pB1,6)};pw3=(u32x4){PKW(pB1,8),PKW(pB1,10),PKW(pB1,12),PKW(pB1,14)};
    SBAR(); pv(o,vb0+sl_cur,PAF(0),PAF(1),PAF(2),PAF(3)); }
  #undef PKW
  #undef PAF
  #undef VFR
  #undef PIN
  #undef MX3
  #undef GAPA
  #undef GAPB
  #undef EX
  #undef VRD
  #undef KRD
  #undef STEP
  #undef ENDW
  {auto rr=__builtin_amdgcn_permlane32_swap(__float_as_uint(l_reg),__float_as_uint(l_reg),false,false);l_reg=__uint_as_float(rr[0])+__uint_as_float(rr[1]);}
  if(hi==0)wsf[32+r32]=l_reg;asm volatile("s_waitcnt lgkmcnt(0)":::"memory");
  float rli[16];
  #pragma unroll
  for(int r=0;r<16;++r)rli[r]=__builtin_amdgcn_rcpf(wsf[32+crow(r,hi)]);
  { const float g0=gnorm[h*D+r32],g1=gnorm[h*D+32+r32];
    #pragma unroll
    for(int r=0;r<16;++r){ const float x0=o[0][r]*rli[r],x1=o[1][r]*rli[r]; float s=x0*x0+x1*x1;
      s+=__shfl_xor(s,1);s+=__shfl_xor(s,2);s+=__shfl_xor(s,4);s+=__shfl_xor(s,8);s+=__shfl_xor(s,16);
      const float sc=1.0f/sqrtf(s*(1.0f/64.0f)+1e-6f); o[0][r]=x0*sc*g0; o[1][r]=x1*sc*g1; rli[r]=1.0f; } }
  bf16*Ow=O+(rowbase+q0+wid*QBLK)*OPITCH+h*D;
  { bf16*stg=(bf16*)(shm+LDS_OST)+wid*2048;
    #pragma unroll
    for(int r=0;r<16;++r){const int orow=crow(r,hi);
      #pragma unroll
      for(int d0=0;d0<2;++d0)stg[orow*64+d0*32+r32]=__float2bfloat16(o[d0][r]*rli[r]);}
    asm volatile("s_waitcnt lgkmcnt(0)":::"memory");
    #pragma unroll
    for(int i=0;i<4;++i){const int row=i*8+(lane>>3),ch=lane&7; const u32x4 v=*(const u32x4*)(stg+row*64+ch*8); ATTN_STORE16(Ow+(long)row*OPITCH+ch*8,v);} }
  asm volatile("s_waitcnt lgkmcnt(0)\n\ts_barrier":::"memory");
  #undef DMA_K
  #undef DMA_V
  #undef CMASK
  #undef CKADD
  #undef START
  #undef RESC
  #undef ROT
}
constexpr int ATTN_LDS_BYTES=LDS_BYTES;
#undef SBAR
#undef WAIT_BAR
}
constexpr int NWAVES = 8;
constexpr int BATCH = 4, SEQ = 8192, M = BATCH * SEQ, D = 1024, DFF = 2816, INC = 3592, NPROJ = 3584;
constexpr int NP1 = 1536, NP2 = 1280;
constexpr float LN_EPS = 1e-5f, RMS_EPS = 1e-6f;
constexpr float DN_ALPHA = 1.4142135623730951f;
constexpr float LOG2E = 1.4426950408889634f;
constexpr size_t MiB = 1u << 20;
constexpr size_t WS_CTL = 0, CTL_ZERO_BYTES = 49152;
constexpr int CW_BAR = 8192;
constexpr int CW_KMAX = 1024, CW_QMAX = 2048, CW_TS = 4096;
constexpr size_t WS_WFA = 1 * MiB;
constexpr size_t WS_STATS = 2 * MiB;
constexpr size_t WS_C2 = 4 * MiB;
constexpr size_t WS_LFA = 5 * MiB;
constexpr size_t WS_WIN = 8 * MiB, WS_WO = 22 * MiB, WS_WUP = 26 * MiB, WS_WDN = 48 * MiB;
constexpr size_t WS_XN = 60 * MiB;
constexpr size_t WS_SLOT0 = 124 * MiB;
constexpr size_t WS_MIX = 380 * MiB;
constexpr size_t WS_HALO = 124 * MiB;
constexpr size_t WS_SUB = 124 * MiB;
constexpr size_t WS_G = 316 * MiB;
constexpr size_t WS_HQS = 444 * MiB, WS_HOI = 476 * MiB, WS_HDL = 508 * MiB;
constexpr size_t WS_END = 512 * MiB;
static_assert(WS_G + (size_t)M * DFF * 2 <= WS_END && WS_HALO + (size_t)(M / 64) * 4 * 5632 * 4 <= WS_G && WS_MIX + (size_t)M * 1024 * 2 <= WS_END, "ws map");
constexpr int RING_BYTES = 131072, MISC_OFF = RING_BYTES + 320, LDS_BYTES = 147456;

#define GAS __attribute__((address_space(1)))
#define LAS __attribute__((address_space(3)))
typedef unsigned short bf16;
typedef unsigned v4u __attribute__((ext_vector_type(4)));
typedef float f32x4 __attribute__((ext_vector_type(4)));
typedef short bf16x8 __attribute__((ext_vector_type(8)));
typedef short bf16x4 __attribute__((ext_vector_type(4)));
#define LDS_WAIT() asm volatile("s_waitcnt lgkmcnt(0)" ::: "memory")
__device__ __forceinline__ unsigned f2bf(float f) { unsigned u = __builtin_bit_cast(unsigned, f); return (u + 0x7fffu + ((u >> 16) & 1u)) >> 16; }
__device__ __forceinline__ unsigned pk2(float lo, float hi) { return f2bf(lo) | (f2bf(hi) << 16); }
__device__ __forceinline__ float bf2f(unsigned short v) { return __uint_as_float((unsigned)v << 16); }
__device__ __forceinline__ float wave_sum(float v) {
#pragma unroll
    for (int o = 1; o < 64; o <<= 1) v += __shfl_xor(v, o);
    return v;
}
__device__ __forceinline__ void p0_transpose_item(const float* W, int ldw, int K, int N, bf16* WT, int row_off, LAS float* scr, int item, int lane) {
    const int nblk = N / 32, kb = item / nblk, nb = item % nblk, k0 = 64 * kb, n0 = 32 * nb;
#pragma unroll
    for (int i = 0; i < 8; ++i) { const int kk = 8 * i + (lane >> 3), c4 = (lane & 7) * 4; const f32x4 v = *(const f32x4*)(W + (size_t)(k0 + kk) * ldw + n0 + c4);
        scr[kk * 33 + c4] = v.x; scr[kk * 33 + c4 + 1] = v.y; scr[kk * 33 + c4 + 2] = v.z; scr[kk * 33 + c4 + 3] = v.w; }
    LDS_WAIT(); asm volatile("" ::: "memory");
    const int c = lane & 7;
#pragma unroll
    for (int j = 0; j < 4; ++j) { const int n = (lane >> 3) + 8 * j; const LAS float* s = scr + (8 * c) * 33 + n;
        v4u o; o.x = pk2(s[0 * 33], s[1 * 33]); o.y = pk2(s[2 * 33], s[3 * 33]); o.z = pk2(s[4 * 33], s[5 * 33]); o.w = pk2(s[6 * 33], s[7 * 33]);
        *(GAS v4u*)(WT + (size_t)(row_off + n0 + n) * K + k0 + 8 * c) = o; }
    LDS_WAIT(); asm volatile("" ::: "memory");
}

typedef GAS unsigned gu32;
#define RLX_AGENT __ATOMIC_RELAXED, __HIP_MEMORY_SCOPE_AGENT
#define XB_TMO      128
#define XB_XCNT(j)  (256  + 64 * (j))
#define XB_XSUB(j)  (1280 + 64 * (j))
#define XB_XGEN(j)  (2304 + 64 * (j))
#define XB_TOP      3328
#define XB_TOPGEN   3392
#define XCD_BAR_WORDS 3456
#define XB_SPIN_CAP (1u << 18)

__device__ __forceinline__ unsigned xb_ld(unsigned* p)              { return __hip_atomic_load(p, __ATOMIC_RELAXED, __HIP_MEMORY_SCOPE_AGENT); }
__device__ __forceinline__ unsigned xb_add(unsigned* p, unsigned v) { return __hip_atomic_fetch_add(p, v, __ATOMIC_RELAXED, __HIP_MEMORY_SCOPE_AGENT); }
__device__ __forceinline__ unsigned xb_xcc_id() { return (unsigned)__builtin_amdgcn_s_getreg((3 << 11) | 20) & 0xFu; }
#define XB_SPIN(cond, bar) do { unsigned _sp = 0; while (cond) { __builtin_amdgcn_s_sleep(1); \
    if ((++_sp & 255u) == 0u) { if (xb_ld(&(bar)[XB_TMO])) break; if (_sp > XB_SPIN_CAP) { atomicAdd(&(bar)[XB_TMO], 1u); break; } } } } while (0)

struct XcdBarrier {
    unsigned* bar; unsigned x;
    volatile LAS unsigned* st;
};

__device__ __forceinline__ XcdBarrier xcd_barrier_post(unsigned* bar, volatile LAS unsigned* st) {
    XcdBarrier b; b.bar = bar; b.x = xb_xcc_id(); b.st = st;
    if (threadIdx.x == 0) (void)xb_add(&bar[XB_XCNT(b.x)], 1u);
    return b;
}
__device__ __forceinline__ void xcd_barrier_complete(unsigned* bar, unsigned x, unsigned& nloc, unsigned& nx) {
    const unsigned G = gridDim.x * gridDim.y * gridDim.z;
    unsigned sum, cnt, mine, sp = 0u;
    for (;;) {
        sum = 0u; cnt = 0u; mine = 0u;
#pragma unroll
        for (unsigned j = 0; j < 16; ++j) { const unsigned c = xb_ld(&bar[XB_XCNT(j)]); sum += c; cnt += (c > 0u) ? 1u : 0u; mine = (j == x) ? c : mine; }
        if (sum == G) break;
        __builtin_amdgcn_s_sleep(1);
        if ((++sp & 255u) == 0u) { if (xb_ld(&bar[XB_TMO])) break; if (sp > XB_SPIN_CAP) { atomicAdd(&bar[XB_TMO], 1u); break; } }
    }
    nloc = mine > 0u ? mine : 1u; nx = cnt > 0u ? cnt : 1u;
}

__device__ __forceinline__ void xcd_barrier(const XcdBarrier& b) {
    asm volatile("s_waitcnt vmcnt(0)" ::: "memory");
    __syncthreads();
    if (threadIdx.x == 0) {
        unsigned* bar = b.bar; unsigned xq = b.x; asm volatile("" : "+s"(bar), "+s"(xq));
        __builtin_amdgcn_s_waitcnt(0);
        unsigned nloc = b.st[0], nx = b.st[1];
        if (nloc == 0u) { xcd_barrier_complete(bar, xq, nloc, nx); b.st[0] = nloc; b.st[1] = nx; }
        const unsigned old = xb_add(&bar[XB_XSUB(xq)], 1u);
        const unsigned gen = old / nloc;
        if (old + 1u == (gen + 1u) * nloc) {
            __builtin_amdgcn_fence(__ATOMIC_RELEASE, "agent");
            asm volatile("s_waitcnt vmcnt(0)" ::: "memory");
            const unsigned og = xb_add(&bar[XB_TOP], 1u);
            const unsigned tg = og / nx;
            if (og + 1u == (tg + 1u) * nx) xb_add(&bar[XB_TOPGEN], 1u);
            else XB_SPIN(xb_ld(&bar[XB_TOPGEN]) == tg, bar);
            __builtin_amdgcn_fence(__ATOMIC_ACQUIRE, "agent");
            xb_add(&bar[XB_XGEN(xq)], 1u);
            asm volatile("s_waitcnt vmcnt(0)" ::: "memory");
        } else {
            XB_SPIN(xb_ld(&bar[XB_XGEN(xq)]) == gen, bar);
            __builtin_amdgcn_fence(__ATOMIC_ACQUIRE, "agent");
            asm volatile("s_waitcnt vmcnt(0)" ::: "memory");
        }
    }
    __syncthreads();
}

struct Ptrs {
    const float *x, *ln_emb_g, *ln_emb_b, *w_in, *fox_f_bias, *fox_norm_g, *hlb, *hgrn_norm_g, *w_o, *ln_mix_g, *ln_mix_b, *w_up, *conv_w, *conv_b, *w_down, *ln_ffn_g, *ln_ffn_b;
    float* out; unsigned char* ws;
};

__device__ __forceinline__ void prologue_weights(const Ptrs& P, LAS unsigned char* lds, int gw, int NGW, int wave, int lane, int gtid, int nthr) {
    LAS float* scr = (LAS float*)(lds + wave * 16384);
    bf16* win = (bf16*)(P.ws + WS_WIN); bf16* wo = (bf16*)(P.ws + WS_WO); bf16* wup = (bf16*)(P.ws + WS_WUP); bf16* wdn = (bf16*)(P.ws + WS_WDN);
    constexpr int IT0 = 16 * 48, IT1 = 16 * 64, IT2 = 16 * 32, IT3 = 44 * 16 * 4, IT7 = 44 * 32;
    constexpr int PER_LAYER = IT0 + IT1 + IT2 + IT3 + IT7;
    for (int it = gw; it < 2 * PER_LAYER; it += NGW) {
        const int l = it / PER_LAYER; int r = it % PER_LAYER;
        const float* wi = P.w_in + (size_t)l * 1024 * INC; const float* wu = P.w_up + (size_t)l * 1024 * 2 * DFF;
        bf16* winl = win + (size_t)l * NPROJ * 1024; bf16* wupl = wup + (size_t)l * 2 * DFF * 1024;
        if (r < IT0) { p0_transpose_item(wi, INC, 1024, 1536, winl, 0, scr, r, lane); continue; } r -= IT0;
        if (r < IT1) { p0_transpose_item(wi + 1544, INC, 1024, 2048, winl, 1536, scr, r, lane); continue; } r -= IT1;
        if (r < IT2) { p0_transpose_item(P.w_o + (size_t)l * 1024 * 1024, 1024, 1024, 1024, wo + (size_t)l * 1024 * 1024, 0, scr, r, lane); continue; } r -= IT2;
        if (r < IT3) { const int sgm = r >> 6, ri = r & 63; p0_transpose_item(wu + ((sgm & 1) ? DFF : 0) + (sgm >> 1) * 128, 2 * DFF, 1024, 128, wupl, sgm * 128, scr, ri, lane); continue; } r -= IT3;
        p0_transpose_item(P.w_down + (size_t)l * DFF * 1024, 1024, DFF, 1024, wdn + (size_t)l * 1024 * DFF, 0, scr, r, lane);
    }
    float* wfa = (float*)(P.ws + WS_WFA);
    for (int i = gtid; i < 2 * 8 * 1024; i += nthr) { const int l = i >> 13, j = (i >> 10) & 7, k = i & 1023; wfa[i] = P.w_in[(size_t)l * 1024 * INC + (size_t)k * INC + 1536 + j]; }
}


template <int LN_NR, bool FA, bool ADD> __device__ __forceinline__ void ln_phase(const float* xsrc, const bf16* xsrcb, const bf16* add, float alpha, float* xdst, bf16* XN, const float* g, const float* bta, const float* wfa, int wfa_ld, const float* fbias, float* lfa,
                                         LAS float* wl, int gw, int NGW, int lane, int tid) {
    if (FA && wfa_ld == 0) { for (int i = tid; i < 8 * 1024 / 4; i += NWAVES * 64) ((LAS f32x4*)wl)[i] = ((const f32x4*)wfa)[i]; __syncthreads(); }
    else if (FA) {
        for (int k = tid; k < 1024; k += NWAVES * 64) { const f32x4 a = *(const f32x4*)(wfa + (size_t)k * wfa_ld), b = *(const f32x4*)(wfa + (size_t)k * wfa_ld + 4);
            wl[k] = a.x; wl[1024 + k] = a.y; wl[2048 + k] = a.z; wl[3072 + k] = a.w; wl[4096 + k] = b.x; wl[5120 + k] = b.y; wl[6144 + k] = b.z; wl[7168 + k] = b.w; }
        __syncthreads(); }
    f32x4 gv[4], bv[4];
#pragma unroll
    for (int j = 0; j < 4; ++j) { gv[j] = ((const f32x4*)g)[lane + 64 * j]; bv[j] = ((const f32x4*)bta)[lane + 64 * j]; }
    const float fb = (FA && lane < 8) ? fbias[lane] : 0.f;
#pragma nounroll
    for (int m0 = gw; m0 < M; m0 += LN_NR * NGW) {
        f32x4 v[LN_NR][4]; unsigned long long av[ADD ? LN_NR : 1][4];
#pragma unroll
        for (int r = 0; r < LN_NR; ++r) { const int m = m0 + r * NGW;
            if (xsrc) { const GAS f32x4* xr = (const GAS f32x4*)(xsrc + (size_t)m * D) + lane;
#pragma unroll
                for (int j = 0; j < 4; ++j) v[r][j] = xr[64 * j]; }
            else { const GAS unsigned long long* xr = (const GAS unsigned long long*)(xsrcb + (size_t)m * D) + lane;
#pragma unroll
                for (int j = 0; j < 4; ++j) { const unsigned long long a = xr[64 * j]; const unsigned lo = (unsigned)a, hi = (unsigned)(a >> 32);
                    v[r][j] = (f32x4){__uint_as_float(lo << 16), __uint_as_float(lo & 0xffff0000u), __uint_as_float(hi << 16), __uint_as_float(hi & 0xffff0000u)}; } }
            if (ADD) { const GAS unsigned long long* ar = (const GAS unsigned long long*)(add + (size_t)m * D) + lane;
#pragma unroll
                for (int j = 0; j < 4; ++j) av[r][j] = ar[64 * j]; } }
#pragma unroll
        for (int r = 0; r < LN_NR; ++r) { const int m = m0 + r * NGW; float s = 0.f;
            if (ADD) {
#pragma unroll
                for (int j = 0; j < 4; ++j) { const unsigned lo = (unsigned)av[r][j], hi = (unsigned)(av[r][j] >> 32);
                    v[r][j] = v[r][j] * alpha + (f32x4){__uint_as_float(lo << 16), __uint_as_float(lo & 0xffff0000u), __uint_as_float(hi << 16), __uint_as_float(hi & 0xffff0000u)}; } }
#pragma unroll
            for (int j = 0; j < 4; ++j) s += (v[r][j].x + v[r][j].y) + (v[r][j].z + v[r][j].w);
            const float mean = wave_sum(s) * (1.f / D); float s2 = 0.f;
#pragma unroll
            for (int j = 0; j < 4; ++j) { v[r][j] = v[r][j] - mean; s2 += (v[r][j].x * v[r][j].x + v[r][j].y * v[r][j].y) + (v[r][j].z * v[r][j].z + v[r][j].w * v[r][j].w); }
            const float rstd = 1.f / sqrtf(wave_sum(s2) * (1.f / D) + LN_EPS);
#pragma unroll
            for (int j = 0; j < 4; ++j) v[r][j] = (v[r][j] * rstd) * gv[j] + bv[j];
            if (XN) { GAS unsigned long long* o8 = (GAS unsigned long long*)(XN + (size_t)m * D) + lane;
#pragma unroll
                for (int j = 0; j < 4; ++j) o8[64 * j] = (unsigned long long)pk2(v[r][j].x, v[r][j].y) | ((unsigned long long)pk2(v[r][j].z, v[r][j].w) << 32); }
            if (xdst) { GAS f32x4* o = (GAS f32x4*)(xdst + (size_t)m * D) + lane;
#pragma unroll
                for (int j = 0; j < 4; ++j) o[64 * j] = v[r][j]; }
            if (FA) { float mine = 0.f; const LAS f32x4* wlr = (const LAS f32x4*)wl; asm volatile("" : "+v"(wlr));
#pragma unroll
                for (int h = 0; h < 8; ++h) { float d = 0.f;
#pragma unroll
                    for (int j = 0; j < 4; ++j) { const f32x4 w = wlr[h * 256 + lane + 64 * j]; d += (v[r][j].x * w.x + v[r][j].y * w.y) + (v[r][j].z * w.z + v[r][j].w * w.w); }
                    d = wave_sum(d); if (lane == h) mine = d; }
                if (lane < 8) { const float z = mine + fb; lfa[(size_t)m * 8 + lane] = fminf(z, 0.f) - __logf(1.0f + __expf(-fabsf(z))); } } }
    }
}

__device__ __forceinline__ void cumsum_phase(const float* lfa, float* c2, int b, LAS float* scr, int tid, int wave, int lane) {
    const f32x4* src = (const f32x4*)(lfa + ((size_t)b * SEQ + 16 * tid) * 8);
    float a[16][8];
#pragma unroll
    for (int i = 0; i < 16; ++i) { const f32x4 p = src[2 * i], q = src[2 * i + 1]; a[i][0] = p.x; a[i][1] = p.y; a[i][2] = p.z; a[i][3] = p.w; a[i][4] = q.x; a[i][5] = q.y; a[i][6] = q.z; a[i][7] = q.w; }
#pragma unroll
    for (int i = 1; i < 16; ++i)
#pragma unroll
        for (int h = 0; h < 8; ++h) a[i][h] += a[i - 1][h];
    float off[8];
#pragma unroll
    for (int h = 0; h < 8; ++h) { float t = a[15][h], inc = t;
#pragma unroll
        for (int o = 1; o < 64; o <<= 1) { const float u = __shfl_up(inc, o); if (lane >= o) inc += u; }
        off[h] = inc - t; if (lane == 63) scr[wave * 8 + h] = inc; }
    __syncthreads();
#pragma unroll
    for (int h = 0; h < 8; ++h) { float p = 0.f; for (int w = 0; w < wave; ++w) p += scr[w * 8 + h]; off[h] += p; }
#pragma unroll
    for (int h = 0; h < 8; ++h) { f32x4* dst = (f32x4*)(c2 + ((size_t)(b * 8 + h)) * SEQ + 16 * tid);
#pragma unroll
        for (int i4 = 0; i4 < 4; ++i4) dst[i4] = (f32x4){(a[4 * i4][h] + off[h]) * LOG2E, (a[4 * i4 + 1][h] + off[h]) * LOG2E, (a[4 * i4 + 2][h] + off[h]) * LOG2E, (a[4 * i4 + 3][h] + off[h]) * LOG2E}; }
    __syncthreads();
}

#ifndef THR_EXTRA
#define THR_EXTRA 0.0f
#endif
__device__ __forceinline__ void fox_norms(const bf16* QA, const bf16* KA, unsigned* kmax, unsigned* qmax, int gw, int lane) {
    if (gw >= M / 16) return;
    float kq = 0.f, qq = 0.f;
#pragma unroll 4
    for (int i = 0; i < 16; ++i) { const size_t off = ((size_t)(16 * gw + i)) * 512 + lane * 8;
        const v4u kv = *(const v4u*)(KA + off), qv = *(const v4u*)(QA + off); float sk = 0.f, sq = 0.f;
#pragma unroll
        for (int j = 0; j < 4; ++j) { const float k0 = __uint_as_float(kv[j] << 16), k1 = __uint_as_float(kv[j] & 0xffff0000u), q0 = __uint_as_float(qv[j] << 16), q1 = __uint_as_float(qv[j] & 0xffff0000u); sk += k0 * k0 + k1 * k1; sq += q0 * q0 + q1 * q1; }
        sk += __shfl_xor(sk, 1); sk += __shfl_xor(sk, 2); sk += __shfl_xor(sk, 4); sq += __shfl_xor(sq, 1); sq += __shfl_xor(sq, 2); sq += __shfl_xor(sq, 4);
        kq = fmaxf(kq, sk); qq = fmaxf(qq, sq); }
    if ((lane & 7) == 0) { const int row0 = 16 * gw, b = row0 / SEQ, qb = (row0 % SEQ) / 256, h = lane >> 3;
        atomicMax(kmax + b * 8 + h, __float_as_uint(kq)); atomicMax(qmax + (b * 8 + h) * 32 + qb, __float_as_uint(qq)); }
}
__device__ __forceinline__ void fox_tstart(const float* c2, const unsigned* kmax, const unsigned* qmax, unsigned* tsout, int u) {
    if (u >= 1024) return;
    const int bh = u & 31, qb = u >> 5, q0 = qb * 256;
    const float kn = sqrtf(__uint_as_float(kmax[bh])) * 1.01f, qn = sqrtf(__uint_as_float(qmax[bh * 32 + qb])) * 1.01f;
    const float* cb = c2 + (size_t)bh * SEQ; const float thr = -152.0f - qn * kn - THR_EXTRA;
    const float cq0 = cb[q0];
    int T = q0 / 64 - 1;
    while (T >= 0 && !(cq0 - cb[64 * T + 63] < thr)) --T;
    int ts = (T + 1) & ~1; const int NTabs = q0 / 64 + 4; if (ts > NTabs - 4) ts = NTabs - 4;
    tsout[u] = (unsigned)ts;
}

__device__ __forceinline__ void gate_fixup(const float* halo, const float* cw, const float* cb, bf16* G, int gtid, int nthr) {
    const int ngrp = DFF / 4, nitems = (M / 64) * ngrp;
    for (int item = gtid; item < nitems; item += nthr) {
        const int blk = item / ngrp, ch = (item % ngrp) * 4;
        const float* h0 = halo + (size_t)blk * 4 * 5632 + ch;
        const f32x4 a0 = *(const f32x4*)(h0), u0 = *(const f32x4*)(h0 + 2816), a1 = *(const f32x4*)(h0 + 5632), u1 = *(const f32x4*)(h0 + 5632 + 2816);
        f32x4 pa62 = (f32x4){0.f, 0.f, 0.f, 0.f}, pa63 = pa62, pu62 = pa62, pu63 = pa62;
        if ((blk & 127) != 0) { const float* hp = h0 - 2 * 5632; pa62 = *(const f32x4*)(hp); pu62 = *(const f32x4*)(hp + 2816); pa63 = *(const f32x4*)(hp + 5632); pu63 = *(const f32x4*)(hp + 5632 + 2816); }
        const f32x4 wa0 = *(const f32x4*)(cw + ch), wa1 = *(const f32x4*)(cw + 5632 + ch), wa2 = *(const f32x4*)(cw + 2 * 5632 + ch), ba = *(const f32x4*)(cb + ch);
        const f32x4 wu0 = *(const f32x4*)(cw + 2816 + ch), wu1 = *(const f32x4*)(cw + 5632 + 2816 + ch), wu2 = *(const f32x4*)(cw + 2 * 5632 + 2816 + ch), bu = *(const f32x4*)(cb + 2816 + ch);
        const f32x4 ya0 = wa0 * pa62 + wa1 * pa63 + wa2 * a0 + ba, yu0 = wu0 * pu62 + wu1 * pu63 + wu2 * u0 + bu;
        const f32x4 ya1 = wa0 * pa63 + wa1 * a0 + wa2 * a1 + ba, yu1 = wu0 * pu63 + wu1 * u0 + wu2 * u1 + bu;
        const pg8::f32x2 g00 = pg8::gelu_pk((pg8::f32x2){ya0[0], ya0[1]}), g01 = pg8::gelu_pk((pg8::f32x2){ya0[2], ya0[3]}), g10 = pg8::gelu_pk((pg8::f32x2){ya1[0], ya1[1]}), g11 = pg8::gelu_pk((pg8::f32x2){ya1[2], ya1[3]});
        typedef unsigned u32x2f __attribute__((ext_vector_type(2)));
        *(u32x2f*)(G + (size_t)(blk * 64) * DFF + ch) = (u32x2f){pk2(g00.x * yu0[0], g00.y * yu0[1]), pk2(g01.x * yu0[2], g01.y * yu0[3])};
        *(u32x2f*)(G + (size_t)(blk * 64 + 1) * DFF + ch) = (u32x2f){pk2(g10.x * yu1[0], g10.y * yu1[1]), pk2(g11.x * yu1[2], g11.y * yu1[3])};
    }
}

namespace hg {
constexpr int QT_P = 272, KH_P = 144;
constexpr int O_QT = 0, O_KT = O_QT + 64 * QT_P, O_KH = O_KT + 64 * QT_P, O_VT = O_KH + 128 * KH_P, O_PB = O_VT + 128 * KH_P, O_BT = O_PB + 64 * KH_P, O_RS = O_BT + 2048, O_END = O_RS + 4096;
static_assert(O_END <= RING_BYTES, "hgrn lds");
constexpr int NITEMS = 16 * 128;
#define MFMA16(a, b, c) __builtin_amdgcn_mfma_f32_16x16x32_bf16((a), (b), (c), 0, 0, 0)
typedef float f32x2_t __attribute__((ext_vector_type(2))); typedef __bf16 bf16x2_t __attribute__((ext_vector_type(2)));
__device__ __forceinline__ unsigned cvtpk(float lo, float hi) { f32x2_t v = {lo, hi}; bf16x2_t b = __builtin_convertvector(v, bf16x2_t); return __builtin_bit_cast(unsigned, b); }
__device__ __forceinline__ void hgrn_prep(int first, int stride, bf16* QR, float* LF, const bf16* IR, const bf16* GR, bf16* U, bf16* QS, bf16* OI, float* DLg, LAS unsigned char* lds) {
    int tid_ = threadIdx.x; asm volatile("" : "+v"(tid_)); const int tid = tid_, lane = tid & 63, w = __builtin_amdgcn_readfirstlane(tid >> 6), n16 = lane & 15, g = lane >> 4;
    const int col = tid & 127, tq = tid >> 7;
    LAS unsigned char* QT = lds + O_QT; LAS unsigned char* KT = lds + O_KT; LAS unsigned char* KH = lds + O_KH; LAS unsigned char* VT = lds + O_VT; LAS unsigned char* PB = lds + O_PB;
    LAS float* BT = (LAS float*)(lds + O_BT);
    const int r32 = col & 31, qpos = (col & ~31) + ((r32 < 16) ? (8 * (r32 >> 2) + (r32 & 3)) : (8 * ((r32 - 16) >> 2) + 4 + (r32 & 3)));
    if (first >= NITEMS) return;
    float lf[16]; unsigned short qv[16], vv[16];
    { const int bh = first >> 7, c = first & 127; const size_t base = ((size_t)(bh >> 2) * SEQ + 64 * c + 16 * tq) * 512 + (bh & 3) * 128 + col;
#pragma unroll
      for (int i = 0; i < 16; ++i) { lf[i] = LF[base + (size_t)i * 512]; qv[i] = QR[base + (size_t)i * 512]; vv[i] = IR[base + (size_t)i * 512]; } }
    for (int it = first; it < NITEMS; it += stride) {
        float bl[16]; bl[0] = lf[0];
#pragma unroll
        for (int i = 1; i < 16; ++i) bl[i] = bl[i - 1] + lf[i];
        BT[tq * 128 + col] = bl[15];
        __syncthreads();
        const float t0 = BT[col], t1 = BT[128 + col], t2 = BT[256 + col], t3 = BT[384 + col];
        const float off = (tq == 0) ? 0.f : (tq == 1) ? t0 : (tq == 2) ? (t0 + t1) : (t0 + t1 + t2);
        const float bref = t0 + t1, blast = (t0 + t1) + (t2 + t3);
        unsigned khp[8], vtp[8];
        bf16* qsrow = QS + (size_t)it * 8192 + (size_t)(16 * tq) * 128 + qpos;
#pragma unroll
        for (int i = 0; i < 16; i += 2) {
            const float bb0 = bl[i] + off, bb1 = bl[i + 1] + off, k0 = 1.0f - __expf(lf[i]), k1 = 1.0f - __expf(lf[i + 1]), q0 = bf2f(qv[i]), q1 = bf2f(qv[i + 1]);
            const unsigned qs = cvtpk(q0 * __expf(fminf(bb0 - bref, 80.f)), q1 * __expf(fminf(bb1 - bref, 80.f)));
            const unsigned ks = cvtpk(k0 * __expf(fminf(bref - bb0, 80.f)), k1 * __expf(fminf(bref - bb1, 80.f)));
            const unsigned qa = cvtpk(q0 * __expf(bb0), q1 * __expf(bb1));
            khp[i >> 1] = cvtpk(k0 * __expf(blast - bb0), k1 * __expf(blast - bb1));
            vtp[i >> 1] = (unsigned)vv[i] | ((unsigned)vv[i + 1] << 16);
            *(LAS unsigned short*)(QT + (16 * tq + i) * QT_P + col * 2) = (unsigned short)qs; *(LAS unsigned short*)(QT + (16 * tq + i + 1) * QT_P + col * 2) = (unsigned short)(qs >> 16);
            *(LAS unsigned short*)(KT + (16 * tq + i) * QT_P + col * 2) = (unsigned short)ks; *(LAS unsigned short*)(KT + (16 * tq + i + 1) * QT_P + col * 2) = (unsigned short)(ks >> 16);
            qsrow[(size_t)i * 128] = (unsigned short)qa; qsrow[(size_t)(i + 1) * 128] = (unsigned short)(qa >> 16);
        }
        *(LAS v4u*)(KH + col * KH_P + 32 * tq) = (v4u){khp[0], khp[1], khp[2], khp[3]}; *(LAS v4u*)(KH + col * KH_P + 32 * tq + 16) = (v4u){khp[4], khp[5], khp[6], khp[7]};
        *(LAS v4u*)(VT + col * KH_P + 32 * tq) = (v4u){vtp[0], vtp[1], vtp[2], vtp[3]}; *(LAS v4u*)(VT + col * KH_P + 32 * tq + 16) = (v4u){vtp[4], vtp[5], vtp[6], vtp[7]};
        if (tq == 0) DLg[(size_t)it * 128 + col] = __expf(blast);
        if (it + stride < NITEMS) { const int nx = it + stride, bh = nx >> 7, c = nx & 127; const size_t base = ((size_t)(bh >> 2) * SEQ + 64 * c + 16 * tq) * 512 + (bh & 3) * 128 + col;
#pragma unroll
            for (int i = 0; i < 16; ++i) { lf[i] = LF[base + (size_t)i * 512]; qv[i] = QR[base + (size_t)i * 512]; vv[i] = IR[base + (size_t)i * 512]; } }
        __syncthreads();
        { const int tb = w >> 1;
#pragma unroll
          for (int jj = 0; jj < 2; ++jj) { const int sb = 2 * (w & 1) + jj; f32x4 p = (f32x4){0.f, 0.f, 0.f, 0.f};
              if (sb <= tb) {
#pragma unroll
                  for (int kk = 0; kk < 4; ++kk) { const bf16x8 A = *(const LAS bf16x8*)(QT + (16 * tb + n16) * QT_P + (32 * kk + 8 * g) * 2), B = *(const LAS bf16x8*)(KT + (16 * sb + n16) * QT_P + (32 * kk + 8 * g) * 2); p = MFMA16(A, B, p); }
                  if (sb == tb) {
#pragma unroll
                      for (int i = 0; i < 4; ++i) if (n16 > 4 * g + i) p[i] = 0.f; } }
#pragma unroll
              for (int i = 0; i < 4; ++i) *(LAS unsigned short*)(PB + (16 * tb + 4 * g + i) * KH_P + (16 * sb + n16) * 2) = (unsigned short)f2bf(p[i]); } }
        __syncthreads();
        bf16x8 vB[2];
#pragma unroll
        for (int kk = 0; kk < 2; ++kk) vB[kk] = *(const LAS bf16x8*)(VT + (16 * w + n16) * KH_P + (32 * kk + 8 * g) * 2);
#pragma unroll
        for (int mt = 0; mt < 4; ++mt) { f32x4 acc = (f32x4){0.f, 0.f, 0.f, 0.f};
#pragma unroll
            for (int kk = 0; kk < 2; ++kk) { const bf16x8 A = *(const LAS bf16x8*)(PB + (16 * mt + n16) * KH_P + (32 * kk + 8 * g) * 2); acc = MFMA16(A, vB[kk], acc); }
            *(unsigned long long*)(OI + (((size_t)it * 8 + w) * 4 + mt) * 256 + lane * 4) = (unsigned long long)cvtpk(acc[0], acc[1]) | ((unsigned long long)cvtpk(acc[2], acc[3]) << 32); }
#pragma unroll
        for (int j = 0; j < 8; ++j) { f32x4 acc = (f32x4){0.f, 0.f, 0.f, 0.f};
#pragma unroll
            for (int kk = 0; kk < 2; ++kk) { const bf16x8 A = *(const LAS bf16x8*)(KH + (16 * j + n16) * KH_P + (32 * kk + 8 * g) * 2); acc = MFMA16(A, vB[kk], acc); }
            { const int bh_ = it >> 7; const size_t T0_ = (size_t)(bh_ >> 2) * SEQ + 64 * (it & 127);
              *(unsigned long long*)((bf16*)(LF + (T0_ + 8 * w + j) * 512 + (bh_ & 3) * 128) + lane * 4) = (unsigned long long)cvtpk(acc[0], acc[1]) | ((unsigned long long)cvtpk(acc[2], acc[3]) << 32); } }
    }
    __syncthreads();
}
typedef unsigned u32x2 __attribute__((ext_vector_type(2)));
__device__ __forceinline__ f32x4 up4(u32x2 v) { return (f32x4){__uint_as_float(v.x << 16), __uint_as_float(v.x & 0xffff0000u), __uint_as_float(v.y << 16), __uint_as_float(v.y & 0xffff0000u)}; }
__device__ __forceinline__ void hgrn_scan(int task, float* LF, const float* DLg, int lane) {
    if (task >= 16 * 64) return;
    const int bh = task >> 6, wj = task & 63, g = lane >> 4;
    bf16* up = (bf16*)(LF + ((size_t)(bh >> 2) * SEQ + wj) * 512 + (bh & 3) * 128) + lane * 4;
    const float* dlp = DLg + (size_t)bh * 128 * 128 + 16 * (wj & 7) + 4 * g;
    f32x4 S = (f32x4){0.f, 0.f, 0.f, 0.f};
    u32x2 ub[8]; f32x4 db[8];
#pragma unroll
    for (int k = 0; k < 8; ++k) { ub[k] = *(const u32x2*)(up + (size_t)k * 65536); db[k] = *(const f32x4*)(dlp + (size_t)k * 128); }
#pragma nounroll
    for (int c0 = 0; c0 < SEQ / 64; c0 += 8) {
        u32x2 un[8]; f32x4 dn[8];
        if (c0 + 8 < SEQ / 64) {
#pragma unroll
            for (int k = 0; k < 8; ++k) { un[k] = *(const u32x2*)(up + (size_t)(c0 + 8 + k) * 65536); dn[k] = *(const f32x4*)(dlp + (size_t)(c0 + 8 + k) * 128); } }
        else {
#pragma unroll
            for (int k = 0; k < 8; ++k) { un[k] = (u32x2){0u, 0u}; dn[k] = (f32x4){0.f, 0.f, 0.f, 0.f}; } }
#pragma unroll
        for (int k = 0; k < 8; ++k) { *(u32x2*)(up + (size_t)(c0 + k) * 65536) = (u32x2){cvtpk(S[0], S[1]), cvtpk(S[2], S[3])}; S = S * db[k] + up4(ub[k]); }
#pragma unroll
        for (int k = 0; k < 8; ++k) { ub[k] = un[k]; db[k] = dn[k]; }
    }
}
struct OutSet { v4u qc[2], gc[2]; u32x2 oif[4], sp[8]; };
__device__ __forceinline__ void hgrn_out_phase(int first, int stride, const float* LF, const bf16* QS, const bf16* OI, const bf16* GQ, const float* gnorm, bf16* MIX, LAS unsigned char* lds) {
    int tid_ = threadIdx.x; asm volatile("" : "+v"(tid_)); const int tid = tid_, lane = tid & 63, w = __builtin_amdgcn_readfirstlane(tid >> 6), n16 = lane & 15, g = lane >> 4;
    if (first >= NITEMS) return;
    constexpr int TP = 272, TILE = 64 * TP;
    LAS unsigned char* QTL = lds;
    LAS unsigned char* GTL = lds + 2 * TILE;
    LAS unsigned char* OT = lds + 4 * TILE;
    LAS float* RS = (LAS float*)(lds + 5 * TILE + 1024);
    const int cr0 = tid >> 4, cc = (tid & 15) * 8;
#define HO_LOAD(S, IT) do { const int bh_ = (IT) >> 7, hc_ = (bh_ & 3) * 128; const size_t T0_ = (size_t)(bh_ >> 2) * SEQ + 64 * ((IT) & 127); \
      S.qc[0] = *(const v4u*)(QS + (size_t)(IT) * 8192 + cr0 * 128 + cc); S.qc[1] = *(const v4u*)(QS + (size_t)(IT) * 8192 + (cr0 + 32) * 128 + cc); \
      S.gc[0] = *(const v4u*)(GQ + (T0_ + cr0) * 512 + hc_ + cc); S.gc[1] = *(const v4u*)(GQ + (T0_ + cr0 + 32) * 512 + hc_ + cc); \
      _Pragma("unroll") for (int mt = 0; mt < 4; ++mt) S.oif[mt] = *(const u32x2*)(OI + (((size_t)(IT) * 8 + w) * 4 + mt) * 256 + lane * 4); \
      _Pragma("unroll") for (int j = 0; j < 8; ++j) S.sp[j] = *(const u32x2*)((const bf16*)(LF + (T0_ + 8 * w + j) * 512 + hc_) + lane * 4); } while (0)
#define HO_STAGE(S, P) do { *(LAS v4u*)(QTL + (P) * TILE + cr0 * TP + cc * 2) = S.qc[0]; *(LAS v4u*)(QTL + (P) * TILE + (cr0 + 32) * TP + cc * 2) = S.qc[1]; \
      *(LAS v4u*)(GTL + (P) * TILE + cr0 * TP + cc * 2) = S.gc[0]; *(LAS v4u*)(GTL + (P) * TILE + (cr0 + 32) * TP + cc * 2) = S.gc[1]; } while (0)
#define HO_BAR() asm volatile("s_waitcnt lgkmcnt(0)\n\ts_barrier" ::: "memory")
#define HO_ITER(CUR, NXT, P, IT) do { \
      const int bh = (IT) >> 7, hc = (bh & 3) * 128; const size_t T0 = (size_t)(bh >> 2) * SEQ + 64 * ((IT) & 127); \
      const float gn = gnorm[hc + 16 * w + n16]; \
      const LAS unsigned char* qt = QTL + (P) * TILE; const LAS unsigned char* gt = GTL + (P) * TILE; LAS float* RSc = RS + (P) * 512; \
      f32x4 o[4]; \
      _Pragma("unroll") for (int mt = 0; mt < 4; ++mt) { f32x4 acc = up4(CUR.oif[mt]); \
          _Pragma("unroll") for (int kk = 0; kk < 4; ++kk) acc = MFMA16(*(const LAS bf16x8*)(qt + (16 * mt + n16) * TP + (32 * kk + 8 * g) * 2), \
                                   __builtin_bit_cast(bf16x8, (v4u){CUR.sp[2 * kk].x, CUR.sp[2 * kk].y, CUR.sp[2 * kk + 1].x, CUR.sp[2 * kk + 1].y}), acc); \
          o[mt] = acc; } \
      _Pragma("unroll") for (int mt = 0; mt < 4; ++mt) { f32x4 q = o[mt] * o[mt]; \
          _Pragma("unroll") for (int sh = 1; sh < 16; sh <<= 1) { q[0] += __shfl_xor(q[0], sh); q[1] += __shfl_xor(q[1], sh); q[2] += __shfl_xor(q[2], sh); q[3] += __shfl_xor(q[3], sh); } \
          if (n16 == 0) *(LAS f32x4*)(RSc + w * 64 + 16 * mt + 4 * g) = q; } \
      HO_BAR();                                                              \
      _Pragma("unroll") for (int mt = 0; mt < 4; ++mt) { f32x4 tot = (f32x4){0.f, 0.f, 0.f, 0.f}; \
          _Pragma("unroll") for (int ww = 0; ww < 8; ++ww) tot += *(const LAS f32x4*)(RSc + ww * 64 + 16 * mt + 4 * g); \
          _Pragma("unroll") for (int i = 0; i < 4; ++i) { const int t = 16 * mt + 4 * g + i, e = 16 * w + n16; const float r = __builtin_amdgcn_rsqf(tot[i] * (1.f / 128.f) + RMS_EPS); \
              const float gate = bf2f(*(const LAS unsigned short*)(gt + t * TP + e * 2)); \
              *(LAS unsigned short*)(OT + t * TP + e * 2) = (unsigned short)f2bf(o[mt][i] * r * gn * gate); } } \
      if ((IT) + stride < NITEMS) HO_STAGE(NXT, (P) ^ 1);                    \
      HO_BAR();                                                              \
      { const v4u o0 = *(const LAS v4u*)(OT + cr0 * TP + cc * 2), o1 = *(const LAS v4u*)(OT + (cr0 + 32) * TP + cc * 2); \
        *(v4u*)(MIX + (T0 + cr0) * 1024 + 512 + hc + cc) = o0; *(v4u*)(MIX + (T0 + cr0 + 32) * 1024 + 512 + hc + cc) = o1; } \
      if ((IT) + 2 * stride < NITEMS) HO_LOAD(CUR, (IT) + 2 * stride); } while (0)
    OutSet A, B;
    HO_LOAD(A, first);
    if (first + stride < NITEMS) HO_LOAD(B, first + stride); else B = A;
    HO_STAGE(A, 0);
    HO_BAR();
    for (int it = first; it < NITEMS; it += 2 * stride) {
        HO_ITER(A, B, 0, it);
        if (it + stride < NITEMS) HO_ITER(B, A, 1, it + stride);
    }
    __syncthreads();
#undef HO_LOAD
#undef HO_STAGE
#undef HO_BAR
#undef HO_ITER
}
}
namespace cg = cooperative_groups;
#ifndef PHM
#define PHM 0xffff
#endif
#define PH(b) if constexpr ((PHM >> (b)) & 1)
#ifndef DUPP
#define DUPP 0
#endif
#define GSYNC() do { xcd_barrier(xbar); if (DUPP == 9) xcd_barrier(xbar); } while (0)
#ifndef PG8_SP2_
#define PG8_SP2_ true
#endif
#ifndef PG8_ALIGN_UP
#define PG8_ALIGN_UP true
#endif
#ifndef PG8_ALIGN_
#define PG8_ALIGN_ true
#endif
#ifndef CIDX
#define CIDX bx
#endif
#define REP(k) for (int rep_ = 0; rep_ < ((DUPP == (k)) ? 2 : 1); ++rep_)
struct Args { Ptrs p; };
#define FRESH_IDS() int tid = threadIdx.x; asm volatile("" : "+v"(tid)); const int lane = tid & 63, wave = __builtin_amdgcn_readfirstlane(tid >> 6); const int gw = bx * NWAVES + wave, gtid = bx * (NWAVES * 64) + tid; (void)lane; (void)gw; (void)gtid;
__global__ void __launch_bounds__(NWAVES * 64, 2) fwd_megakernel(Args args) {
    extern __shared__ __attribute__((aligned(16))) unsigned char lds_raw[];
    cg::grid_group grid = cg::this_grid();
    const Ptrs& P = args.p;
    LAS unsigned char* lds = (LAS unsigned char*)lds_raw;
    volatile LAS int* MISC = (volatile LAS int*)(lds + MISC_OFF);
    const int G = gridDim.x, bx = blockIdx.x;
    const int NGW = G * NWAVES, nthr = G * NWAVES * 64;
    unsigned char* ws = P.ws;
    unsigned* ctl = (unsigned*)(ws + WS_CTL);
    if (threadIdx.x < 32) ((LAS unsigned*)(lds + MISC_OFF))[threadIdx.x] = 0u;
    __syncthreads();
    const XcdBarrier xbar = xcd_barrier_post(ctl + CW_BAR, (volatile LAS unsigned*)(lds + MISC_OFF) + 8);
    float* c2 = (float*)(ws + WS_C2); float* lfa = (float*)(ws + WS_LFA); const float* wfa = (const float*)(ws + WS_WFA);
    bf16* XN = (bf16*)(ws + WS_XN); bf16* slot0 = (bf16*)(ws + WS_SLOT0); bf16* MIX = (bf16*)(ws + WS_MIX); bf16* GB = (bf16*)(ws + WS_G); bf16* SUB = (bf16*)(ws + WS_SUB);

    REP(5) PH(0) { FRESH_IDS(); prologue_weights(P, lds, gw, NGW, wave, lane, gtid, nthr); }
    __syncthreads();
    PH(1) { FRESH_IDS(); ln_phase<4, true, false>(P.x, nullptr, nullptr, 1.f, nullptr, XN, P.ln_emb_g, P.ln_emb_b, P.w_in + 1536, INC, P.fox_f_bias, lfa, (LAS float*)lds, gw, NGW, lane, tid); }
    grid.sync();

#pragma nounroll
    for (int l = 0; l < 2; ++l) {
        PH(2) if (bx < BATCH) { FRESH_IDS(); cumsum_phase(lfa, c2, bx, (LAS float*)lds, tid, wave, lane); }
        REP(1) { if (rep_) GSYNC();
        PH(3) { pg8::Gemm g{XN, (const bf16*)(ws + WS_WIN) + (size_t)l * NPROJ * 1024, M, NPROJ, D}; pg8::StaticOrder S; S.init(M, NPROJ, G, CIDX);
          pg8::EpiProj E{slot0, P.hlb, l, attn_body::C2};
          pg8::gemm_phase<pg8::EpiProj, pg8::StaticOrder, PG8_ALIGN_, PG8_SP2_>(lds, g, S, E); } }
        GSYNC();
        PH(5) { FRESH_IDS(); fox_norms(slot0, slot0 + pg8::SLOT_ELEMS, ctl + CW_KMAX + 32 * l, ctl + CW_QMAX + 1024 * l, gw, lane); }
        REP(4) { if (rep_) GSYNC();
        PH(4) hg::hgrn_prep(bx, G, slot0 + 3 * pg8::SLOT_ELEMS, (float*)(slot0 + 4 * pg8::SLOT_ELEMS), slot0 + 6 * pg8::SLOT_ELEMS, slot0 + 7 * pg8::SLOT_ELEMS, nullptr, (bf16*)(ws + WS_HQS), (bf16*)(ws + WS_HOI), (float*)(ws + WS_HDL), lds); }
        GSYNC();
        PH(4) { FRESH_IDS(); hg::hgrn_scan(gw, (float*)(slot0 + 4 * pg8::SLOT_ELEMS), (const float*)(ws + WS_HDL), lane);
                if (gw >= 1024) fox_tstart(c2, ctl + CW_KMAX + 32 * l, ctl + CW_QMAX + 1024 * l, ctl + CW_TS + 1024 * l, gtid - 1024 * 64); }
        GSYNC();
#ifndef DUP_MIX
#define DUP_MIX 0
#endif
        for (int rep = 0; rep < (DUP_MIX ? 2 : 1); ++rep) { unsigned* ctr = ctl + 64 * (l + 2 * rep); const bool do_h = (rep == 0) || (DUP_MIX & 1), do_a = (rep == 0) || (DUP_MIX & 2);
          const bf16* QA = slot0; const bf16* KA = slot0 + pg8::SLOT_ELEMS; const bf16* VA = slot0 + 2 * pg8::SLOT_ELEMS;
          int nxt_it = 0, nxt_ts = 0; if (threadIdx.x == 0) { nxt_it = (int)atomicAdd(ctr, 1u); nxt_ts = (nxt_it < 1024) ? (int)ctl[CW_TS + 1024 * l + (nxt_it & 31) + 32 * (31 - (nxt_it >> 5))] : 0; }
          for (;;) {
              FRESH_IDS();
              if (tid == 0) { MISC[16] = nxt_it; MISC[17] = nxt_ts; }
              __syncthreads();
              const int it = MISC[16], its = MISC[17];
              __syncthreads();
              if (it >= 1024) break;
              if (tid == 0) { nxt_it = (int)atomicAdd(ctr, 1u); nxt_ts = (nxt_it < 1024) ? (int)ctl[CW_TS + 1024 * l + (nxt_it & 31) + 32 * (31 - (nxt_it >> 5))] : 0; }
              PH(5) if (do_a) { const int idx = it, qb = 31 - (idx >> 5), bh = idx & 31;
                     attn_body::attn_unit<60>(bh >> 3, bh & 7, qb, (const attn_body::bf16*)QA, (const attn_body::bf16*)KA, (const attn_body::bf16*)VA, (attn_body::bf16*)MIX, c2, P.fox_norm_g + l * 512, (int)__builtin_amdgcn_readfirstlane(its), (char*)lds_raw); }
          }
          PH(4) if (do_h) hg::hgrn_out_phase(bx, G, (const float*)(slot0 + 4 * pg8::SLOT_ELEMS), (const bf16*)(ws + WS_HQS), (const bf16*)(ws + WS_HOI), slot0 + 7 * pg8::SLOT_ELEMS, P.hgrn_norm_g + l * 512, MIX, lds);
          if (DUP_MIX && rep == 0) GSYNC(); }
        GSYNC();
        REP(6) { if (rep_) GSYNC();
        PH(6) { pg8::Gemm g{MIX, (const bf16*)(ws + WS_WO) + (size_t)l * 1024 * 1024, M, D, D}; pg8::StaticOrder S; S.init(M, D, G, CIDX);
          pg8::EpiBf16<0> E{SUB, D, nullptr, 0, 0, 1.f};
          pg8::gemm_phase<pg8::EpiBf16<0>, pg8::StaticOrder, PG8_ALIGN_, PG8_SP2_>(lds, g, S, E); } }
        GSYNC();
        REP(3) { if (rep_) GSYNC();
        PH(1) { FRESH_IDS(); ln_phase<4, false, true>(nullptr, XN, SUB, DN_ALPHA, nullptr, (DUPP == 3 && rep_ == 0) ? (bf16*)(ws + 200 * MiB) : XN, P.ln_mix_g + l * D, P.ln_mix_b + l * D, nullptr, 0, nullptr, nullptr, (LAS float*)lds, gw, NGW, lane, tid); } }
        GSYNC();
        REP(2) { if (rep_) GSYNC();
        PH(7) { pg8::Gemm g{XN, (const bf16*)(ws + WS_WUP) + (size_t)l * 2 * DFF * 1024, M, 2 * DFF, D}; pg8::StaticOrder S; S.init(M, 2 * DFF, G, CIDX);
          pg8::EpiGate E{GB, (float*)(ws + WS_HALO), P.conv_w + (size_t)l * 3 * 2 * DFF, P.conv_b + (size_t)l * 2 * DFF};
          pg8::gemm_phase<pg8::EpiGate, pg8::StaticOrder, PG8_ALIGN_UP, PG8_SP2_>(lds, g, S, E); } }
        GSYNC();
        REP(8) { if (rep_) GSYNC();
        PH(8) { FRESH_IDS(); gate_fixup((const float*)(ws + WS_HALO), P.conv_w + (size_t)l * 3 * 2 * DFF, P.conv_b + (size_t)l * 2 * DFF, GB, gtid, nthr); } }
        GSYNC();
        REP(7) { if (rep_) GSYNC();
        PH(6) { pg8::Gemm g{GB, (const bf16*)(ws + WS_WDN) + (size_t)l * 1024 * DFF, M, D, DFF}; pg8::StaticOrder S; S.init(M, D, G, CIDX);
          pg8::EpiBf16<0> E{SUB, D, nullptr, 0, 0, 1.f};
          pg8::gemm_phase<pg8::EpiBf16<0>, pg8::StaticOrder, PG8_ALIGN_, PG8_SP2_>(lds, g, S, E); } }
        GSYNC();
        if (l == 0) { PH(1) { FRESH_IDS(); ln_phase<4, true, true>(nullptr, XN, SUB, DN_ALPHA, nullptr, XN, P.ln_ffn_g, P.ln_ffn_b, wfa + 8 * 1024, 0, P.fox_f_bias + 8, lfa, (LAS float*)lds, gw, NGW, lane, tid); } GSYNC(); }
        else PH(1) { FRESH_IDS(); ln_phase<4, false, true>(nullptr, XN, SUB, DN_ALPHA, P.out, nullptr, P.ln_ffn_g + D, P.ln_ffn_b + D, nullptr, 0, nullptr, nullptr, (LAS float*)lds, gw, NGW, lane, tid); }
    }
}

extern "C" void kernel_launch(void* const* d_in, const int* in_sizes, int n_in, void* d_out, int out_size, void* d_ws, size_t ws_size, hipStream_t stream) {
    static int grid = 0;
    if (grid == 0) {
        if (n_in != 17 || in_sizes[0] != M * D || out_size != M * D || ws_size < WS_END) { fprintf(stderr, "kernel_launch: unexpected shapes: n_in %d in0 %d out %d ws %zu\n", n_in, n_in > 0 ? in_sizes[0] : -1, out_size, ws_size); grid = -1; return; }
        int dev = 0, cus = 0, per_cu = 0;
        if (hipGetDevice(&dev) != hipSuccess || hipDeviceGetAttribute(&cus, hipDeviceAttributeMultiprocessorCount, dev) != hipSuccess) { fprintf(stderr, "kernel_launch: device query failed\n"); grid = -1; return; }
        if (hipFuncSetAttribute((const void*)fwd_megakernel, hipFuncAttributeMaxDynamicSharedMemorySize, LDS_BYTES) != hipSuccess) { fprintf(stderr, "kernel_launch: hipFuncSetAttribute failed\n"); grid = -1; return; }
        if (hipOccupancyMaxActiveBlocksPerMultiprocessor(&per_cu, (const void*)fwd_megakernel, NWAVES * 64, LDS_BYTES) != hipSuccess || per_cu < 1) { fprintf(stderr, "kernel_launch: occupancy query says %d blocks/CU\n", per_cu); per_cu = 1; }
        (void)hipGetLastError();
        if (cus < 256) { fprintf(stderr, "kernel_launch: this kernel's phase maps need 256 co-resident workgroups (one per CU); the device has %d CUs\n", cus); grid = -1; return; }
        grid = 256;
    }
    if (grid < 0) return;
    (void)hipMemsetAsync((char*)d_ws + WS_CTL, 0, CTL_ZERO_BYTES, stream);
    Args a{};
    const float** pp = (const float**)&a.p;
    for (int i = 0; i < 17; ++i) pp[i] = (const float*)d_in[i];
    a.p.out = (float*)d_out; a.p.ws = (unsigned char*)d_ws;
    void* kargs[] = {&a};
    const hipError_t e = hipLaunchCooperativeKernel((const void*)fwd_megakernel, dim3(grid), dim3(NWAVES * 64), kargs, LDS_BYTES, stream);
    if (e != hipSuccess) fprintf(stderr, "kernel_launch: cooperative launch failed: %s (grid %d)\n", hipGetErrorString(e), grid);
}
```

```cpp
#include <hip/hip_runtime.h>
#include <hip/hip_cooperative_groups.h>
#include <hip/hip_bf16.h>
#include <cstdio>
#include <cstdint>
#include <cmath>
namespace pg8 {
#define PG8_LAS __attribute__((address_space(3)))
typedef unsigned short bf16_t;
typedef short bf16x8 __attribute__((ext_vector_type(8)));
typedef float f32x4 __attribute__((ext_vector_type(4)));
typedef unsigned u32x4 __attribute__((ext_vector_type(4)));
constexpr int BM = 256, BK = 64, HALF = 128, HTB = HALF * BK * 2  , STAGE_BYTES = 8 * HTB, NXCD = 8, WGM = 4;

__host__ __device__ __forceinline__ int lds_byte(int r, int c) { const int st = (r >> 4) * 2 + (c >> 5), rr = r & 15, cc = c & 31, ob = rr * 64 + cc * 2; return st * 1024 + (ob ^ (((ob >> 9) & 1) << 5)); }
__host__ __device__ __forceinline__ void stage_rc(int b, int& R, int& C) { const int st = b / 1024, sb = b % 1024, swz = sb ^ (((sb >> 9) & 1) << 5); R = (st >> 1) * 16 + swz / 64; C = (st & 1) * 32 + (swz % 64) / 2; }
__host__ __device__ __forceinline__ int perm32(int rho) { const int n = rho >> 4, i = rho & 15; return 8 * (i >> 2) + 4 * n + (i & 3); }

struct Unit { int pm, pn; };
struct Gemm { const bf16_t* A; const bf16_t* Bt; int M, N, K; };

struct StaticOrder {
    int nM, nN, nwg, G, c;
    __host__ __device__ void init(int M, int N, int G_, int c_) { nM = M / BM; nN = N / BM; nwg = nM * nN; G = G_; c = c_; }
    __host__ __device__ bool next(int i, Unit& u) const {
        const long L = (long)i * G + c; if (L >= nwg) return false;
        int wgid = (int)L; { const int q = nwg / NXCD, r = nwg % NXCD, xcd = wgid % NXCD, off = wgid / NXCD; wgid = (xcd < r ? xcd * (q + 1) : r * (q + 1) + (xcd - r) * q) + off; }
        const int nig = WGM * nN, gid = wgid / nig, fm = gid * WGM, gsz = (nM - fm) < WGM ? (nM - fm) : WGM;
        u.pm = fm + ((wgid % nig) % gsz); u.pn = (wgid % nig) / gsz; return true;
    }
    __device__ __forceinline__ void a_ready(const Unit&) const {}
    __device__ __forceinline__ void done(const Unit&) const {}
};

typedef float f32x2c __attribute__((ext_vector_type(2))); typedef __bf16 bf16x2c __attribute__((ext_vector_type(2)));
__device__ __forceinline__ unsigned cvt_pk_bf16(float lo, float hi) { f32x2c v = {lo, hi}; bf16x2c b = __builtin_convertvector(v, bf16x2c); return __builtin_bit_cast(unsigned, b); }
typedef float f32x2 __attribute__((ext_vector_type(2)));
__device__ __forceinline__ f32x2 gelu_pk(f32x2 v) {
    const f32x2 av = __builtin_elementwise_abs(v), d = av * 0.2316418882f + 1.0f;
    f32x2 t; t.x = __builtin_amdgcn_rcpf(d.x); t.y = __builtin_amdgcn_rcpf(d.y);
    f32x2 q = t * 0.5307027145f + (-0.7265760135f); q = q * t + 0.7107068705f; q = q * t + (-0.142248368f); q = q * t + 0.127414796f; q = q * t;
    const f32x2 s = (v * v) * (-0.72134752044f);
    f32x2 e; e.x = __builtin_amdgcn_exp2f(s.x); e.y = __builtin_amdgcn_exp2f(s.y);
    f32x2 p; p.x = fmaxf(v.x, 0.f); p.y = fmaxf(v.y, 0.f);
    return p - av * (q * e);
}

template <int ACT  > struct EpiBf16 {
    static constexpr bool PERM = true, AFTER_DRAIN = false; static_assert(ACT == 0 || ACT == 1, "EpiBf16: ACT is 0 (none) or 1 (gelu_pk)");
    bf16_t* O; int ldc; const float* bias; int split_cols; size_t split_stride; float scale0;
    __device__ __forceinline__ void operator()(const f32x4 (&acc)[2][2][4][2], const Unit& u, int wr, int wc, int fr, int fq) const {
        const int row0 = u.pm * BM + wr * 64 + fr; int colt = u.pn * BM; bf16_t* base = O;
        float sc = 1.f; if (split_cols) { const int t = colt / split_cols; base += (size_t)t * split_stride; colt -= t * split_cols; if (t == 0) sc = scale0; }
        const int col0 = colt + wc * 32 + 8 * fq, bcol0 = u.pn * BM + wc * 32 + 8 * fq;
        f32x4 bv[2][2];
#pragma unroll
        for (int bj = 0; bj < 2; ++bj)
#pragma unroll
            for (int n = 0; n < 2; ++n) bv[bj][n] = bias ? *(const f32x4*)(bias + bcol0 + bj * HALF + 4 * n) : (f32x4){0.f, 0.f, 0.f, 0.f};
#pragma unroll
        for (int ai = 0; ai < 2; ++ai)
#pragma unroll
            for (int m = 0; m < 4; ++m) { bf16_t* rowp = base + (size_t)(row0 + ai * HALF + m * 16) * ldc + col0;
#pragma unroll
                for (int bj = 0; bj < 2; ++bj) { f32x4 v0 = acc[ai][bj][m][0] + bv[bj][0], v1 = acc[ai][bj][m][1] + bv[bj][1];
                    if (ACT == 1) { f32x2 a = gelu_pk((f32x2){v0[0], v0[1]}), b = gelu_pk((f32x2){v0[2], v0[3]}), c = gelu_pk((f32x2){v1[0], v1[1]}), d = gelu_pk((f32x2){v1[2], v1[3]});
                        v0 = (f32x4){a.x, a.y, b.x, b.y}; v1 = (f32x4){c.x, c.y, d.x, d.y}; }
                    v0 = v0 * sc; v1 = v1 * sc; u32x4 w; w.x = cvt_pk_bf16(v0[0], v0[1]); w.y = cvt_pk_bf16(v0[2], v0[3]); w.z = cvt_pk_bf16(v1[0], v1[1]); w.w = cvt_pk_bf16(v1[2], v1[3]);
                    *(u32x4*)(rowp + bj * HALF) = w; } }
    }
};
__device__ __forceinline__ float silu_f(float x) { return x * __builtin_amdgcn_rcpf(1.0f + __expf(-x)); }
constexpr size_t SLOT_ELEMS = (size_t)32768 * 512;
struct EpiProj {
    static constexpr bool PERM = true, AFTER_DRAIN = false;
    bf16_t* base0; const float* hlb; int layer; float qscale;
    template <int MODE  > __device__ __forceinline__ void st_bf16(const f32x4 (&acc)[2][2][4][2], bf16_t* base, int row0, int col0, float sc) const {
#pragma unroll
        for (int ai = 0; ai < 2; ++ai)
#pragma unroll
            for (int m = 0; m < 4; ++m) { bf16_t* rowp = base + (size_t)(row0 + ai * HALF + m * 16) * 512 + col0;
#pragma unroll
                for (int bj = 0; bj < 2; ++bj) { f32x4 v0 = acc[ai][bj][m][0], v1 = acc[ai][bj][m][1];
                    if (MODE == 2) { v0 = (f32x4){silu_f(v0[0]), silu_f(v0[1]), silu_f(v0[2]), silu_f(v0[3])}; v1 = (f32x4){silu_f(v1[0]), silu_f(v1[1]), silu_f(v1[2]), silu_f(v1[3])}; }
                    if (MODE == 1) { v0 = v0 * sc; v1 = v1 * sc; }
                    u32x4 w; w.x = cvt_pk_bf16(v0[0], v0[1]); w.y = cvt_pk_bf16(v0[2], v0[3]); w.z = cvt_pk_bf16(v1[0], v1[1]); w.w = cvt_pk_bf16(v1[2], v1[3]);
                    *(u32x4*)(rowp + bj * HALF) = w; } }
    }
    template <bool LB0> static __device__ __forceinline__ float logf_gate(float z, float l) {
        const float e = __expf(-fabsf(z));
        if (LB0) return fminf(z, 0.f) - __logf(1.0f + e);
        const float r = __builtin_amdgcn_rcpf(1.0f + e); const float sg = (z >= 0.f) ? r : e * r;
        return __logf(l + (1.0f - l) * sg);
    }
    template <bool LB0> static __device__ __forceinline__ f32x4 logf_gate4(f32x4 v, f32x4 l) { return (f32x4){logf_gate<LB0>(v[0], l[0]), logf_gate<LB0>(v[1], l[1]), logf_gate<LB0>(v[2], l[2]), logf_gate<LB0>(v[3], l[3])}; }
    __device__ __forceinline__ f32x4 lb4(int c) const {
        const f32x4 h0 = *(const f32x4*)(hlb + c), h1 = *(const f32x4*)(hlb + 512 + c);
        return (f32x4){__builtin_amdgcn_rcpf(1.0f + __expf(h0[0] - h1[0])), __builtin_amdgcn_rcpf(1.0f + __expf(h0[1] - h1[1])), __builtin_amdgcn_rcpf(1.0f + __expf(h0[2] - h1[2])), __builtin_amdgcn_rcpf(1.0f + __expf(h0[3] - h1[3]))};
    }
    template <bool LB0> __device__ __forceinline__ void st_logf(const f32x4 (&acc)[2][2][4][2], float* base, int row0, int col0) const {
        const f32x4 z4 = (f32x4){0.f, 0.f, 0.f, 0.f};
        const f32x4 lA0 = LB0 ? z4 : lb4(col0), lA1 = LB0 ? z4 : lb4(col0 + 4), lB0 = LB0 ? z4 : lb4(col0 + HALF), lB1 = LB0 ? z4 : lb4(col0 + HALF + 4);
#pragma unroll
        for (int ai = 0; ai < 2; ++ai)
#pragma unroll
            for (int m = 0; m < 4; ++m) { float* rowp = base + (size_t)(row0 + ai * HALF + m * 16) * 512 + col0;
                *(f32x4*)(rowp) = logf_gate4<LB0>(acc[ai][0][m][0], lA0); *(f32x4*)(rowp + 4) = logf_gate4<LB0>(acc[ai][0][m][1], lA1);
                *(f32x4*)(rowp + HALF) = logf_gate4<LB0>(acc[ai][1][m][0], lB0); *(f32x4*)(rowp + HALF + 4) = logf_gate4<LB0>(acc[ai][1][m][1], lB1); }
    }
    __device__ __forceinline__ void operator()(const f32x4 (&acc)[2][2][4][2], const Unit& u, int wr, int wc, int fr, int fq) const {
        const int t = u.pn >> 1, colt = (u.pn & 1) * 256, slot = t < 5 ? t : t + 1;
        const int row0 = u.pm * BM + wr * 64 + fr, col0 = colt + wc * 32 + 8 * fq;
        bf16_t* base = base0 + (size_t)slot * SLOT_ELEMS;
        if (t == 4) { if (layer == 0) st_logf<true>(acc, (float*)base, row0, col0); else st_logf<false>(acc, (float*)base, row0, col0); }
        else if (t == 0) st_bf16<1>(acc, base, row0, col0, qscale);
        else if (t == 3 || t == 6) st_bf16<2>(acc, base, row0, col0, 1.f);
        else st_bf16<0>(acc, base, row0, col0, 1.f);
    }
};
struct EpiRes {
    static constexpr bool PERM = false, AFTER_DRAIN = false;
    const float* ysrc; float* ydst; const float* stats; const float* g; const float* b; float alpha;
    __device__ __forceinline__ void operator()(const f32x4 (&acc)[2][2][4][2], const Unit& u, int wr, int wc, int fr, int fq) const {
        const int col0 = u.pn * BM + wc * 32 + 4 * fq, rowb = u.pm * BM + wr * 64 + fr;
        float mu[2][4], rs[2][4];
#pragma unroll
        for (int ai = 0; ai < 2; ++ai)
#pragma unroll
            for (int m = 0; m < 4; ++m) { const f32x2 st = *(const f32x2*)(stats + 2 * (rowb + ai * HALF + m * 16)); mu[ai][m] = st.x; rs[ai][m] = st.y; }
#pragma unroll
        for (int bj = 0; bj < 2; ++bj)
#pragma unroll
            for (int n = 0; n < 2; ++n) { const int c = col0 + bj * HALF + n * 16;
                f32x4 y[2][4];
#pragma unroll
                for (int ai = 0; ai < 2; ++ai)
#pragma unroll
                    for (int m = 0; m < 4; ++m) y[ai][m] = *(const f32x4*)(ysrc + (size_t)(rowb + ai * HALF + m * 16) * 1024 + c);
                const f32x4 gv = *(const f32x4*)(g + c), bv = *(const f32x4*)(b + c);
#pragma unroll
                for (int ai = 0; ai < 2; ++ai)
#pragma unroll
                    for (int m = 0; m < 4; ++m) { const f32x4 o = (((y[ai][m] - mu[ai][m]) * rs[ai][m]) * gv + bv) * alpha + acc[ai][bj][m][n];
                        *(f32x4*)(ydst + (size_t)(rowb + ai * HALF + m * 16) * 1024 + c) = o; }
                asm volatile("" ::: "memory"); }
    }
};
struct EpiGate {
    static constexpr bool PERM = true, AFTER_DRAIN = false;
    bf16_t* G; float* halo; const float* cw; const float* cb;
    static __device__ __forceinline__ float ror1(float v) { return __builtin_bit_cast(float, __builtin_amdgcn_mov_dpp(__builtin_bit_cast(int, v), 0x121, 0xf, 0xf, false)); }
    static __device__ __forceinline__ float ror2(float v) { return __builtin_bit_cast(float, __builtin_amdgcn_mov_dpp(__builtin_bit_cast(int, v), 0x122, 0xf, 0xf, false)); }
    static __device__ __forceinline__ f32x4 ror1v(f32x4 v) { return (f32x4){ror1(v[0]), ror1(v[1]), ror1(v[2]), ror1(v[3])}; }
    static __device__ __forceinline__ f32x4 ror2v(f32x4 v) { return (f32x4){ror2(v[0]), ror2(v[1]), ror2(v[2]), ror2(v[3])}; }
    __device__ __forceinline__ void operator()(const f32x4 (&acc)[2][2][4][2], const Unit& u, int wr, int wc, int fr, int fq) const {
        const int rowb = u.pm * BM + wr * 64 + fr;
#pragma unroll
        for (int n = 0; n < 2; ++n) {
            const int ch = u.pn * 128 + wc * 32 + 8 * fq + 4 * n;
            const f32x4 wa0 = *(const f32x4*)(cw + ch), wa1 = *(const f32x4*)(cw + 5632 + ch), wa2 = *(const f32x4*)(cw + 2 * 5632 + ch), ba = *(const f32x4*)(cb + ch);
            const f32x4 wu0 = *(const f32x4*)(cw + 2816 + ch), wu1 = *(const f32x4*)(cw + 5632 + 2816 + ch), wu2 = *(const f32x4*)(cw + 2 * 5632 + 2816 + ch), bu = *(const f32x4*)(cb + 2816 + ch);
#pragma unroll
            for (int ai = 0; ai < 2; ++ai) {
                f32x4 pa1 = (f32x4){0.f, 0.f, 0.f, 0.f}, pa2 = pa1, pu1 = pa1, pu2 = pa1;
#pragma unroll
                for (int m = 0; m < 4; ++m) {
                    const f32x4 a = acc[ai][0][m][n], uu = acc[ai][1][m][n];
                    const f32x4 ra1 = ror1v(a), ra2 = ror2v(a), ru1 = ror1v(uu), ru2 = ror2v(uu);
                    const f32x4 a1 = (fr >= 1) ? ra1 : pa1, a2 = (fr >= 2) ? ra2 : pa2, u1 = (fr >= 1) ? ru1 : pu1, u2 = (fr >= 2) ? ru2 : pu2;
                    const f32x4 ya = wa0 * a2 + wa1 * a1 + wa2 * a + ba, yu = wu0 * u2 + wu1 * u1 + wu2 * uu + bu;
                    const f32x2 g0 = gelu_pk((f32x2){ya[0], ya[1]}), g1 = gelu_pk((f32x2){ya[2], ya[3]});
                    const int row = rowb + ai * HALF + m * 16;
                    if (m > 0 || fr >= 2) { typedef unsigned u32x2 __attribute__((ext_vector_type(2)));
                        u32x2 w; w.x = cvt_pk_bf16(g0.x * yu[0], g0.y * yu[1]); w.y = cvt_pk_bf16(g1.x * yu[2], g1.y * yu[3]); *(u32x2*)(G + (size_t)row * 2816 + ch) = w; }
                    if (m == 0 && fr < 2) { float* hp = halo + ((size_t)(row >> 6) * 4 + fr) * 5632 + ch; *(f32x4*)hp = a; *(f32x4*)(hp + 2816) = uu; }
                    if (m == 3 && fr >= 14) { float* hp = halo + ((size_t)(row >> 6) * 4 + (fr - 12)) * 5632 + ch; *(f32x4*)hp = a; *(f32x4*)(hp + 2816) = uu; }
                    pa1 = ra1; pa2 = ra2; pu1 = ru1; pu2 = ru2;
                }
            }
        }
    }
};
template <class Epi, class Sched, bool ALIGN_EPI = false, bool SP2 = false>
__device__ __forceinline__ void gemm_phase(PG8_LAS unsigned char* lds, const Gemm g, const Sched& S, const Epi& E) {
    int tid_ = threadIdx.x; asm volatile("" : "+v"(tid_)); const int tid = tid_, wid = __builtin_amdgcn_readfirstlane(tid >> 6), lane = tid & 63, wr = wid >> 2, wc = wid & 3, fr = lane & 15, fq = lane >> 4;
    const int K = g.K, nt = K / BK;
    unsigned voffA[2], voffB[2];
#pragma unroll
    for (int i = 0; i < 2; ++i) { int R, C; stage_rc(tid * 16 + i * 8192, R, C); const int Rb = Epi::PERM ? ((R & ~31) + perm32(R & 31)) : R;
        voffA[i] = (unsigned)(R * K + C) * 2u; voffB[i] = (unsigned)(Rb * K + C) * 2u; }
    const size_t kstep = (size_t)(BK * 2);
    const size_t hstep = (size_t)HALF * K * 2;
    const size_t tstep = 2 * hstep;
    const unsigned ldsw = (unsigned)wid * 1024u;
    const int aoff = lds_byte(wr * 64 + fr, fq * 8), boff = lds_byte(wc * 32 + fr, fq * 8);
#define PG8_SA(b, h) (((b) * 2 + (h)) * HTB)
#define PG8_SB(b, h) ((4 + (b) * 2 + (h)) * HTB)
#define PG8_STAGE(bufoff, gbase, voff) do { _Pragma("unroll") for (int _i = 0; _i < 2; ++_i) \
        __builtin_amdgcn_global_load_lds((const unsigned*)((const char*)(gbase) + (voff)[_i]), (PG8_LAS unsigned*)(lds + (bufoff) + ldsw + _i * 8192), 16, 0, 0); } while (0)
#define PG8_LDA(dst, b, h) do { _Pragma("unroll") for (int m = 0; m < 4; ++m) _Pragma("unroll") for (int k = 0; k < 2; ++k) dst[m][k] = *(const PG8_LAS bf16x8*)(lds + PG8_SA(b, h) + aoff + m * 2048 + k * 1024); } while (0)
#define PG8_LDB(dst, b, h) do { _Pragma("unroll") for (int n = 0; n < 2; ++n) _Pragma("unroll") for (int k = 0; k < 2; ++k) dst[n][k] = *(const PG8_LAS bf16x8*)(lds + PG8_SB(b, h) + boff + n * 2048 + k * 1024); } while (0)
#define PG8_MMA(ai, bj, At, Bt) do { __builtin_amdgcn_s_setprio(1); _Pragma("unroll") for (int m = 0; m < 4; ++m) _Pragma("unroll") for (int n = 0; n < 2; ++n) _Pragma("unroll") for (int k = 0; k < 2; ++k) \
        acc[ai][bj][m][n] = __builtin_amdgcn_mfma_f32_16x16x32_bf16(Bt[n][k], At[m][k], acc[ai][bj][m][n], 0, 0, 0); __builtin_amdgcn_s_setprio(0); } while (0)
#define PG8_WAIT_V(n) asm volatile("s_waitcnt vmcnt(" #n ")" ::: "memory")
#define PG8_WAIT_L(n) asm volatile("s_waitcnt lgkmcnt(" #n ")" ::: "memory")
#define PG8_BAR __builtin_amdgcn_s_barrier()
#define PG8_SCHED __builtin_amdgcn_sched_barrier(0)
    Unit cur, nxt; int ui = 0;
    if (!S.next(0, cur)) return;
    f32x4 acc[2][2][4][2];
#pragma unroll
    for (int a = 0; a < 2; ++a)
#pragma unroll
        for (int b = 0; b < 2; ++b)
#pragma unroll
            for (int m = 0; m < 4; ++m)
#pragma unroll
                for (int n = 0; n < 2; ++n) acc[a][b][m][n] = (f32x4){0.f, 0.f, 0.f, 0.f};
    bf16x8 At[4][2], B0[2][2], B1[2][2];
    const char* cA = (const char*)g.A + (size_t)cur.pm * tstep; const char* cB = (const char*)g.Bt + (size_t)cur.pn * tstep;
    S.a_ready(cur);
    if constexpr (SP2) {
        PG8_STAGE(PG8_SB(0, 0), cB, voffB); PG8_STAGE(PG8_SB(0, 1), cB + hstep, voffB); PG8_STAGE(PG8_SA(0, 0), cA, voffA); PG8_STAGE(PG8_SA(0, 1), cA + hstep, voffA);
        if (wr == 1) PG8_BAR;
        PG8_WAIT_V(2); PG8_BAR;
        PG8_STAGE(PG8_SB(1, 0), cB + kstep, voffB); PG8_STAGE(PG8_SA(1, 0), cA + kstep, voffA); PG8_STAGE(PG8_SB(1, 1), cB + hstep + kstep, voffB);
        PG8_WAIT_V(6); PG8_BAR;
    } else {
        PG8_STAGE(PG8_SB(0, 0), cB, voffB); PG8_STAGE(PG8_SA(0, 0), cA, voffA); PG8_STAGE(PG8_SB(0, 1), cB + hstep, voffB); PG8_STAGE(PG8_SA(0, 1), cA + hstep, voffA);
        if (wr == 1) PG8_BAR;
        PG8_WAIT_V(4); PG8_BAR;
        PG8_STAGE(PG8_SB(1, 0), cB + kstep, voffB); PG8_STAGE(PG8_SA(1, 0), cA + kstep, voffA); PG8_STAGE(PG8_SB(1, 1), cB + hstep + kstep, voffB);
        PG8_WAIT_V(6); PG8_BAR;
    }
    for (;;) {
        const bool has_next = S.next(ui + 1, nxt);
        const char* nA = has_next ? (const char*)g.A + (size_t)nxt.pm * tstep : cA; const char* nB = has_next ? (const char*)g.Bt + (size_t)nxt.pn * tstep : cB;
        for (int t = 0; t < nt; t += 2) {
            const bool last = (t == nt - 2);
            const char* a1 = cA + (size_t)(t + 1) * kstep;
            const char* a2 = last ? nA : cA + (size_t)(t + 2) * kstep; const char* b2 = last ? nB : cB + (size_t)(t + 2) * kstep;
            const char* a3 = a2 + kstep; const char* b3 = b2 + kstep;
            if (last && has_next) S.a_ready(nxt);
            if constexpr (SP2) {
            PG8_LDB(B0, 0, 0); PG8_LDB(B1, 0, 1); PG8_SCHED; PG8_LDA(At, 0, 0); PG8_STAGE(PG8_SA(1, 1), a1 + hstep, voffA);
            PG8_WAIT_V(8); PG8_WAIT_L(0); PG8_BAR; PG8_MMA(0, 0, At, B0); PG8_MMA(0, 1, At, B1); PG8_BAR; PG8_SCHED;
            PG8_LDA(At, 0, 1); PG8_STAGE(PG8_SB(0, 0), b2, voffB); PG8_STAGE(PG8_SB(0, 1), b2 + hstep, voffB); PG8_STAGE(PG8_SA(0, 0), a2, voffA);
            PG8_WAIT_V(8); PG8_WAIT_L(0); PG8_BAR; PG8_MMA(1, 0, At, B0); PG8_MMA(1, 1, At, B1); PG8_BAR; PG8_SCHED;
            PG8_LDB(B0, 1, 0); PG8_LDB(B1, 1, 1); PG8_SCHED; PG8_LDA(At, 1, 0); PG8_STAGE(PG8_SA(0, 1), a2 + hstep, voffA);
            PG8_WAIT_V(8); PG8_WAIT_L(0); PG8_BAR; PG8_MMA(0, 0, At, B0); PG8_MMA(0, 1, At, B1); PG8_BAR; PG8_SCHED;
            PG8_LDA(At, 1, 1); PG8_STAGE(PG8_SB(1, 0), b3, voffB); PG8_STAGE(PG8_SB(1, 1), b3 + hstep, voffB); PG8_STAGE(PG8_SA(1, 0), a3, voffA);
            PG8_WAIT_V(8); PG8_WAIT_L(0); PG8_BAR; PG8_MMA(1, 0, At, B0); PG8_MMA(1, 1, At, B1); PG8_BAR; PG8_SCHED;
            } else {
            PG8_LDB(B0, 0, 0); PG8_SCHED; PG8_LDA(At, 0, 0); PG8_STAGE(PG8_SA(1, 1), a1 + hstep, voffA);
            PG8_WAIT_L(8); PG8_BAR; PG8_WAIT_L(0); PG8_MMA(0, 0, At, B0); PG8_BAR; PG8_SCHED;
            PG8_LDB(B1, 0, 1); PG8_STAGE(PG8_SB(0, 0), b2, voffB);
            PG8_BAR; PG8_WAIT_L(0); PG8_MMA(0, 1, At, B1); PG8_BAR;
            PG8_LDA(At, 0, 1); PG8_STAGE(PG8_SA(0, 0), a2, voffA);
            PG8_BAR; PG8_WAIT_L(0); PG8_MMA(1, 0, At, B0); PG8_BAR; PG8_SCHED;
            PG8_STAGE(PG8_SB(0, 1), b2 + hstep, voffB);
            PG8_WAIT_V(6); PG8_BAR; PG8_MMA(1, 1, At, B1); PG8_BAR;
            PG8_LDB(B0, 1, 0); PG8_SCHED; PG8_LDA(At, 1, 0); PG8_STAGE(PG8_SA(0, 1), a2 + hstep, voffA);
            PG8_WAIT_L(8); PG8_BAR; PG8_WAIT_L(0); PG8_MMA(0, 0, At, B0); PG8_BAR; PG8_SCHED;
            PG8_LDB(B1, 1, 1); PG8_STAGE(PG8_SB(1, 0), b3, voffB);
            PG8_BAR; PG8_WAIT_L(0); PG8_MMA(0, 1, At, B1); PG8_BAR;
            PG8_LDA(At, 1, 1); PG8_STAGE(PG8_SA(1, 0), a3, voffA);
            PG8_BAR; PG8_WAIT_L(0); PG8_MMA(1, 0, At, B0); PG8_BAR; PG8_SCHED;
            PG8_STAGE(PG8_SB(1, 1), b3 + hstep, voffB);
            PG8_WAIT_V(6); PG8_BAR; PG8_MMA(1, 1, At, B1); PG8_BAR;
            }
        }
        if constexpr (ALIGN_EPI) { if (wr == 0) PG8_BAR; }
        if constexpr (!Epi::AFTER_DRAIN) { E(acc, cur, wr, wc, fr, fq); S.done(cur); }
        if (!has_next) break;
#pragma unroll
        for (int a = 0; a < 2; ++a)
#pragma unroll
            for (int b = 0; b < 2; ++b)
#pragma unroll
                for (int m = 0; m < 4; ++m)
#pragma unroll
                    for (int n = 0; n < 2; ++n) acc[a][b][m][n] = (f32x4){0.f, 0.f, 0.f, 0.f};
        cur = nxt; cA = nA; cB = nB; ++ui;
        if constexpr (ALIGN_EPI) { if (wr == 1) PG8_BAR; }
    }
    PG8_WAIT_V(0);
    if constexpr (!ALIGN_EPI) { if (wr == 0) PG8_BAR; }
    PG8_BAR;
    if constexpr (Epi::AFTER_DRAIN) { E.fused(acc, cur, wr, wc, fr, fq, lds, wid, lane); S.done(cur); }
#undef PG8_SA
#undef PG8_SB
#undef PG8_STAGE
#undef PG8_LDA
#undef PG8_LDB
#undef PG8_MMA
#undef PG8_WAIT_V
#undef PG8_WAIT_L
#undef PG8_BAR
#undef PG8_SCHED
}
}
namespace attn_body {
using bf16=__hip_bfloat16;
using bf16x8=__attribute__((ext_vector_type(8)))short;
using s16x4=__attribute__((ext_vector_type(4)))short;
using f32x16=__attribute__((ext_vector_type(16)))float;
using u32x4=__attribute__((ext_vector_type(4)))unsigned;
constexpr int BATCH=4,NHEAD=8,SEQ=8192,D=64,DM=NHEAD*D,OPITCH=1024;
constexpr int NW=8,QBLK=32,QB=QBLK*NW,KVBLK=64,NQB=SEQ/QB;
constexpr int ATTN_PITCH=DM, ATTN_UNIT_ROWS=QB;
__device__ __forceinline__ int crow(int r,int hi){return (r&3)+8*(r>>2)+4*hi;}
#define SBAR() __builtin_amdgcn_sched_barrier(0)
__device__ __forceinline__ void cmask(f32x16&p0,f32x16&p1,int jb,int qrel,int hi){
  const float NEG=-INFINITY; int kb=64*jb+4*hi;
  #pragma unroll
  for(int r=0;r<16;++r){int kv=kb+(r&3)+8*(r>>2); if(kv>qrel)p0[r]=NEG; if(kv+32>qrel)p1[r]=NEG;}
}

constexpr int NSLOT=3, SLOTB=8192;
constexpr int LDS_K=0, LDS_V=NSLOT*SLOTB, LDS_WS=2*NSLOT*SLOTB, LDS_OST=LDS_WS+NW*64*4, LDS_CK=LDS_OST+NW*4096, LDS_BYTES=LDS_CK+SEQ*4;
constexpr float C2=0.125f*1.4426950408889634f;
__device__ __forceinline__ void glds16(const void*gsrc,unsigned lds_dst){unsigned keep;
  asm volatile("s_mov_b32 %0, m0\n\ts_mov_b32 m0, %2\n\ts_nop 0\n\tglobal_load_lds_dwordx4 %1, off\n\ts_mov_b32 m0, %0":"=&s"(keep):"v"(gsrc),"s"(lds_dst):"memory");}
__device__ __forceinline__ float max3f(float a,float b,float c){float r;asm("v_max3_f32 %0, %1, %2, %3":"=v"(r):"v"(a),"v"(b),"v"(c));return r;}
__device__ __forceinline__ float max2f(float a,float b){float r;asm("v_max_f32_e32 %0, %1, %2":"=v"(r):"v"(a),"v"(b));return r;}
__device__ __forceinline__ float fadd_s(float a,float b){float r;asm("v_add_f32_e32 %0, %1, %2":"=v"(r):"v"(a),"v"(b));return r;}
__device__ __forceinline__ float fsub_s(float a,float b){float r;asm("v_sub_f32_e32 %0, %1, %2":"=v"(r):"v"(a),"v"(b));return r;}
typedef float f32x2_t __attribute__((ext_vector_type(2))); typedef __bf16 bf16x2_t __attribute__((ext_vector_type(2)));
__device__ __forceinline__ unsigned cvtpk_s(float lo,float hi){f32x2_t v={lo,hi};bf16x2_t b=__builtin_convertvector(v,bf16x2_t);return __builtin_bit_cast(unsigned,b);}
#define WAIT_BAR(N) asm volatile("s_waitcnt vmcnt(" #N ") lgkmcnt(0)\n\ts_barrier":::"memory")

__device__ __forceinline__ void qkt(f32x16&p0,f32x16&p1,const char*Kslot,const bf16x8*qr,const f32x16&negm,int r32,int hi){
  const char*kb=Kslot+hi*1024+r32*16;
  #pragma unroll
  for(int d0=0;d0<4;++d0){
    const bf16x8 b0=*reinterpret_cast<const bf16x8*>(kb+d0*2048);
    const bf16x8 b1=*reinterpret_cast<const bf16x8*>(kb+d0*2048+512);
    if(d0==0){p0=__builtin_amdgcn_mfma_f32_32x32x16_bf16(b0,qr[0],negm,0,0,0);p1=__builtin_amdgcn_mfma_f32_32x32x16_bf16(b1,qr[0],negm,0,0,0);}
    else{p0=__builtin_amdgcn_mfma_f32_32x32x16_bf16(b0,qr[d0],p0,0,0,0);p1=__builtin_amdgcn_mfma_f32_32x32x16_bf16(b1,qr[d0],p1,0,0,0);}}
}
typedef __attribute__((address_space(3))) const char* lds_cptr;
typedef short v4i16_t __attribute__((ext_vector_type(4)));
__device__ __forceinline__ void kload8(bf16x8*kf,lds_cptr kp){
  kf[0]=*(const __attribute__((address_space(3))) bf16x8*)(kp);      kf[1]=*(const __attribute__((address_space(3))) bf16x8*)(kp+512);
  kf[2]=*(const __attribute__((address_space(3))) bf16x8*)(kp+2048); kf[3]=*(const __attribute__((address_space(3))) bf16x8*)(kp+2560);
  kf[4]=*(const __attribute__((address_space(3))) bf16x8*)(kp+4096); kf[5]=*(const __attribute__((address_space(3))) bf16x8*)(kp+4608);
  kf[6]=*(const __attribute__((address_space(3))) bf16x8*)(kp+6144); kf[7]=*(const __attribute__((address_space(3))) bf16x8*)(kp+6656);
}
__device__ __forceinline__ void kload2(bf16x8*kf,lds_cptr kp,int j){ kf[2*j]=*(const __attribute__((address_space(3))) bf16x8*)(kp+j*2048); kf[2*j+1]=*(const __attribute__((address_space(3))) bf16x8*)(kp+j*2048+512); }
__device__ __forceinline__ s16x4 vtr(lds_cptr p){ return __builtin_bit_cast(s16x4,__builtin_amdgcn_ds_read_tr16_b64_v4i16((__attribute__((address_space(3))) v4i16_t*)p)); }
__device__ __forceinline__ float rowmax(const f32x16&p0,const f32x16&p1){
  float a=max3f(p0[0],p0[1],p1[0]),b=max3f(p0[2],p0[3],p1[1]);a=max3f(a,p1[2],p1[3]);
  #pragma unroll
  for(int r=4;r<16;r+=4){a=max3f(a,p0[r],p0[r+1]);b=max3f(b,p0[r+2],p0[r+3]);a=max3f(a,p1[r],p1[r+1]);b=max3f(b,p1[r+2],p1[r+3]);}
  const float m=max2f(a,b);
  auto rr=__builtin_amdgcn_permlane32_swap(__float_as_uint(m),__float_as_uint(m),false,false);
  return max2f(__uint_as_float(rr[0]),__uint_as_float(rr[1]));
}
__device__ __forceinline__ void pv(f32x16*o,int vb,bf16x8 pa0,bf16x8 pa1,bf16x8 pa2,bf16x8 pa3){
  #pragma unroll
  for(int d0=0;d0<2;++d0){s16x4 lo[4],hi[4];
    #pragma unroll
    for(int ks=0;ks<4;++ks){
      asm volatile("ds_read_b64_tr_b16 %0,%1 offset:%c2":"=&v"(lo[ks]):"v"(vb),"i"(d0*4096+ks*1024):"memory");
      asm volatile("ds_read_b64_tr_b16 %0,%1 offset:%c2":"=&v"(hi[ks]):"v"(vb),"i"(d0*4096+ks*1024+512):"memory");}
    asm volatile("s_waitcnt lgkmcnt(0)":::"memory");SBAR();
    #define PK(k) (bf16x8){lo[k][0],lo[k][1],lo[k][2],lo[k][3],hi[k][0],hi[k][1],hi[k][2],hi[k][3]}
    o[d0]=__builtin_amdgcn_mfma_f32_32x32x16_bf16(pa0,PK(0),o[d0],0,0,0);
    o[d0]=__builtin_amdgcn_mfma_f32_32x32x16_bf16(pa1,PK(1),o[d0],0,0,0);
    o[d0]=__builtin_amdgcn_mfma_f32_32x32x16_bf16(pa2,PK(2),o[d0],0,0,0);
    o[d0]=__builtin_amdgcn_mfma_f32_32x32x16_bf16(pa3,PK(3),o[d0],0,0,0);
    #undef PK
  }
}

#ifndef ATTN_STORE16
#define ATTN_STORE16(p,v) (*(u32x4*)(p)=(v))
#endif
template<int THRL> __device__ __forceinline__ void attn_unit(int b,int h,int qb,const bf16*Q,const bf16*__restrict__ K,const bf16*__restrict__ V,bf16*O,const float*__restrict__ c2,const float*__restrict__ gnorm,int ts,char*shm){
  int tid_=threadIdx.x; asm volatile("":"+v"(tid_)); const int tid=tid_,lane=tid&63,r32=lane&31,hi=lane>>5; const int wid=__builtin_amdgcn_readfirstlane(tid>>6);
  const long rowbase=(long)b*SEQ; const int q0=qb*QB;
  const bf16*Qw=Q+(rowbase+q0+wid*QBLK)*DM+h*D;
  const bf16*Kh=K+(rowbase+(long)ts*KVBLK)*DM+h*D,*Vh=V+(rowbase+(long)ts*KVBLK)*DM+h*D;
  const unsigned lds0=(unsigned)(uintptr_t)shm;
  float*wsf=(float*)(shm+LDS_WS)+wid*64;
  const bf16*ksrc=Kh+(long)lane*DM+wid*8;
  const bf16*vsrc=Vh+(long)(16*(wid&3)+(lane>>2))*DM+(wid>>2)*32+(lane&3)*8;
  const unsigned kdst=lds0+LDS_K+wid*1024, vdst=lds0+LDS_V+wid*1024;
  #define DMA_K(t,slot) glds16(ksrc+(long)(t)*KVBLK*DM,(unsigned)__builtin_amdgcn_readfirstlane(kdst+(slot)))
  #define DMA_V(t,slot) glds16(vsrc+(long)(t)*KVBLK*DM,(unsigned)__builtin_amdgcn_readfirstlane(vdst+(slot)))
  const int vb0=(int)(lds0+LDS_V)+((lane>>4)&1)*32+(lane&3)*8+(4*hi+((lane&15)>>2))*64;
  const char*Kbase=shm+LDS_K; bf16x8 kf[8];
  const lds_cptr shm3=(lds_cptr)shm; const lds_cptr kp0=shm3+LDS_K+hi*1024+r32*16; const lds_cptr vp0=shm3+LDS_V+((lane>>4)&1)*32+(lane&3)*8+(4*hi+((lane&15)>>2))*64;
  const int NT=(q0+QB)/KVBLK-ts;
  DMA_K(0,0);DMA_V(0,0);DMA_K(1,SLOTB);
  bf16x8 qr[4];
  #pragma unroll
  for(int d0=0;d0<4;++d0)qr[d0]=*reinterpret_cast<const bf16x8*>(&Qw[(long)r32*DM+d0*16+hi*8]);
  float mhat=0.f,l_reg=0.f;float zz_=0.f;asm volatile("":"+v"(zz_));f32x16 o[2];f32x16 negm;
  _Pragma("unroll") for(int r=0;r<16;++r){o[0][r]=zz_;o[1][r]=zz_;negm[r]=zz_;}    asm volatile("":"+v"(negm));
  const int qrel=wid*QBLK+r32;
  #define CMASK(P0,P1,t) do{int jb_=(t)-(NT-4); if(jb_>=0)cmask(P0,P1,jb_,qrel,hi);}while(0)
  bool resc=false;
  #define START(P0,P1) do{ const float rm=*(const __attribute__((address_space(3))) float*)(shm3+LDS_CK+4*(q0-ts*KVBLK+wid*QBLK+r32)); resc=false; \
    { const float dl=rm; mhat=fadd_s(mhat,dl); \
      _Pragma("unroll") for(int r=0;r<16;++r){P0[r]=fsub_s(P0[r],dl);P1[r]=fsub_s(P1[r],dl);} \
      _Pragma("unroll") for(int r=0;r<16;++r)negm[r]=-mhat; asm volatile("":"+v"(negm)); } \
    _Pragma("unroll") for(int r=0;r<16;++r)P0[r]=__builtin_amdgcn_exp2f(P0[r]); }while(0)
  #define RESC() do{ if(resc){ asm volatile("s_waitcnt lgkmcnt(0)":::"memory"); \
      _Pragma("unroll") for(int d_=0;d_<2;++d_) _Pragma("unroll") for(int r=0;r<16;++r)o[d_][r]*=wsf[crow(r,hi)]; } }while(0)
  f32x16 pA0,pA1,pB0,pB1;
  int sl_prev=0,sl_cur=0,sl_next=SLOTB;
  #define ROT() do{sl_prev=sl_cur;sl_cur=sl_next;sl_next=(sl_next==(NSLOT-1)*SLOTB)?0:sl_next+SLOTB;}while(0)
  { typedef float f32x4v __attribute__((ext_vector_type(4)));
    const float*cb=c2+((long)(b*NHEAD+h))*SEQ; const float cref=cb[q0+QB-1];
    for(int i=tid;i<(q0+QB)/4-ts*16;i+=NW*64){ const f32x4v v=*(const f32x4v*)(cb+ts*64+4*i); *(__attribute__((address_space(3))) f32x4v*)((lds_cptr)shm+LDS_CK+16*i)=(f32x4v){cref-v[0],cref-v[1],cref-v[2],cref-v[3]}; } }
  DMA_K(2,2*SLOTB);
  WAIT_BAR(3);
  typedef float f32x4w __attribute__((ext_vector_type(4)));
  #define CKADD(P0,P1,t) do{ const __attribute__((address_space(3))) f32x4w*cp_=(const __attribute__((address_space(3))) f32x4w*)(shm3+LDS_CK)+(t)*16+hi; \
    { SBAR(); const f32x4w a0_=cp_[0],a1_=cp_[2],a2_=cp_[4],a3_=cp_[6]; \
      P0[0]+=a0_[0];P0[1]+=a0_[1];P0[2]+=a0_[2];P0[3]+=a0_[3]; P0[4]+=a1_[0];P0[5]+=a1_[1];P0[6]+=a1_[2];P0[7]+=a1_[3]; \
      P0[8]+=a2_[0];P0[9]+=a2_[1];P0[10]+=a2_[2];P0[11]+=a2_[3]; P0[12]+=a3_[0];P0[13]+=a3_[1];P0[14]+=a3_[2];P0[15]+=a3_[3]; } \
    { SBAR(); const f32x4w b0_=cp_[8],b1_=cp_[10],b2_=cp_[12],b3_=cp_[14]; \
      P1[0]+=b0_[0];P1[1]+=b0_[1];P1[2]+=b0_[2];P1[3]+=b0_[3]; P1[4]+=b1_[0];P1[5]+=b1_[1];P1[6]+=b1_[2];P1[7]+=b1_[3]; \
      P1[8]+=b2_[0];P1[9]+=b2_[1];P1[10]+=b2_[2];P1[11]+=b2_[3]; P1[12]+=b3_[0];P1[13]+=b3_[1];P1[14]+=b3_[2];P1[15]+=b3_[3]; } }while(0)
  qkt(pA0,pA1,Kbase,qr,negm,r32,hi);asm volatile("s_nop 15\n\ts_nop 7":"+v"(pA0),"+v"(pA1));CKADD(pA0,pA1,0);CMASK(pA0,pA1,0);
  START(pA0,pA1);
  _Pragma("unroll") for(int r=0;r<16;++r)pA1[r]=__builtin_amdgcn_exp2f(pA1[r]);
  WAIT_BAR(0);
  DMA_K(3,0);DMA_V(1,SLOTB);
  ROT();
  kload8(kf,kp0+sl_cur);
  WAIT_BAR(2);
  s16x4 vlo[8],vhi[8]; u32x4 pw0,pw1,pw2,pw3;
  #define PKW(P,B) cvtpk_s(P[B],P[B+1])
  #define PAF(k) __builtin_bit_cast(bf16x8,pw##k)
  #define VFR(i) (bf16x8){vlo[i][0],vlo[i][1],vlo[i][2],vlo[i][3],vhi[i][0],vhi[i][1],vhi[i][2],vhi[i][3]}
  #define PIN(x) asm volatile("":"+v"(x))
  #define MX3(a,b,c) __builtin_fmaxf(__builtin_fmaxf((a),(b)),(c))
  #define GAPA(MF,A0,A1,A2,A3,W0,W1,PW) do{ MF; sacc+=A0; sacc+=A1; sacc+=A2; sacc+=A3; PIN(sacc); W0; W1; PIN(PW); SBAR(); }while(0)
  #define EX(v) __builtin_amdgcn_exp2f(v)
  #define GAPB(MF,X,B) do{ MF; X[B]=EX(X[B]); X[B+1]=EX(X[B+1]); X[B+2]=EX(X[B+2]); X[B+3]=EX(X[B+3]); PIN(X); SBAR(); }while(0)
  #define VRD(i) do{ vlo[i]=vtr(vp_+(((i)>>2)*4096+((i)&3)*1024)); vhi[i]=vtr(vp_+(((i)>>2)*4096+((i)&3)*1024+512)); }while(0)
  #define KRD(G,j) do{ if(G){ kload2(kf,kp0+sl_next,j); SBAR(); } }while(0)
  #define STEP(C0,C1,P0,P1,t,GK,GV,GL) do{ SBAR(); \
    const lds_cptr vp_=vp0+sl_prev; \
    VRD(0); SBAR(); float sacc=(P0[0]+P0[1]); \
    GAPA(C0=__builtin_amdgcn_mfma_f32_32x32x16_bf16(kf[0],qr[0],negm,0,0,0), P0[2],P0[3],P0[4],P0[5],     pw0[0]=PKW(P0,0), pw0[1]=PKW(P0,2), pw0); \
    VRD(4); SBAR(); GAPA(C1=__builtin_amdgcn_mfma_f32_32x32x16_bf16(kf[1],qr[0],negm,0,0,0), P0[6],P0[7],P0[8],P0[9],     pw0[2]=PKW(P0,4), pw0[3]=PKW(P0,6), pw0); \
    VRD(1); SBAR(); GAPA(C0=__builtin_amdgcn_mfma_f32_32x32x16_bf16(kf[2],qr[1],C0,0,0,0),   P0[10],P0[11],P0[12],P0[13], pw1[0]=PKW(P0,8), pw1[1]=PKW(P0,10), pw1); \
    VRD(5); SBAR(); GAPA(C1=__builtin_amdgcn_mfma_f32_32x32x16_bf16(kf[3],qr[1],C1,0,0,0),   P0[14],P0[15],P1[0],P1[1],   pw1[2]=PKW(P0,12),pw1[3]=PKW(P0,14), pw1); \
    VRD(2); SBAR(); GAPA(C0=__builtin_amdgcn_mfma_f32_32x32x16_bf16(kf[4],qr[2],C0,0,0,0),   P1[2],P1[3],P1[4],P1[5],     pw2[0]=PKW(P1,0), pw2[1]=PKW(P1,2), pw2); \
    VRD(6); SBAR(); GAPA(C1=__builtin_amdgcn_mfma_f32_32x32x16_bf16(kf[5],qr[2],C1,0,0,0),   P1[6],P1[7],P1[8],P1[9],     pw2[2]=PKW(P1,4), pw2[3]=PKW(P1,6), pw2); \
    VRD(3); SBAR(); GAPA(C0=__builtin_amdgcn_mfma_f32_32x32x16_bf16(kf[6],qr[3],C0,0,0,0),   P1[10],P1[11],P1[12],P1[13], pw3[0]=PKW(P1,8), pw3[1]=PKW(P1,10), pw3); \
    VRD(7); SBAR(); GAPA(C1=__builtin_amdgcn_mfma_f32_32x32x16_bf16(kf[7],qr[3],C1,0,0,0),   P1[14],P1[15],0.f,0.f,       pw3[2]=PKW(P1,12),pw3[3]=PKW(P1,14), pw3); \
    l_reg+=sacc; \
    if(GK){DMA_K((t)+3,sl_cur);} if(GV){DMA_V((t)+1,sl_next);} \
    CKADD(C0,C1,t); CMASK(C0,C1,t); \
    { float a=MX3(C0[0],C0[1],C1[0]),b=MX3(C0[2],C0[3],C1[1]); a=MX3(a,C1[2],C1[3]); \
      _Pragma("unroll") for(int r=4;r<16;r+=4){a=MX3(a,C0[r],C0[r+1]);b=MX3(b,C0[r+2],C0[r+3]);a=MX3(a,C1[r],C1[r+1]);b=MX3(b,C1[r+2],C1[r+3]);} \
      float rm=__builtin_fmaxf(a,b); { auto rr=__builtin_amdgcn_permlane32_swap(__float_as_uint(rm),__float_as_uint(rm),false,false); rm=__builtin_fmaxf(__uint_as_float(rr[0]),__uint_as_float(rr[1])); } \
      resc=false; \
      if(__builtin_expect(__any(rm>(float)THRL),0)){ const float dl=__builtin_fmaxf(rm,0.f); mhat+=dl; \
        _Pragma("unroll") for(int r=0;r<16;++r){C0[r]-=dl;C1[r]-=dl;} \
        _Pragma("unroll") for(int r=0;r<16;++r)negm[r]=-mhat; asm volatile("":"+v"(negm)); \
        const float f=__builtin_amdgcn_exp2f(-dl); l_reg*=f; if(hi==0)wsf[r32]=f; resc=true; } } \
    SBAR(); \
    GAPB(o[0]=__builtin_amdgcn_mfma_f32_32x32x16_bf16(PAF(0),VFR(0),o[0],0,0,0), C0,0); \
    GAPB(o[1]=__builtin_amdgcn_mfma_f32_32x32x16_bf16(PAF(0),VFR(4),o[1],0,0,0), C0,4); \
    KRD(GL,0); GAPB(o[0]=__builtin_amdgcn_mfma_f32_32x32x16_bf16(PAF(1),VFR(1),o[0],0,0,0), C0,8); \
    KRD(GL,1); GAPB(o[1]=__builtin_amdgcn_mfma_f32_32x32x16_bf16(PAF(1),VFR(5),o[1],0,0,0), C0,12); \
    KRD(GL,2); GAPB(o[0]=__builtin_amdgcn_mfma_f32_32x32x16_bf16(PAF(2),VFR(2),o[0],0,0,0), C1,0); \
    KRD(GL,3); GAPB(o[1]=__builtin_amdgcn_mfma_f32_32x32x16_bf16(PAF(2),VFR(6),o[1],0,0,0), C1,4); \
    GAPB(o[0]=__builtin_amdgcn_mfma_f32_32x32x16_bf16(PAF(3),VFR(3),o[0],0,0,0), C1,8); \
    GAPB(o[1]=__builtin_amdgcn_mfma_f32_32x32x16_bf16(PAF(3),VFR(7),o[1],0,0,0), C1,12); \
    }while(0)
  int t=1;
  #undef CMASK
  #define CMASK(P0,P1,t) do{}while(0)
  for(;t+5<NT;t+=2){
    STEP(pB0,pB1,pA0,pA1,t,true,true,true);     WAIT_BAR(2); RESC(); ROT();
    STEP(pA0,pA1,pB0,pB1,t+1,true,true,true);   WAIT_BAR(2); RESC(); ROT();
  }
  #undef CMASK
  #define CMASK(P0,P1,t) do{int jb_=(t)-(NT-4); if(jb_>=0)cmask(P0,P1,jb_,qrel,hi);}while(0)
  #define ENDW(tt) do{ if((tt)+3<NT){WAIT_BAR(2);} else if((tt)+2<NT){WAIT_BAR(1);} else {WAIT_BAR(0);} }while(0)
  for(;t+1<NT;t+=2){
    STEP(pB0,pB1,pA0,pA1,t,(t+3<NT),(t+1<NT),(t+1<NT));       ENDW(t);   RESC(); ROT();
    STEP(pA0,pA1,pB0,pB1,t+1,(t+4<NT),(t+2<NT),(t+2<NT));     ENDW(t+1); RESC(); ROT();
  }
  STEP(pB0,pB1,pA0,pA1,NT-1,false,false,false); RESC();
  { float sacc=pB0[0]+pB0[1]; _Pragma("unroll") for(int r=2;r<16;++r)sacc+=pB0[r]; _Pragma("unroll") for(int r=0;r<16;++r)sacc+=pB1[r]; l_reg+=sacc;
    pw0=(u32x4){PKW(pB0,0),PKW(pB0,2),PKW(pB0,4),PKW(pB0,6)};pw1=(u32x4){PKW(pB0,8),PKW(pB0,10),PKW(pB0,12),PKW(pB0,14)};pw2=(u32x4){PKW(pB1,0),PKW(pB1,2),PKW(pB1,4),PKW(pB1,6)};pw3=(u32x4){PKW(pB1,8),PKW(pB1,10),PKW(pB1,12),PKW(pB1,14)};
    SBAR(); pv(o,vb0+sl_cur,PAF(0),PAF(1),PAF(2),PAF(3)); }
  #undef PKW
  #undef PAF
  #undef VFR
  #undef PIN
  #undef MX3
  #undef GAPA
  #undef GAPB
  #undef EX
  #undef VRD
  #undef KRD
  #undef STEP
  #undef ENDW
  {auto rr=__builtin_amdgcn_permlane32_swap(__float_as_uint(l_reg),__float_as_uint(l_reg),false,false);l_reg=__uint_as_float(rr[0])+__uint_as_float(rr[1]);}
  if(hi==0)wsf[32+r32]=l_reg;asm volatile("s_waitcnt lgkmcnt(0)":::"memory");
  float rli[16];
  #pragma unroll
  for(int r=0;r<16;++r)rli[r]=__builtin_amdgcn_rcpf(wsf[32+crow(r,hi)]);
  { const float g0=gnorm[h*D+r32],g1=gnorm[h*D+32+r32];
    #pragma unroll
    for(int r=0;r<16;++r){ const float x0=o[0][r]*rli[r],x1=o[1][r]*rli[r]; float s=x0*x0+x1*x1;
      s+=__shfl_xor(s,1);s+=__shfl_xor(s,2);s+=__shfl_xor(s,4);s+=__shfl_xor(s,8);s+=__shfl_xor(s,16);
      const float sc=1.0f/sqrtf(s*(1.0f/64.0f)+1e-6f); o[0][r]=x0*sc*g0; o[1][r]=x1*sc*g1; rli[r]=1.0f; } }
  bf16*Ow=O+(rowbase+q0+wid*QBLK)*OPITCH+h*D;
  { bf16*stg=(bf16*)(shm+LDS_OST)+wid*2048;
    #pragma unroll
    for(int r=0;r<16;++r){const int orow=crow(r,hi);
      #pragma unroll
      for(int d0=0;d0<2;++d0)stg[orow*64+d0*32+r32]=__float2bfloat16(o[d0][r]*rli[r]);}
    asm volatile("s_waitcnt lgkmcnt(0)":::"memory");
    #pragma unroll
    for(int i=0;i<4;++i){const int row=i*8+(lane>>3),ch=lane&7; const u32x4 v=*(const u32x4*)(stg+row*64+ch*8); ATTN_STORE16(Ow+(long)row*OPITCH+ch*8,v);} }
  asm volatile("s_waitcnt lgkmcnt(0)\n\ts_barrier":::"memory");
  #undef DMA_K
  #undef DMA_V
  #undef CMASK
  #undef CKADD
  #undef START
  #undef RESC
  #undef ROT
}
constexpr int ATTN_LDS_BYTES=LDS_BYTES;
#undef SBAR
#undef WAIT_BAR
}
constexpr int NWAVES = 8;
constexpr int BATCH = 4, SEQ = 8192, M = BATCH * SEQ, D = 1024, DFF = 2816, INC = 3592, NPROJ = 3584;
constexpr int NP1 = 1536, NP2 = 1280;
constexpr float LN_EPS = 1e-5f, RMS_EPS = 1e-6f;
constexpr float DN_ALPHA = 1.4142135623730951f;
constexpr float LOG2E = 1.4426950408889634f;
constexpr size_t MiB = 1u << 20;
constexpr size_t WS_CTL = 0, CTL_ZERO_BYTES = 49152;
constexpr int CW_BAR = 8192;
constexpr int CW_KMAX = 1024, CW_QMAX = 2048, CW_TS = 4096;
constexpr size_t WS_WFA = 1 * MiB;
constexpr size_t WS_STATS = 2 * MiB;
constexpr size_t WS_C2 = 4 * MiB;
constexpr size_t WS_LFA = 5 * MiB;
constexpr size_t WS_WIN = 8 * MiB, WS_WO = 22 * MiB, WS_WUP = 26 * MiB, WS_WDN = 48 * MiB;
constexpr size_t WS_XN = 60 * MiB;
constexpr size_t WS_SLOT0 = 124 * MiB;
constexpr size_t WS_MIX = 380 * MiB;
constexpr size_t WS_HALO = 124 * MiB;
constexpr size_t WS_SUB = 124 * MiB;
constexpr size_t WS_G = 316 * MiB;
constexpr size_t WS_HQS = 444 * MiB, WS_HOI = 476 * MiB, WS_HDL = 508 * MiB;
constexpr size_t WS_END = 512 * MiB;
static_assert(WS_G + (size_t)M * DFF * 2 <= WS_END && WS_HALO + (size_t)(M / 64) * 4 * 5632 * 4 <= WS_G && WS_MIX + (size_t)M * 1024 * 2 <= WS_END, "ws map");
constexpr int RING_BYTES = 131072, MISC_OFF = RING_BYTES + 320, LDS_BYTES = 147456;

#define GAS __attribute__((address_space(1)))
#define LAS __attribute__((address_space(3)))
typedef unsigned short bf16;
typedef unsigned v4u __attribute__((ext_vector_type(4)));
typedef float f32x4 __attribute__((ext_vector_type(4)));
typedef short bf16x8 __attribute__((ext_vector_type(8)));
typedef short bf16x4 __attribute__((ext_vector_type(4)));
#define LDS_WAIT() asm volatile("s_waitcnt lgkmcnt(0)" ::: "memory")
__device__ __forceinline__ unsigned f2bf(float f) { unsigned u = __builtin_bit_cast(unsigned, f); return (u + 0x7fffu + ((u >> 16) & 1u)) >> 16; }
__device__ __forceinline__ unsigned pk2(float lo, float hi) { return f2bf(lo) | (f2bf(hi) << 16); }
__device__ __forceinline__ float bf2f(unsigned short v) { return __uint_as_float((unsigned)v << 16); }
__device__ __forceinline__ float wave_sum(float v) {
#pragma unroll
    for (int o = 1; o < 64; o <<= 1) v += __shfl_xor(v, o);
    return v;
}
__device__ __forceinline__ void p0_transpose_item(const float* W, int ldw, int K, int N, bf16* WT, int row_off, LAS float* scr, int item, int lane) {
    const int nblk = N / 32, kb = item / nblk, nb = item % nblk, k0 = 64 * kb, n0 = 32 * nb;
#pragma unroll
    for (int i = 0; i < 8; ++i) { const int kk = 8 * i + (lane >> 3), c4 = (lane & 7) * 4; const f32x4 v = *(const f32x4*)(W + (size_t)(k0 + kk) * ldw + n0 + c4);
        scr[kk * 33 + c4] = v.x; scr[kk * 33 + c4 + 1] = v.y; scr[kk * 33 + c4 + 2] = v.z; scr[kk * 33 + c4 + 3] = v.w; }
    LDS_WAIT(); asm volatile("" ::: "memory");
    const int c = lane & 7;
#pragma unroll
    for (int j = 0; j < 4; ++j) { const int n = (lane >> 3) + 8 * j; const LAS float* s = scr + (8 * c) * 33 + n;
        v4u o; o.x = pk2(s[0 * 33], s[1 * 33]); o.y = pk2(s[2 * 33], s[3 * 33]); o.z = pk2(s[4 * 33], s[5 * 33]); o.w = pk2(s[6 * 33], s[7 * 33]);
        *(GAS v4u*)(WT + (size_t)(row_off + n0 + n) * K + k0 + 8 * c) = o; }
    LDS_WAIT(); asm volatile("" ::: "memory");
}

typedef GAS unsigned gu32;
#define RLX_AGENT __ATOMIC_RELAXED, __HIP_MEMORY_SCOPE_AGENT
#define XB_TMO      128
#define XB_XCNT(j)  (256  + 64 * (j))
#define XB_XSUB(j)  (1280 + 64 * (j))
#define XB_XGEN(j)  (2304 + 64 * (j))
#define XB_TOP      3328
#define XB_TOPGEN   3392
#define XCD_BAR_WORDS 3456
#define XB_SPIN_CAP (1u << 18)

__device__ __forceinline__ unsigned xb_ld(unsigned* p)              { return __hip_atomic_load(p, __ATOMIC_RELAXED, __HIP_MEMORY_SCOPE_AGENT); }
__device__ __forceinline__ unsigned xb_add(unsigned* p, unsigned v) { return __hip_atomic_fetch_add(p, v, __ATOMIC_RELAXED, __HIP_MEMORY_SCOPE_AGENT); }
__device__ __forceinline__ unsigned xb_xcc_id() { return (unsigned)__builtin_amdgcn_s_getreg((3 << 11) | 20) & 0xFu; }
#define XB_SPIN(cond, bar) do { unsigned _sp = 0; while (cond) { __builtin_amdgcn_s_sleep(1); \
    if ((++_sp & 255u) == 0u) { if (xb_ld(&(bar)[XB_TMO])) break; if (_sp > XB_SPIN_CAP) { atomicAdd(&(bar)[XB_TMO], 1u); break; } } } } while (0)

struct XcdBarrier {
    unsigned* bar; unsigned x;
    volatile LAS unsigned* st;
};

__device__ __forceinline__ XcdBarrier xcd_barrier_post(unsigned* bar, volatile LAS unsigned* st) {
    XcdBarrier b; b.bar = bar; b.x = xb_xcc_id(); b.st = st;
    if (threadIdx.x == 0) (void)xb_add(&bar[XB_XCNT(b.x)], 1u);
    return b;
}
__device__ __forceinline__ void xcd_barrier_complete(unsigned* bar, unsigned x, unsigned& nloc, unsigned& nx) {
    const unsigned G = gridDim.x * gridDim.y * gridDim.z;
    unsigned sum, cnt, mine, sp = 0u;
    for (;;) {
        sum = 0u; cnt = 0u; mine = 0u;
#pragma unroll
        for (unsigned j = 0; j < 16; ++j) { const unsigned c = xb_ld(&bar[XB_XCNT(j)]); sum += c; cnt += (c > 0u) ? 1u : 0u; mine = (j == x) ? c : mine; }
        if (sum == G) break;
        __builtin_amdgcn_s_sleep(1);
        if ((++sp & 255u) == 0u) { if (xb_ld(&bar[XB_TMO])) break; if (sp > XB_SPIN_CAP) { atomicAdd(&bar[XB_TMO], 1u); break; } }
    }
    nloc = mine > 0u ? mine : 1u; nx = cnt > 0u ? cnt : 1u;
}

__device__ __forceinline__ void xcd_barrier(const XcdBarrier& b) {
    asm volatile("s_waitcnt vmcnt(0)" ::: "memory");
    __syncthreads();
    if (threadIdx.x == 0) {
        unsigned* bar = b.bar; unsigned xq = b.x; asm volatile("" : "+s"(bar), "+s"(xq));
        __builtin_amdgcn_s_waitcnt(0);
        unsigned nloc = b.st[0], nx = b.st[1];
        if (nloc == 0u) { xcd_barrier_complete(bar, xq, nloc, nx); b.st[0] = nloc; b.st[1] = nx; }
        const unsigned old = xb_add(&bar[XB_XSUB(xq)], 1u);
        const unsigned gen = old / nloc;
        if (old + 1u == (gen + 1u) * nloc) {
            __builtin_amdgcn_fence(__ATOMIC_RELEASE, "agent");
            asm volatile("s_waitcnt vmcnt(0)" ::: "memory");
            const unsigned og = xb_add(&bar[XB_TOP], 1u);
            const unsigned tg = og / nx;
            if (og + 1u == (tg + 1u) * nx) xb_add(&bar[XB_TOPGEN], 1u);
            else XB_SPIN(xb_ld(&bar[XB_TOPGEN]) == tg, bar);
            __builtin_amdgcn_fence(__ATOMIC_ACQUIRE, "agent");
            xb_add(&bar[XB_XGEN(xq)], 1u);
            asm volatile("s_waitcnt vmcnt(0)" ::: "memory");
        } else {
            XB_SPIN(xb_ld(&bar[XB_XGEN(xq)]) == gen, bar);
            __builtin_amdgcn_fence(__ATOMIC_ACQUIRE, "agent");
            asm volatile("s_waitcnt vmcnt(0)" ::: "memory");
        }
    }
    __syncthreads();
}

struct Ptrs {
    const float *x, *ln_emb_g, *ln_emb_b, *w_in, *fox_f_bias, *fox_norm_g, *hlb, *hgrn_norm_g, *w_o, *ln_mix_g, *ln_mix_b, *w_up, *conv_w, *conv_b, *w_down, *ln_ffn_g, *ln_ffn_b;
    float* out; unsigned char* ws;
};

__device__ __forceinline__ void prologue_weights(const Ptrs& P, LAS unsigned char* lds, int gw, int NGW, int wave, int lane, int gtid, int nthr) {
    LAS float* scr = (LAS float*)(lds + wave * 16384);
    bf16* win = (bf16*)(P.ws + WS_WIN); bf16* wo = (bf16*)(P.ws + WS_WO); bf16* wup = (bf16*)(P.ws + WS_WUP); bf16* wdn = (bf16*)(P.ws + WS_WDN);
    constexpr int IT0 = 16 * 48, IT1 = 16 * 64, IT2 = 16 * 32, IT3 = 44 * 16 * 4, IT7 = 44 * 32;
    constexpr int PER_LAYER = IT0 + IT1 + IT2 + IT3 + IT7;
    for (int it = gw; it < 2 * PER_LAYER; it += NGW) {
        const int l = it / PER_LAYER; int r = it % PER_LAYER;
        const float* wi = P.w_in + (size_t)l * 1024 * INC; const float* wu = P.w_up + (size_t)l * 1024 * 2 * DFF;
        bf16* winl = win + (size_t)l * NPROJ * 1024; bf16* wupl = wup + (size_t)l * 2 * DFF * 1024;
        if (r < IT0) { p0_transpose_item(wi, INC, 1024, 1536, winl, 0, scr, r, lane); continue; } r -= IT0;
        if (r < IT1) { p0_transpose_item(wi + 1544, INC, 1024, 2048, winl, 1536, scr, r, lane); continue; } r -= IT1;
        if (r < IT2) { p0_transpose_item(P.w_o + (size_t)l * 1024 * 1024, 1024, 1024, 1024, wo + (size_t)l * 1024 * 1024, 0, scr, r, lane); continue; } r -= IT2;
        if (r < IT3) { const int sgm = r >> 6, ri = r & 63; p0_transpose_item(wu + ((sgm & 1) ? DFF : 0) + (sgm >> 1) * 128, 2 * DFF, 1024, 128, wupl, sgm * 128, scr, ri, lane); continue; } r -= IT3;
        p0_transpose_item(P.w_down + (size_t)l * DFF * 1024, 1024, DFF, 1024, wdn + (size_t)l * 1024 * DFF, 0, scr, r, lane);
    }
    float* wfa = (float*)(P.ws + WS_WFA);
    for (int i = gtid; i < 2 * 8 * 1024; i += nthr) { const int l = i >> 13, j = (i >> 10) & 7, k = i & 1023; wfa[i] = P.w_in[(size_t)l * 1024 * INC + (size_t)k * INC + 1536 + j]; }
}


template <int LN_NR, bool FA, bool ADD> __device__ __forceinline__ void ln_phase(const float* xsrc, const bf16* xsrcb, const bf16* add, float alpha, float* xdst, bf16* XN, const float* g, const float* bta, const float* wfa, int wfa_ld, const float* fbias, float* lfa,
                                         LAS float* wl, int gw, int NGW, int lane, int tid) {
    if (FA && wfa_ld == 0) { for (int i = tid; i < 8 * 1024 / 4; i += NWAVES * 64) ((LAS f32x4*)wl)[i] = ((const f32x4*)wfa)[i]; __syncthreads(); }
    else if (FA) {
        for (int k = tid; k < 1024; k += NWAVES * 64) { const f32x4 a = *(const f32x4*)(wfa + (size_t)k * wfa_ld), b = *(const f32x4*)(wfa + (size_t)k * wfa_ld + 4);
            wl[k] = a.x; wl[1024 + k] = a.y; wl[2048 + k] = a.z; wl[3072 + k] = a.w; wl[4096 + k] = b.x; wl[5120 + k] = b.y; wl[6144 + k] = b.z; wl[7168 + k] = b.w; }
        __syncthreads(); }
    f32x4 gv[4], bv[4];
#pragma unroll
    for (int j = 0; j < 4; ++j) { gv[j] = ((const f32x4*)g)[lane + 64 * j]; bv[j] = ((const f32x4*)bta)[lane + 64 * j]; }
    const float fb = (FA && lane < 8) ? fbias[lane] : 0.f;
#pragma nounroll
    for (int m0 = gw; m0 < M; m0 += LN_NR * NGW) {
        f32x4 v[LN_NR][4]; unsigned long long av[ADD ? LN_NR : 1][4];
#pragma unroll
        for (int r = 0; r < LN_NR; ++r) { const int m = m0 + r * NGW;
            if (xsrc) { const GAS f32x4* xr = (const GAS f32x4*)(xsrc + (size_t)m * D) + lane;
#pragma unroll
                for (int j = 0; j < 4; ++j) v[r][j] = xr[64 * j]; }
            else { const GAS unsigned long long* xr = (const GAS unsigned long long*)(xsrcb + (size_t)m * D) + lane;
#pragma unroll
                for (int j = 0; j < 4; ++j) { const unsigned long long a = xr[64 * j]; const unsigned lo = (unsigned)a, hi = (unsigned)(a >> 32);
                    v[r][j] = (f32x4){__uint_as_float(lo << 16), __uint_as_float(lo & 0xffff0000u), __uint_as_float(hi << 16), __uint_as_float(hi & 0xffff0000u)}; } }
            if (ADD) { const GAS unsigned long long* ar = (const GAS unsigned long long*)(add + (size_t)m * D) + lane;
#pragma unroll
                for (int j = 0; j < 4; ++j) av[r][j] = ar[64 * j]; } }
#pragma unroll
        for (int r = 0; r < LN_NR; ++r) { const int m = m0 + r * NGW; float s = 0.f;
            if (ADD) {
#pragma unroll
                for (int j = 0; j < 4; ++j) { const unsigned lo = (unsigned)av[r][j], hi = (unsigned)(av[r][j] >> 32);
                    v[r][j] = v[r][j] * alpha + (f32x4){__uint_as_float(lo << 16), __uint_as_float(lo & 0xffff0000u), __uint_as_float(hi << 16), __uint_as_float(hi & 0xffff0000u)}; } }
#pragma unroll
            for (int j = 0; j < 4; ++j) s += (v[r][j].x + v[r][j].y) + (v[r][j].z + v[r][j].w);
            const float mean = wave_sum(s) * (1.f / D); float s2 = 0.f;
#pragma unroll
            for (int j = 0; j < 4; ++j) { v[r][j] = v[r][j] - mean; s2 += (v[r][j].x * v[r][j].x + v[r][j].y * v[r][j].y) + (v[r][j].z * v[r][j].z + v[r][j].w * v[r][j].w); }
            const float rstd = 1.f / sqrtf(wave_sum(s2) * (1.f / D) + LN_EPS);
#pragma unroll
            for (int j = 0; j < 4; ++j) v[r][j] = (v[r][j] * rstd) * gv[j] + bv[j];
            if (XN) { GAS unsigned long long* o8 = (GAS unsigned long long*)(XN + (size_t)m * D) + lane;
#pragma unroll
                for (int j = 0; j < 4; ++j) o8[64 * j] = (unsigned long long)pk2(v[r][j].x, v[r][j].y) | ((unsigned long long)pk2(v[r][j].z, v[r][j].w) << 32); }
            if (xdst) { GAS f32x4* o = (GAS f32x4*)(xdst + (size_t)m * D) + lane;
#pragma unroll
                for (int j = 0; j < 4; ++j) o[64 * j] = v[r][j]; }
            if (FA) { float mine = 0.f; const LAS f32x4* wlr = (const LAS f32x4*)wl; asm volatile("" : "+v"(wlr));
#pragma unroll
                for (int h = 0; h < 8; ++h) { float d = 0.f;
#pragma unroll
                    for (int j = 0; j < 4; ++j) { const f32x4 w = wlr[h * 256 + lane + 64 * j]; d += (v[r][j].x * w.x + v[r][j].y * w.y) + (v[r][j].z * w.z + v[r][j].w * w.w); }
                    d = wave_sum(d); if (lane == h) mine = d; }
                if (lane < 8) { const float z = mine + fb; lfa[(size_t)m * 8 + lane] = fminf(z, 0.f) - __logf(1.0f + __expf(-fabsf(z))); } } }
    }
}

__device__ __forceinline__ void cumsum_phase(const float* lfa, float* c2, int b, LAS float* scr, int tid, int wave, int lane) {
    const f32x4* src = (const f32x4*)(lfa + ((size_t)b * SEQ + 16 * tid) * 8);
    float a[16][8];
#pragma unroll
    for (int i = 0; i < 16; ++i) { const f32x4 p = src[2 * i], q = src[2 * i + 1]; a[i][0] = p.x; a[i][1] = p.y; a[i][2] = p.z; a[i][3] = p.w; a[i][4] = q.x; a[i][5] = q.y; a[i][6] = q.z; a[i][7] = q.w; }
#pragma unroll
    for (int i = 1; i < 16; ++i)
#pragma unroll
        for (int h = 0; h < 8; ++h) a[i][h] += a[i - 1][h];
    float off[8];
#pragma unroll
    for (int h = 0; h < 8; ++h) { float t = a[15][h], inc = t;
#pragma unroll
        for (int o = 1; o < 64; o <<= 1) { const float u = __shfl_up(inc, o); if (lane >= o) inc += u; }
        off[h] = inc - t; if (lane == 63) scr[wave * 8 + h] = inc; }
    __syncthreads();
#pragma unroll
    for (int h = 0; h < 8; ++h) { float p = 0.f; for (int w = 0; w < wave; ++w) p += scr[w * 8 + h]; off[h] += p; }
#pragma unroll
    for (int h = 0; h < 8; ++h) { f32x4* dst = (f32x4*)(c2 + ((size_t)(b * 8 + h)) * SEQ + 16 * tid);
#pragma unroll
        for (int i4 = 0; i4 < 4; ++i4) dst[i4] = (f32x4){(a[4 * i4][h] + off[h]) * LOG2E, (a[4 * i4 + 1][h] + off[h]) * LOG2E, (a[4 * i4 + 2][h] + off[h]) * LOG2E, (a[4 * i4 + 3][h] + off[h]) * LOG2E}; }
    __syncthreads();
}

#ifndef THR_EXTRA
#define THR_EXTRA 0.0f
#endif
__device__ __forceinline__ void fox_norms(const bf16* QA, const bf16* KA, unsigned* kmax, unsigned* qmax, int gw, int lane) {
    if (gw >= M / 16) return;
    v4u kv[16], qv[16];
#pragma unroll
    for (int i = 0; i < 16; ++i) { const size_t off = ((size_t)(16 * gw + i)) * 512 + lane * 8; kv[i] = *(const v4u*)(KA + off); qv[i] = *(const v4u*)(QA + off); }
    float kq = 0.f, qq = 0.f;
#pragma unroll
    for (int i = 0; i < 16; ++i) { float sk = 0.f, sq = 0.f;
#pragma unroll
        for (int j = 0; j < 4; ++j) { const float k0 = __uint_as_float(kv[i][j] << 16), k1 = __uint_as_float(kv[i][j] & 0xffff0000u), q0 = __uint_as_float(qv[i][j] << 16), q1 = __uint_as_float(qv[i][j] & 0xffff0000u); sk += k0 * k0 + k1 * k1; sq += q0 * q0 + q1 * q1; }
        sk += __shfl_xor(sk, 1); sk += __shfl_xor(sk, 2); sk += __shfl_xor(sk, 4); sq += __shfl_xor(sq, 1); sq += __shfl_xor(sq, 2); sq += __shfl_xor(sq, 4);
        kq = fmaxf(kq, sk); qq = fmaxf(qq, sq); }
    if ((lane & 7) == 0) { const int row0 = 16 * gw, b = row0 / SEQ, qb = (row0 % SEQ) / 256, h = lane >> 3;
        atomicMax(kmax + b * 8 + h, __float_as_uint(kq)); atomicMax(qmax + (b * 8 + h) * 32 + qb, __float_as_uint(qq)); }
}
__device__ __forceinline__ void fox_tstart(const float* c2, const unsigned* kmax, const unsigned* qmax, unsigned* tsout, int u) {
    if (u >= 1024) return;
    const int bh = u & 31, qb = u >> 5, q0 = qb * 256;
    const float kn = sqrtf(__uint_as_float(kmax[bh])) * 1.01f, qn = sqrtf(__uint_as_float(qmax[bh * 32 + qb])) * 1.01f;
    const float* cb = c2 + (size_t)bh * SEQ; const float thr = -152.0f - qn * kn - THR_EXTRA;
    const float cq0 = cb[q0];
    int T = q0 / 64 - 1;
    while (T >= 0 && !(cq0 - cb[64 * T + 63] < thr)) --T;
    int ts = (T + 1) & ~1; const int NTabs = q0 / 64 + 4; if (ts > NTabs - 4) ts = NTabs - 4;
    tsout[u] = (unsigned)ts;
}

__device__ __forceinline__ void gate_fixup(const float* halo, const float* cw, const float* cb, bf16* G, int gtid, int nthr) {
    const int ngrp = DFF / 4, nitems = (M / 64) * ngrp;
    for (int item = gtid; item < nitems; item += nthr) {
        const int blk = item / ngrp, ch = (item % ngrp) * 4;
        const float* h0 = halo + (size_t)blk * 4 * 5632 + ch;
        const f32x4 a0 = *(const f32x4*)(h0), u0 = *(const f32x4*)(h0 + 2816), a1 = *(const f32x4*)(h0 + 5632), u1 = *(const f32x4*)(h0 + 5632 + 2816);
        f32x4 pa62 = (f32x4){0.f, 0.f, 0.f, 0.f}, pa63 = pa62, pu62 = pa62, pu63 = pa62;
        if ((blk & 127) != 0) { const float* hp = h0 - 2 * 5632; pa62 = *(const f32x4*)(hp); pu62 = *(const f32x4*)(hp + 2816); pa63 = *(const f32x4*)(hp + 5632); pu63 = *(const f32x4*)(hp + 5632 + 2816); }
        const f32x4 wa0 = *(const f32x4*)(cw + ch), wa1 = *(const f32x4*)(cw + 5632 + ch), wa2 = *(const f32x4*)(cw + 2 * 5632 + ch), ba = *(const f32x4*)(cb + ch);
        const f32x4 wu0 = *(const f32x4*)(cw + 2816 + ch), wu1 = *(const f32x4*)(cw + 5632 + 2816 + ch), wu2 = *(const f32x4*)(cw + 2 * 5632 + 2816 + ch), bu = *(const f32x4*)(cb + 2816 + ch);
        const f32x4 ya0 = wa0 * pa62 + wa1 * pa63 + wa2 * a0 + ba, yu0 = wu0 * pu62 + wu1 * pu63 + wu2 * u0 + bu;
        const f32x4 ya1 = wa0 * pa63 + wa1 * a0 + wa2 * a1 + ba, yu1 = wu0 * pu63 + wu1 * u0 + wu2 * u1 + bu;
        const pg8::f32x2 g00 = pg8::gelu_pk((pg8::f32x2){ya0[0], ya0[1]}), g01 = pg8::gelu_pk((pg8::f32x2){ya0[2], ya0[3]}), g10 = pg8::gelu_pk((pg8::f32x2){ya1[0], ya1[1]}), g11 = pg8::gelu_pk((pg8::f32x2){ya1[2], ya1[3]});
        typedef unsigned u32x2f __attribute__((ext_vector_type(2)));
        *(u32x2f*)(G + (size_t)(blk * 64) * DFF + ch) = (u32x2f){pk2(g00.x * yu0[0], g00.y * yu0[1]), pk2(g01.x * yu0[2], g01.y * yu0[3])};
        *(u32x2f*)(G + (size_t)(blk * 64 + 1) * DFF + ch) = (u32x2f){pk2(g10.x * yu1[0], g10.y * yu1[1]), pk2(g11.x * yu1[2], g11.y * yu1[3])};
    }
}

namespace hg {
constexpr int QT_P = 272, KH_P = 144;
constexpr int O_QT = 0, O_KT = O_QT + 64 * QT_P, O_KH = O_KT + 64 * QT_P, O_VT = O_KH + 128 * KH_P, O_PB = O_VT + 128 * KH_P, O_BT = O_PB + 64 * KH_P, O_RS = O_BT + 2048, O_END = O_RS + 4096;
static_assert(O_END <= RING_BYTES, "hgrn lds");
constexpr int NITEMS = 16 * 128;
#define MFMA16(a, b, c) __builtin_amdgcn_mfma_f32_16x16x32_bf16((a), (b), (c), 0, 0, 0)
typedef float f32x2_t __attribute__((ext_vector_type(2))); typedef __bf16 bf16x2_t __attribute__((ext_vector_type(2)));
__device__ __forceinline__ unsigned cvtpk(float lo, float hi) { f32x2_t v = {lo, hi}; bf16x2_t b = __builtin_convertvector(v, bf16x2_t); return __builtin_bit_cast(unsigned, b); }
__device__ __forceinline__ void hgrn_prep(int first, int stride, bf16* QR, float* LF, const bf16* IR, const bf16* GR, bf16* U, bf16* QS, bf16* OI, float* DLg, LAS unsigned char* lds) {
    int tid_ = threadIdx.x; asm volatile("" : "+v"(tid_)); const int tid = tid_, lane = tid & 63, w = __builtin_amdgcn_readfirstlane(tid >> 6), n16 = lane & 15, g = lane >> 4;
    const int col = tid & 127, tq = tid >> 7;
    LAS unsigned char* QT = lds + O_QT; LAS unsigned char* KT = lds + O_KT; LAS unsigned char* KH = lds + O_KH; LAS unsigned char* VT = lds + O_VT; LAS unsigned char* PB = lds + O_PB;
    LAS float* BT = (LAS float*)(lds + O_BT);
    const int r32 = col & 31, qpos = (col & ~31) + ((r32 < 16) ? (8 * (r32 >> 2) + (r32 & 3)) : (8 * ((r32 - 16) >> 2) + 4 + (r32 & 3)));
    if (first >= NITEMS) return;
    float lf[16]; unsigned short qv[16], vv[16];
    { const int bh = first >> 7, c = first & 127; const size_t base = ((size_t)(bh >> 2) * SEQ + 64 * c + 16 * tq) * 512 + (bh & 3) * 128 + col;
#pragma unroll
      for (int i = 0; i < 16; ++i) { lf[i] = LF[base + (size_t)i * 512]; qv[i] = QR[base + (size_t)i * 512]; vv[i] = IR[base + (size_t)i * 512]; } }
    for (int it = first; it < NITEMS; it += stride) {
        float bl[16]; bl[0] = lf[0];
#pragma unroll
        for (int i = 1; i < 16; ++i) bl[i] = bl[i - 1] + lf[i];
        BT[tq * 128 + col] = bl[15];
        asm volatile("s_waitcnt lgkmcnt(0)\n\ts_barrier" ::: "memory");
        const float t0 = BT[col], t1 = BT[128 + col], t2 = BT[256 + col], t3 = BT[384 + col];
        const float off = (tq == 0) ? 0.f : (tq == 1) ? t0 : (tq == 2) ? (t0 + t1) : (t0 + t1 + t2);
        const float bref = t0 + t1, blast = (t0 + t1) + (t2 + t3);
        unsigned khp[8], vtp[8];
        bf16* qsrow = QS + (size_t)it * 8192 + (size_t)(16 * tq) * 128 + qpos;
#pragma unroll
        for (int i = 0; i < 16; i += 2) {
            const float bb0 = bl[i] + off, bb1 = bl[i + 1] + off, k0 = 1.0f - __expf(lf[i]), k1 = 1.0f - __expf(lf[i + 1]), q0 = bf2f(qv[i]), q1 = bf2f(qv[i + 1]);
            const unsigned qs = cvtpk(q0 * __expf(fminf(bb0 - bref, 80.f)), q1 * __expf(fminf(bb1 - bref, 80.f)));
            const unsigned ks = cvtpk(k0 * __expf(fminf(bref - bb0, 80.f)), k1 * __expf(fminf(bref - bb1, 80.f)));
            const unsigned qa = cvtpk(q0 * __expf(bb0), q1 * __expf(bb1));
            khp[i >> 1] = cvtpk(k0 * __expf(blast - bb0), k1 * __expf(blast - bb1));
            vtp[i >> 1] = (unsigned)vv[i] | ((unsigned)vv[i + 1] << 16);
            *(LAS unsigned short*)(QT + (16 * tq + i) * QT_P + col * 2) = (unsigned short)qs; *(LAS unsigned short*)(QT + (16 * tq + i + 1) * QT_P + col * 2) = (unsigned short)(qs >> 16);
            *(LAS unsigned short*)(KT + (16 * tq + i) * QT_P + col * 2) = (unsigned short)ks; *(LAS unsigned short*)(KT + (16 * tq + i + 1) * QT_P + col * 2) = (unsigned short)(ks >> 16);
            qsrow[(size_t)i * 128] = (unsigned short)qa; qsrow[(size_t)(i + 1) * 128] = (unsigned short)(qa >> 16);
        }
        *(LAS v4u*)(KH + col * KH_P + 32 * tq) = (v4u){khp[0], khp[1], khp[2], khp[3]}; *(LAS v4u*)(KH + col * KH_P + 32 * tq + 16) = (v4u){khp[4], khp[5], khp[6], khp[7]};
        *(LAS v4u*)(VT + col * KH_P + 32 * tq) = (v4u){vtp[0], vtp[1], vtp[2], vtp[3]}; *(LAS v4u*)(VT + col * KH_P + 32 * tq + 16) = (v4u){vtp[4], vtp[5], vtp[6], vtp[7]};
        if (tq == 0) DLg[(size_t)it * 128 + col] = __expf(blast);
        if (it + stride < NITEMS) { const int nx = it + stride, bh = nx >> 7, c = nx & 127; const size_t base = ((size_t)(bh >> 2) * SEQ + 64 * c + 16 * tq) * 512 + (bh & 3) * 128 + col;
#pragma unroll
            for (int i = 0; i < 16; ++i) { lf[i] = LF[base + (size_t)i * 512]; qv[i] = QR[base + (size_t)i * 512]; vv[i] = IR[base + (size_t)i * 512]; } }
        asm volatile("s_waitcnt lgkmcnt(0)\n\ts_barrier" ::: "memory");
        { const int tb = w >> 1;
#pragma unroll
          for (int jj = 0; jj < 2; ++jj) { const int sb = 2 * (w & 1) + jj; f32x4 p = (f32x4){0.f, 0.f, 0.f, 0.f};
              if (sb <= tb) {
#pragma unroll
                  for (int kk = 0; kk < 4; ++kk) { const bf16x8 A = *(const LAS bf16x8*)(QT + (16 * tb + n16) * QT_P + (32 * kk + 8 * g) * 2), B = *(const LAS bf16x8*)(KT + (16 * sb + n16) * QT_P + (32 * kk + 8 * g) * 2); p = MFMA16(A, B, p); }
                  if (sb == tb) {
#pragma unroll
                      for (int i = 0; i < 4; ++i) if (n16 > 4 * g + i) p[i] = 0.f; } }
#pragma unroll
              for (int i = 0; i < 4; ++i) *(LAS unsigned short*)(PB + (16 * tb + 4 * g + i) * KH_P + (16 * sb + n16) * 2) = (unsigned short)f2bf(p[i]); } }
        asm volatile("s_waitcnt lgkmcnt(0)\n\ts_barrier" ::: "memory");
        bf16x8 vB[2];
#pragma unroll
        for (int kk = 0; kk < 2; ++kk) vB[kk] = *(const LAS bf16x8*)(VT + (16 * w + n16) * KH_P + (32 * kk + 8 * g) * 2);
#pragma unroll
        for (int mt = 0; mt < 4; ++mt) { f32x4 acc = (f32x4){0.f, 0.f, 0.f, 0.f};
#pragma unroll
            for (int kk = 0; kk < 2; ++kk) { const bf16x8 A = *(const LAS bf16x8*)(PB + (16 * mt + n16) * KH_P + (32 * kk + 8 * g) * 2); acc = MFMA16(A, vB[kk], acc); }
            *(unsigned long long*)(OI + (((size_t)it * 8 + w) * 4 + mt) * 256 + lane * 4) = (unsigned long long)cvtpk(acc[0], acc[1]) | ((unsigned long long)cvtpk(acc[2], acc[3]) << 32); }
#pragma unroll
        for (int j = 0; j < 8; ++j) { f32x4 acc = (f32x4){0.f, 0.f, 0.f, 0.f};
#pragma unroll
            for (int kk = 0; kk < 2; ++kk) { const bf16x8 A = *(const LAS bf16x8*)(KH + (16 * j + n16) * KH_P + (32 * kk + 8 * g) * 2); acc = MFMA16(A, vB[kk], acc); }
            { const int bh_ = it >> 7; const size_t T0_ = (size_t)(bh_ >> 2) * SEQ + 64 * (it & 127);
              *(unsigned long long*)((bf16*)(LF + (T0_ + 8 * w + j) * 512 + (bh_ & 3) * 128) + lane * 4) = (unsigned long long)cvtpk(acc[0], acc[1]) | ((unsigned long long)cvtpk(acc[2], acc[3]) << 32); } }
    }
    __syncthreads();
}
typedef unsigned u32x2 __attribute__((ext_vector_type(2)));
__device__ __forceinline__ f32x4 up4(u32x2 v) { return (f32x4){__uint_as_float(v.x << 16), __uint_as_float(v.x & 0xffff0000u), __uint_as_float(v.y << 16), __uint_as_float(v.y & 0xffff0000u)}; }
__device__ __forceinline__ void hgrn_scan(int task, float* LF, const float* DLg, int lane) {
    if (task >= 16 * 64) return;
    const int bh = task >> 6, wj = task & 63, g = lane >> 4;
    bf16* up = (bf16*)(LF + ((size_t)(bh >> 2) * SEQ + wj) * 512 + (bh & 3) * 128) + lane * 4;
    const float* dlp = DLg + (size_t)bh * 128 * 128 + 16 * (wj & 7) + 4 * g;
    f32x4 S = (f32x4){0.f, 0.f, 0.f, 0.f};
    u32x2 ub[8]; f32x4 db[8];
#pragma unroll
    for (int k = 0; k < 8; ++k) { ub[k] = *(const u32x2*)(up + (size_t)k * 65536); db[k] = *(const f32x4*)(dlp + (size_t)k * 128); }
#pragma nounroll
    for (int c0 = 0; c0 < SEQ / 64; c0 += 8) {
        u32x2 un[8]; f32x4 dn[8];
        if (c0 + 8 < SEQ / 64) {
#pragma unroll
            for (int k = 0; k < 8; ++k) { un[k] = *(const u32x2*)(up + (size_t)(c0 + 8 + k) * 65536); dn[k] = *(const f32x4*)(dlp + (size_t)(c0 + 8 + k) * 128); } }
        else {
#pragma unroll
            for (int k = 0; k < 8; ++k) { un[k] = (u32x2){0u, 0u}; dn[k] = (f32x4){0.f, 0.f, 0.f, 0.f}; } }
#pragma unroll
        for (int k = 0; k < 8; ++k) { *(u32x2*)(up + (size_t)(c0 + k) * 65536) = (u32x2){cvtpk(S[0], S[1]), cvtpk(S[2], S[3])}; S = S * db[k] + up4(ub[k]); }
#pragma unroll
        for (int k = 0; k < 8; ++k) { ub[k] = un[k]; db[k] = dn[k]; }
    }
}
struct OutSet { v4u qc[2], gc[2]; u32x2 oif[4], sp[8]; };
__device__ __forceinline__ void hgrn_out_phase(int first, int stride, const float* LF, const bf16* QS, const bf16* OI, const bf16* GQ, const float* gnorm, bf16* MIX, LAS unsigned char* lds) {
    int tid_ = threadIdx.x; asm volatile("" : "+v"(tid_)); const int tid = tid_, lane = tid & 63, w = __builtin_amdgcn_readfirstlane(tid >> 6), n16 = lane & 15, g = lane >> 4;
    if (first >= NITEMS) return;
    constexpr int TP = 272, TILE = 64 * TP;
    LAS unsigned char* QTL = lds;
    LAS unsigned char* GTL = lds + 2 * TILE;
    LAS unsigned char* OT = lds + 4 * TILE;
    LAS float* RS = (LAS float*)(lds + 5 * TILE + 1024);
    const int cr0 = tid >> 4, cc = (tid & 15) * 8;
#define HO_LOAD(S, IT) do { const int bh_ = (IT) >> 7, hc_ = (bh_ & 3) * 128; const size_t T0_ = (size_t)(bh_ >> 2) * SEQ + 64 * ((IT) & 127); \
      S.qc[0] = *(const v4u*)(QS + (size_t)(IT) * 8192 + cr0 * 128 + cc); S.qc[1] = *(const v4u*)(QS + (size_t)(IT) * 8192 + (cr0 + 32) * 128 + cc); \
      S.gc[0] = *(const v4u*)(GQ + (T0_ + cr0) * 512 + hc_ + cc); S.gc[1] = *(const v4u*)(GQ + (T0_ + cr0 + 32) * 512 + hc_ + cc); \
      _Pragma("unroll") for (int mt = 0; mt < 4; ++mt) S.oif[mt] = *(const u32x2*)(OI + (((size_t)(IT) * 8 + w) * 4 + mt) * 256 + lane * 4); \
      _Pragma("unroll") for (int j = 0; j < 8; ++j) S.sp[j] = *(const u32x2*)((const bf16*)(LF + (T0_ + 8 * w + j) * 512 + hc_) + lane * 4); } while (0)
#define HO_STAGE(S, P) do { *(LAS v4u*)(QTL + (P) * TILE + cr0 * TP + cc * 2) = S.qc[0]; *(LAS v4u*)(QTL + (P) * TILE + (cr0 + 32) * TP + cc * 2) = S.qc[1]; \
      *(LAS v4u*)(GTL + (P) * TILE + cr0 * TP + cc * 2) = S.gc[0]; *(LAS v4u*)(GTL + (P) * TILE + (cr0 + 32) * TP + cc * 2) = S.gc[1]; } while (0)
#define HO_BAR() asm volatile("s_waitcnt lgkmcnt(0)\n\ts_barrier" ::: "memory")
#define HO_ITER(CUR, NXT, P, IT) do { \
      const int bh = (IT) >> 7, hc = (bh & 3) * 128; const size_t T0 = (size_t)(bh >> 2) * SEQ + 64 * ((IT) & 127); \
      const float gn = gnorm[hc + 16 * w + n16]; \
      const LAS unsigned char* qt = QTL + (P) * TILE; const LAS unsigned char* gt = GTL + (P) * TILE; LAS float* RSc = RS + (P) * 512; \
      f32x4 o[4]; \
      _Pragma("unroll") for (int mt = 0; mt < 4; ++mt) { f32x4 acc = up4(CUR.oif[mt]); \
          _Pragma("unroll") for (int kk = 0; kk < 4; ++kk) acc = MFMA16(*(const LAS bf16x8*)(qt + (16 * mt + n16) * TP + (32 * kk + 8 * g) * 2), \
                                   __builtin_bit_cast(bf16x8, (v4u){CUR.sp[2 * kk].x, CUR.sp[2 * kk].y, CUR.sp[2 * kk + 1].x, CUR.sp[2 * kk + 1].y}), acc); \
          o[mt] = acc; } \
      _Pragma("unroll") for (int mt = 0; mt < 4; ++mt) { f32x4 q = o[mt] * o[mt]; \
          _Pragma("unroll") for (int sh = 1; sh < 16; sh <<= 1) { q[0] += __shfl_xor(q[0], sh); q[1] += __shfl_xor(q[1], sh); q[2] += __shfl_xor(q[2], sh); q[3] += __shfl_xor(q[3], sh); } \
          if (n16 == 0) *(LAS f32x4*)(RSc + w * 64 + 16 * mt + 4 * g) = q; } \
      HO_BAR();                                                              \
      _Pragma("unroll") for (int mt = 0; mt < 4; ++mt) { f32x4 tot = (f32x4){0.f, 0.f, 0.f, 0.f}; \
          _Pragma("unroll") for (int ww = 0; ww < 8; ++ww) tot += *(const LAS f32x4*)(RSc + ww * 64 + 16 * mt + 4 * g); \
          _Pragma("unroll") for (int i = 0; i < 4; ++i) { const int t = 16 * mt + 4 * g + i, e = 16 * w + n16; const float r = __builtin_amdgcn_rsqf(tot[i] * (1.f / 128.f) + RMS_EPS); \
              const float gate = bf2f(*(const LAS unsigned short*)(gt + t * TP + e * 2)); \
              *(LAS unsigned short*)(OT + t * TP + e * 2) = (unsigned short)f2bf(o[mt][i] * r * gn * gate); } } \
      if ((IT) + stride < NITEMS) HO_STAGE(NXT, (P) ^ 1);                    \
      HO_BAR();                                                              \
      { const v4u o0 = *(const LAS v4u*)(OT + cr0 * TP + cc * 2), o1 = *(const LAS v4u*)(OT + (cr0 + 32) * TP + cc * 2); \
        *(v4u*)(MIX + (T0 + cr0) * 1024 + 512 + hc + cc) = o0; *(v4u*)(MIX + (T0 + cr0 + 32) * 1024 + 512 + hc + cc) = o1; } \
      if ((IT) + 2 * stride < NITEMS) HO_LOAD(CUR, (IT) + 2 * stride); } while (0)
    OutSet A, B;
    HO_LOAD(A, first);
    if (first + stride < NITEMS) HO_LOAD(B, first + stride); else B = A;
    HO_STAGE(A, 0);
    HO_BAR();
    for (int it = first; it < NITEMS; it += 2 * stride) {
        HO_ITER(A, B, 0, it);
        if (it + stride < NITEMS) HO_ITER(B, A, 1, it + stride);
    }
    __syncthreads();
#undef HO_LOAD
#undef HO_STAGE
#undef HO_BAR
#undef HO_ITER
}
}
namespace cg = cooperative_groups;
#ifndef PHM
#define PHM 0xffff
#endif
#define PH(b) if constexpr ((PHM >> (b)) & 1)
#ifndef DUPP
#define DUPP 0
#endif
#define GSYNC() do { xcd_barrier(xbar); if (DUPP == 9) xcd_barrier(xbar); } while (0)
#ifndef PG8_SP2_
#define PG8_SP2_ true
#endif
#ifndef PG8_ALIGN_UP
#define PG8_ALIGN_UP true
#endif
#ifndef PG8_ALIGN_
#define PG8_ALIGN_ true
#endif
#ifndef CIDX
#define CIDX bx
#endif
#define REP(k) for (int rep_ = 0; rep_ < ((DUPP == (k)) ? 2 : 1); ++rep_)
struct Args { Ptrs p; };
#define FRESH_IDS() int tid = threadIdx.x; asm volatile("" : "+v"(tid)); const int lane = tid & 63, wave = __builtin_amdgcn_readfirstlane(tid >> 6); const int gw = bx * NWAVES + wave, gtid = bx * (NWAVES * 64) + tid; (void)lane; (void)gw; (void)gtid;
__global__ void __launch_bounds__(NWAVES * 64, 2) fwd_megakernel(Args args) {
    extern __shared__ __attribute__((aligned(16))) unsigned char lds_raw[];
    cg::grid_group grid = cg::this_grid();
    const Ptrs& P = args.p;
    LAS unsigned char* lds = (LAS unsigned char*)lds_raw;
    volatile LAS int* MISC = (volatile LAS int*)(lds + MISC_OFF);
    const int G = gridDim.x, bx = blockIdx.x;
    const int NGW = G * NWAVES, nthr = G * NWAVES * 64;
    unsigned char* ws = P.ws;
    unsigned* ctl = (unsigned*)(ws + WS_CTL);
    if (threadIdx.x < 32) ((LAS unsigned*)(lds + MISC_OFF))[threadIdx.x] = 0u;
    __syncthreads();
    const XcdBarrier xbar = xcd_barrier_post(ctl + CW_BAR, (volatile LAS unsigned*)(lds + MISC_OFF) + 8);
    float* c2 = (float*)(ws + WS_C2); float* lfa = (float*)(ws + WS_LFA); const float* wfa = (const float*)(ws + WS_WFA);
    bf16* XN = (bf16*)(ws + WS_XN); bf16* slot0 = (bf16*)(ws + WS_SLOT0); bf16* MIX = (bf16*)(ws + WS_MIX); bf16* GB = (bf16*)(ws + WS_G); bf16* SUB = (bf16*)(ws + WS_SUB);

    REP(5) PH(0) { FRESH_IDS(); prologue_weights(P, lds, gw, NGW, wave, lane, gtid, nthr); }
    __syncthreads();
    PH(1) { FRESH_IDS(); ln_phase<4, true, false>(P.x, nullptr, nullptr, 1.f, nullptr, XN, P.ln_emb_g, P.ln_emb_b, P.w_in + 1536, INC, P.fox_f_bias, lfa, (LAS float*)lds, gw, NGW, lane, tid); }
    grid.sync();

#pragma nounroll
    for (int l = 0; l < 2; ++l) {
        PH(2) if (bx < BATCH) { FRESH_IDS(); cumsum_phase(lfa, c2, bx, (LAS float*)lds, tid, wave, lane); }
        REP(1) { if (rep_) GSYNC();
        PH(3) { pg8::Gemm g{XN, (const bf16*)(ws + WS_WIN) + (size_t)l * NPROJ * 1024, M, NPROJ, D}; pg8::StaticOrder S; S.init(M, NPROJ, G, CIDX);
          pg8::EpiProj E{slot0, P.hlb, l, attn_body::C2};
          pg8::gemm_phase<pg8::EpiProj, pg8::StaticOrder, PG8_ALIGN_, PG8_SP2_>(lds, g, S, E); } }
        GSYNC();
        PH(5) { FRESH_IDS(); fox_norms(slot0, slot0 + pg8::SLOT_ELEMS, ctl + CW_KMAX + 32 * l, ctl + CW_QMAX + 1024 * l, gw, lane); }
        REP(4) { if (rep_) GSYNC();
        PH(4) hg::hgrn_prep(bx, G, slot0 + 3 * pg8::SLOT_ELEMS, (float*)(slot0 + 4 * pg8::SLOT_ELEMS), slot0 + 6 * pg8::SLOT_ELEMS, slot0 + 7 * pg8::SLOT_ELEMS, nullptr, (bf16*)(ws + WS_HQS), (bf16*)(ws + WS_HOI), (float*)(ws + WS_HDL), lds); }
        GSYNC();
        PH(4) { FRESH_IDS(); hg::hgrn_scan(gw, (float*)(slot0 + 4 * pg8::SLOT_ELEMS), (const float*)(ws + WS_HDL), lane);
                if (gw >= 1024) fox_tstart(c2, ctl + CW_KMAX + 32 * l, ctl + CW_QMAX + 1024 * l, ctl + CW_TS + 1024 * l, gtid - 1024 * 64); }
        GSYNC();
#ifndef DUP_MIX
#define DUP_MIX 0
#endif
        for (int rep = 0; rep < (DUP_MIX ? 2 : 1); ++rep) { unsigned* ctr = ctl + 64 * (l + 2 * rep); const bool do_h = (rep == 0) || (DUP_MIX & 1), do_a = (rep == 0) || (DUP_MIX & 2);
          const bf16* QA = slot0; const bf16* KA = slot0 + pg8::SLOT_ELEMS; const bf16* VA = slot0 + 2 * pg8::SLOT_ELEMS;
          int nxt_it = 0, nxt_ts = 0; if (threadIdx.x == 0) { nxt_it = (int)atomicAdd(ctr, 1u); nxt_ts = (nxt_it < 1024) ? (int)ctl[CW_TS + 1024 * l + (nxt_it & 31) + 32 * (31 - (nxt_it >> 5))] : 0; }
          for (;;) {
              FRESH_IDS();
              if (tid == 0) { MISC[16] = nxt_it; MISC[17] = nxt_ts; }
              __syncthreads();
              const int it = MISC[16], its = MISC[17];
              __syncthreads();
              if (it >= 1024) break;
              if (tid == 0) { nxt_it = (int)atomicAdd(ctr, 1u); nxt_ts = (nxt_it < 1024) ? (int)ctl[CW_TS + 1024 * l + (nxt_it & 31) + 32 * (31 - (nxt_it >> 5))] : 0; }
              PH(5) if (do_a) { const int idx = it, qb = 31 - (idx >> 5), bh = idx & 31;
                     attn_body::attn_unit<60>(bh >> 3, bh & 7, qb, (const attn_body::bf16*)QA, (const attn_body::bf16*)KA, (const attn_body::bf16*)VA, (attn_body::bf16*)MIX, c2, P.fox_norm_g + l * 512, (int)__builtin_amdgcn_readfirstlane(its), (char*)lds_raw); }
          }
          PH(4) if (do_h) hg::hgrn_out_phase(bx, G, (const float*)(slot0 + 4 * pg8::SLOT_ELEMS), (const bf16*)(ws + WS_HQS), (const bf16*)(ws + WS_HOI), slot0 + 7 * pg8::SLOT_ELEMS, P.hgrn_norm_g + l * 512, MIX, lds);
          if (DUP_MIX && rep == 0) GSYNC(); }
        GSYNC();
        REP(6) { if (rep_) GSYNC();
        PH(6) { pg8::Gemm g{MIX, (const bf16*)(ws + WS_WO) + (size_t)l * 1024 * 1024, M, D, D}; pg8::StaticOrder S; S.init(M, D, G, CIDX);
          pg8::EpiBf16<0> E{SUB, D, nullptr, 0, 0, 1.f};
          pg8::gemm_phase<pg8::EpiBf16<0>, pg8::StaticOrder, PG8_ALIGN_, PG8_SP2_>(lds, g, S, E); } }
        GSYNC();
        REP(3) { if (rep_) GSYNC();
        PH(1) { FRESH_IDS(); ln_phase<4, false, true>(nullptr, XN, SUB, DN_ALPHA, nullptr, (DUPP == 3 && rep_ == 0) ? (bf16*)(ws + 200 * MiB) : XN, P.ln_mix_g + l * D, P.ln_mix_b + l * D, nullptr, 0, nullptr, nullptr, (LAS float*)lds, gw, NGW, lane, tid); } }
        GSYNC();
        REP(2) { if (rep_) GSYNC();
        PH(7) { pg8::Gemm g{XN, (const bf16*)(ws + WS_WUP) + (size_t)l * 2 * DFF * 1024, M, 2 * DFF, D}; pg8::StaticOrder S; S.init(M, 2 * DFF, G, CIDX);
          pg8::EpiGate E{GB, (float*)(ws + WS_HALO), P.conv_w + (size_t)l * 3 * 2 * DFF, P.conv_b + (size_t)l * 2 * DFF};
          pg8::gemm_phase<pg8::EpiGate, pg8::StaticOrder, PG8_ALIGN_UP, PG8_SP2_>(lds, g, S, E); } }
        GSYNC();
        REP(8) { if (rep_) GSYNC();
        PH(8) { FRESH_IDS(); gate_fixup((const float*)(ws + WS_HALO), P.conv_w + (size_t)l * 3 * 2 * DFF, P.conv_b + (size_t)l * 2 * DFF, GB, gtid, nthr); } }
        GSYNC();
        REP(7) { if (rep_) GSYNC();
        PH(6) { pg8::Gemm g{GB, (const bf16*)(ws + WS_WDN) + (size_t)l * 1024 * DFF, M, D, DFF}; pg8::StaticOrder S; S.init(M, D, G, CIDX);
          pg8::EpiBf16<0> E{SUB, D, nullptr, 0, 0, 1.f};
          pg8::gemm_phase<pg8::EpiBf16<0>, pg8::StaticOrder, PG8_ALIGN_, PG8_SP2_>(lds, g, S, E); } }
        GSYNC();
        if (l == 0) { PH(1) { FRESH_IDS(); ln_phase<4, true, true>(nullptr, XN, SUB, DN_ALPHA, nullptr, XN, P.ln_ffn_g, P.ln_ffn_b, wfa + 8 * 1024, 0, P.fox_f_bias + 8, lfa, (LAS float*)lds, gw, NGW, lane, tid); } GSYNC(); }
        else PH(1) { FRESH_IDS(); ln_phase<4, false, true>(nullptr, XN, SUB, DN_ALPHA, P.out, nullptr, P.ln_ffn_g + D, P.ln_ffn_b + D, nullptr, 0, nullptr, nullptr, (LAS float*)lds, gw, NGW, lane, tid); }
    }
}

extern "C" void kernel_launch(void* const* d_in, const int* in_sizes, int n_in, void* d_out, int out_size, void* d_ws, size_t ws_size, hipStream_t stream) {
    static int grid = 0;
    if (grid == 0) {
        if (n_in != 17 || in_sizes[0] != M * D || out_size != M * D || ws_size < WS_END) { fprintf(stderr, "kernel_launch: unexpected shapes: n_in %d in0 %d out %d ws %zu\n", n_in, n_in > 0 ? in_sizes[0] : -1, out_size, ws_size); grid = -1; return; }
        int dev = 0, cus = 0, per_cu = 0;
        if (hipGetDevice(&dev) != hipSuccess || hipDeviceGetAttribute(&cus, hipDeviceAttributeMultiprocessorCount, dev) != hipSuccess) { fprintf(stderr, "kernel_launch: device query failed\n"); grid = -1; return; }
        if (hipFuncSetAttribute((const void*)fwd_megakernel, hipFuncAttributeMaxDynamicSharedMemorySize, LDS_BYTES) != hipSuccess) { fprintf(stderr, "kernel_launch: hipFuncSetAttribute failed\n"); grid = -1; return; }
        if (hipOccupancyMaxActiveBlocksPerMultiprocessor(&per_cu, (const void*)fwd_megakernel, NWAVES * 64, LDS_BYTES) != hipSuccess || per_cu < 1) { fprintf(stderr, "kernel_launch: occupancy query says %d blocks/CU\n", per_cu); per_cu = 1; }
        (void)hipGetLastError();
        if (cus < 256) { fprintf(stderr, "kernel_launch: this kernel's phase maps need 256 co-resident workgroups (one per CU); the device has %d CUs\n", cus); grid = -1; return; }
        grid = 256;
    }
    if (grid < 0) return;
    (void)hipMemsetAsync((char*)d_ws + WS_CTL, 0, CTL_ZERO_BYTES, stream);
    Args a{};
    const float** pp = (const float**)&a.p;
    for (int i = 0; i < 17; ++i) pp[i] = (const float*)d_in[i];
    a.p.out = (float*)d_out; a.p.ws = (unsigned char*)d_ws;
    void* kargs[] = {&a};
    const hipError_t e = hipLaunchCooperativeKernel((const void*)fwd_megakernel, dim3(grid), dim3(NWAVES * 64), kargs, LDS_BYTES, stream);
    if (e != hipSuccess) fprintf(stderr, "kernel_launch: cooperative launch failed: %s (grid %d)\n", hipGetErrorString(e), grid);
}
```
